# Optimizing an MI355X kernel written in HIP

```python
import math
import jax, jax.numpy as jnp
from jax import lax
import numpy as np


D_MODEL = 1024
BATCH = 4
SEQ = 4096
DEPTH = 1
DEC_BATCH = 128
DEC_SEQ = 1
PAST_LEN = 8192
PAGE_SIZE = 128

HEAD_DIM = 64
N_HEADS = D_MODEL // HEAD_DIM
KV_HEADS = N_HEADS // 4
GROUP = N_HEADS // KV_HEADS
Q_W = N_HEADS * HEAD_DIM
KV_W = KV_HEADS * HEAD_DIM
WINDOW = 128
BLK = WINDOW
N_BUCKETS = 32
MAX_EXACT = N_BUCKETS // 2
MAX_DIST = WINDOW
ATT_SCALE = HEAD_DIM ** -0.5
RNN_W = D_MODEL
N_BLOCKS = 16
BLOCK_W = RNN_W // N_BLOCKS
CONV_W = 4
LRU_C = 8.0
EPS = 1e-6
NEG = -1e30
SPLITS = (Q_W, KV_W, KV_W, Q_W, RNN_W, RNN_W, D_MODEL, D_MODEL)
IN_W = sum(SPLITS)

kernel_name = 'hybrid_swa_sink_rglru_gated_merge_step'


def _rmsnorm(x, g):
    xf = x.astype(jnp.float32)
    y = xf * lax.rsqrt(jnp.mean(xf * xf, axis=-1, keepdims=True) + EPS) * g.astype(jnp.float32)
    return y.astype(x.dtype)


def _rel_bucket(dist):
    n = jnp.maximum(dist, 0)
    nf = jnp.maximum(n, 1).astype(jnp.float32)
    large = MAX_EXACT + (jnp.log(nf / MAX_EXACT) / math.log(MAX_DIST / MAX_EXACT)
                         * (N_BUCKETS - MAX_EXACT)).astype(jnp.int32)
    large = jnp.minimum(large, N_BUCKETS - 1)
    return jnp.where(n < MAX_EXACT, n, large)


def _rel_bias(rel_table, dist):
    b = rel_table[_rel_bucket(dist)].astype(jnp.float32)
    return jnp.transpose(b, (2, 0, 1)).reshape(KV_HEADS, GROUP, dist.shape[0], dist.shape[1])


def _sink_softmax(logits, sinks):
    s = jnp.broadcast_to(sinks.astype(jnp.float32).reshape(KV_HEADS, GROUP, 1, 1),
                         logits.shape[:-1] + (1,))
    p = jax.nn.softmax(jnp.concatenate([logits, s], axis=-1), axis=-1)
    return p[..., :-1]


def _band_attention(q, k, v, rel_table, sinks):
    B, S = q.shape[0], q.shape[1]
    nb = S // BLK
    qb = q.reshape(B, nb, BLK, KV_HEADS, GROUP, HEAD_DIM).astype(jnp.float32)
    pad = jnp.zeros((B, BLK, KV_HEADS, HEAD_DIM), k.dtype)
    kp = jnp.concatenate([pad, k], axis=1)
    vp = jnp.concatenate([pad, v], axis=1)
    shp = (B, nb, BLK, KV_HEADS, HEAD_DIM)
    kb = jnp.concatenate([kp[:, :S].reshape(shp), kp[:, BLK:].reshape(shp)], axis=2).astype(jnp.float32)
    vb = jnp.concatenate([vp[:, :S].reshape(shp), vp[:, BLK:].reshape(shp)], axis=2).astype(jnp.float32)
    logits = jnp.einsum('bnqkgd,bnskd->bnkgqs', qb, kb) * ATT_SCALE
    qi = jnp.arange(BLK)[:, None]
    kj = jnp.arange(2 * BLK)[None, :]
    dist = qi + BLK - kj
    band = (dist >= 0) & (dist < WINDOW)
    not_pad = (jnp.arange(nb)[:, None, None] > 0) | (kj >= BLK)[None]
    valid = band[None] & not_pad
    logits = jnp.where(valid[None, :, None, None], logits + _rel_bias(rel_table, dist), NEG)
    p = _sink_softmax(logits, sinks)
    o = jnp.einsum('bnkgqs,bnskd->bnqkgd', p, vb)
    return o.reshape(B, S, Q_W).astype(q.dtype)


def _window_step_attention(q, k, v, k_past, v_past, rel_table, sinks):
    B, T = q.shape[0], q.shape[1]
    W = k_past.shape[1]
    kc = jnp.concatenate([k_past, k.astype(k_past.dtype)], axis=1)
    vc = jnp.concatenate([v_past, v.astype(v_past.dtype)], axis=1)
    qg = q.reshape(B, T, KV_HEADS, GROUP, HEAD_DIM).astype(jnp.float32)
    logits = jnp.einsum('btkgd,bskd->bkgts', qg, kc.astype(jnp.float32)) * ATT_SCALE
    kpos = jnp.concatenate([jnp.arange(W) - W, jnp.arange(T)])
    dist = jnp.arange(T)[:, None] - kpos[None, :]
    valid = (dist >= 0) & (dist < WINDOW)
    logits = jnp.where(valid, logits + _rel_bias(rel_table, dist), NEG)
    p = _sink_softmax(logits, sinks)
    o = jnp.einsum('bkgts,bskd->btkgd', p, vc.astype(jnp.float32)).reshape(B, T, Q_W)
    return o.astype(q.dtype), kc[:, -W:], vc[:, -W:]


def _causal_conv(xr, buf, w_conv, b_conv):
    T = xr.shape[1]
    xp = jnp.concatenate([buf.astype(xr.dtype), xr], axis=1)
    y = b_conv
    for j in range(CONV_W):
        y = y + xp[:, j:j + T] * w_conv[j]
    return y, xp[:, -(CONV_W - 1):]


def _rglru(xc, h0, w_ra, b_ra, w_rx, b_rx, lam):
    B, T = xc.shape[0], xc.shape[1]
    xf = xc.astype(jnp.float32)
    xb = xf.reshape(B, T, N_BLOCKS, BLOCK_W)
    r = jax.nn.sigmoid(jnp.einsum('btnc,ncd->btnd', xb, w_ra.astype(jnp.float32)).reshape(B, T, RNN_W)
                       + b_ra.astype(jnp.float32))
    i = jax.nn.sigmoid(jnp.einsum('btnc,ncd->btnd', xb, w_rx.astype(jnp.float32)).reshape(B, T, RNN_W)
                       + b_rx.astype(jnp.float32))
    log_a = -LRU_C * r * jax.nn.softplus(-lam.astype(jnp.float32))
    a = jnp.exp(log_a)
    u = jnp.sqrt(-jnp.expm1(2.0 * log_a)) * (i * xf)

    def step(h, au):
        a_t, u_t = au
        h = a_t * h + u_t
        return h, h

    h_last, hs = lax.scan(step, h0.astype(jnp.float32), (jnp.swapaxes(a, 0, 1), jnp.swapaxes(u, 0, 1)))
    return jnp.swapaxes(hs, 0, 1).astype(xc.dtype), h_last.astype(xc.dtype)


def _layer(x, c, k_past, v_past, conv_past, h_past, rel_table, w, prompt):
    (norm_g, w_ada, b_ada, w_in, q_g, k_g, sinks, w_conv, b_conv,
     w_ra, b_ra, w_rx, b_rx, lam, w_pa, w_pr, w_out) = w
    B, T = x.shape[0], x.shape[1]
    mod = (c @ w_ada + b_ada)[:, None, :]
    shift, scale, gate = jnp.split(mod, 3, axis=-1)
    h = _rmsnorm(x, norm_g) * (1.0 + scale) + shift
    z = h @ w_in
    offs = np.cumsum(SPLITS)[:-1].tolist()
    q, k, v, ga, xr, gr, ma, mr = jnp.split(z, offs, axis=-1)
    q = _rmsnorm(q.reshape(B, T, N_HEADS, HEAD_DIM), q_g)
    k = _rmsnorm(k.reshape(B, T, KV_HEADS, HEAD_DIM), k_g)
    v = v.reshape(B, T, KV_HEADS, HEAD_DIM)
    if prompt:
        o = _band_attention(q, k, v, rel_table, sinks)
        wp = min(WINDOW, T)
        k_new, v_new = k[:, -wp:], v[:, -wp:]
        conv_buf = jnp.zeros((B, CONV_W - 1, RNN_W), x.dtype)
        h0 = jnp.zeros((B, RNN_W), x.dtype)
    else:
        o, k_new, v_new = _window_step_attention(q, k, v, k_past, v_past, rel_table, sinks)
        conv_buf, h0 = conv_past, h_past
    ya = o * jax.nn.silu(ga)
    xc, conv_new = _causal_conv(xr, conv_buf, w_conv, b_conv)
    hs, h_last = _rglru(xc, h0, w_ra, b_ra, w_rx, b_rx, lam)
    yr = hs * jax.nn.silu(gr)
    merged = jax.nn.sigmoid(ma) * (ya @ w_pa) + jax.nn.sigmoid(mr) * (yr @ w_pr)
    y = x + gate * (merged @ w_out)
    return y, k_new, v_new, conv_new, h_last


def setup_inputs(seed: int = 0) -> dict:
    key = jax.random.key(seed)
    ks = jax.random.split(key, 28)
    f32 = jnp.float32
    nrm = lambda k, s, sc: jax.random.normal(k, s, f32) * sc
    W = min(WINDOW, PAST_LEN)
    a8 = jax.random.uniform(ks[22], (DEPTH, RNN_W), f32, minval=0.9, maxval=0.999)
    s = a8 ** (1.0 / LRU_C)
    lam = jnp.log(s) - jnp.log1p(-s)
    return {
        'x_prompt': nrm(ks[0], (BATCH, SEQ, D_MODEL), 1.0),
        'x_sample': nrm(ks[1], (DEC_BATCH, DEC_SEQ, D_MODEL), 1.0),
        'cache_k': nrm(ks[2], (DEPTH, DEC_BATCH, W, KV_HEADS, HEAD_DIM), 1.0),
        'cache_v': nrm(ks[3], (DEPTH, DEC_BATCH, W, KV_HEADS, HEAD_DIM), 1.0),
        'state_conv': nrm(ks[4], (DEPTH, DEC_BATCH, CONV_W - 1, RNN_W), 1.0),
        'state_h': nrm(ks[5], (DEPTH, DEC_BATCH, RNN_W), 0.5),
        'c_prompt': nrm(ks[6], (BATCH, D_MODEL), 1.0),
        'c_sample': nrm(ks[7], (DEC_BATCH, D_MODEL), 1.0),
        'rel_table': nrm(ks[8], (N_BUCKETS, N_HEADS), 0.5),
        'norm_g': 1.0 + nrm(ks[9], (DEPTH, D_MODEL), 0.02),
        'w_ada': nrm(ks[10], (DEPTH, D_MODEL, 3 * D_MODEL), 0.5 * D_MODEL ** -0.5),
        'b_ada': nrm(ks[11], (DEPTH, 3 * D_MODEL), 0.01),
        'w_in': nrm(ks[12], (DEPTH, D_MODEL, IN_W), D_MODEL ** -0.5),
        'q_norm_g': 1.0 + nrm(ks[13], (DEPTH, HEAD_DIM), 0.02),
        'k_norm_g': 1.0 + nrm(ks[14], (DEPTH, HEAD_DIM), 0.02),
        'sinks': nrm(ks[15], (DEPTH, N_HEADS), 0.5),
        'w_conv': nrm(ks[16], (DEPTH, CONV_W, RNN_W), CONV_W ** -0.5),
        'b_conv': nrm(ks[17], (DEPTH, RNN_W), 0.01),
        'w_rg_a': nrm(ks[18], (DEPTH, N_BLOCKS, BLOCK_W, BLOCK_W), BLOCK_W ** -0.5),
        'b_rg_a': nrm(ks[19], (DEPTH, RNN_W), 0.01),
        'w_rg_x': nrm(ks[20], (DEPTH, N_BLOCKS, BLOCK_W, BLOCK_W), BLOCK_W ** -0.5),
        'b_rg_x': nrm(ks[21], (DEPTH, RNN_W), 0.01),
        'lru_lambda': lam,
        'w_proj_attn': nrm(ks[23], (DEPTH, Q_W, D_MODEL), Q_W ** -0.5),
        'w_proj_rnn': nrm(ks[24], (DEPTH, RNN_W, D_MODEL), RNN_W ** -0.5),
        'w_out': nrm(ks[25], (DEPTH, D_MODEL, D_MODEL), D_MODEL ** -0.5),
    }


def reference(x_prompt, x_sample, cache_k, cache_v, state_conv, state_h, c_prompt, c_sample,
              rel_table, norm_g, w_ada, b_ada, w_in, q_norm_g, k_norm_g, sinks, w_conv, b_conv,
              w_rg_a, b_rg_a, w_rg_x, b_rg_x, lru_lambda, w_proj_attn, w_proj_rnn, w_out):
    y_p, y_s = x_prompt, x_sample
    kp_l, vp_l, cp_l, hp_l = [], [], [], []
    ks_l, vs_l, cs_l, hs_l = [], [], [], []
    for l in range(DEPTH):
        w = (norm_g[l], w_ada[l], b_ada[l], w_in[l], q_norm_g[l], k_norm_g[l], sinks[l],
             w_conv[l], b_conv[l], w_rg_a[l], b_rg_a[l], w_rg_x[l], b_rg_x[l], lru_lambda[l],
             w_proj_attn[l], w_proj_rnn[l], w_out[l])
        y_p, kp, vp, cp, hp = _layer(y_p, c_prompt, None, None, None, None, rel_table, w, True)
        y_s, kk, vv, cc, hh = _layer(y_s, c_sample, cache_k[l], cache_v[l], state_conv[l],
                                     state_h[l], rel_table, w, False)
        kp_l.append(kp); vp_l.append(vp); cp_l.append(cp); hp_l.append(hp)
        ks_l.append(kk); vs_l.append(vv); cs_l.append(cc); hs_l.append(hh)
    k_win_prompt = jnp.stack(kp_l)
    v_win_prompt = jnp.stack(vp_l)
    conv_prompt = jnp.stack(cp_l)
    h_prompt = jnp.stack(hp_l)
    k_win_sample = jnp.stack(ks_l)
    v_win_sample = jnp.stack(vs_l)
    conv_sample = jnp.stack(cs_l)
    h_sample = jnp.stack(hs_l)
    return (y_p, y_s, k_win_prompt, v_win_prompt, conv_prompt, h_prompt,
            k_win_sample, v_win_sample, conv_sample, h_sample)
```

```cpp
#include <hip/hip_runtime.h>
#include <cstdio>
#include <cstdint>

namespace pg8 {
#define PG8_LAS __attribute__((address_space(3)))
typedef unsigned short bf16_t;
typedef short bf16x8 __attribute__((ext_vector_type(8)));
typedef float f32x4 __attribute__((ext_vector_type(4)));
typedef unsigned u32x4 __attribute__((ext_vector_type(4)));
constexpr int BM = 256, BK = 64, HALF = 128, HTB = HALF * BK * 2, STAGE_BYTES = 8 * HTB, NXCD = 8, WGM = 8;

__host__ __device__ __forceinline__ int lds_byte(int r, int c) { const int st = (r >> 4) * 2 + (c >> 5), rr = r & 15, cc = c & 31, ob = rr * 64 + cc * 2; return st * 1024 + (ob ^ (((ob >> 9) & 1) << 5)); }
__host__ __device__ __forceinline__ void stage_rc(int b, int& R, int& C) { const int st = b / 1024, sb = b % 1024, swz = sb ^ (((sb >> 9) & 1) << 5); R = (st >> 1) * 16 + swz / 64; C = (st & 1) * 32 + (swz % 64) / 2; }
__host__ __device__ __forceinline__ int perm32(int rho) { const int n = rho >> 4, i = rho & 15; return 8 * (i >> 2) + 4 * n + (i & 3); }

struct Unit { int pm, pn; };
struct Gemm { const bf16_t* A; const bf16_t* Bt; int M, N, K; const bf16_t* A2; int lda; };

struct StaticOrder {
    int nM, nN, nwg, G, c;
    __host__ __device__ void init(int M, int N, int G_, int c_) { nM = M / BM; nN = N / BM; nwg = nM * nN; G = G_; c = c_; }
    __host__ __device__ bool next(int i, Unit& u) const {
        const long L = (long)i * G + c; if (L >= nwg) return false;
        int wgid = (int)L; { const int q = nwg / NXCD, r = nwg % NXCD, xcd = wgid % NXCD, off = wgid / NXCD; wgid = (xcd < r ? xcd * (q + 1) : r * (q + 1) + (xcd - r) * q) + off; }
        const int nig = WGM * nN, gid = wgid / nig, fm = gid * WGM, gsz = (nM - fm) < WGM ? (nM - fm) : WGM;
        u.pm = fm + ((wgid % nig) % gsz); u.pn = (wgid % nig) / gsz; return true;
    }
    __device__ __forceinline__ void a_ready(const Unit&) const {}
    __device__ __forceinline__ void done(const Unit&) const {}
};

typedef float f32x2_t __attribute__((ext_vector_type(2))); typedef __bf16 bf16x2_t __attribute__((ext_vector_type(2)));
__device__ __forceinline__ unsigned cvt_pk_bf16(float lo, float hi) { f32x2_t v = {lo, hi}; bf16x2_t b = __builtin_convertvector(v, bf16x2_t); return __builtin_bit_cast(unsigned, b); }

template <class Epi, class Sched, bool ALIGN_EPI = false, bool SP2 = false>
__device__ __forceinline__ void gemm_phase(PG8_LAS unsigned char* lds, const Gemm g, const Sched& S, const Epi& E) {
    int tid_ = threadIdx.x; asm volatile("" : "+v"(tid_));
    const int tid = tid_, wid = __builtin_amdgcn_readfirstlane(tid >> 6), lane = tid & 63, wr = wid >> 2, wc = wid & 3, fr = lane & 15, fq = lane >> 4;
    const int K = g.K, nt = K / BK;
    unsigned voffA[2], voffB[2];
#pragma unroll
    for (int i = 0; i < 2; ++i) { int R, C; stage_rc(tid * 16 + i * 8192, R, C); const int Rb = Epi::PERM ? ((R & ~31) + perm32(R & 31)) : R;
        voffA[i] = (unsigned)(R * g.lda + C) * 2u; voffB[i] = (unsigned)(Rb * K + C) * 2u; }
    const size_t kstep = (size_t)(BK * 2);
    const size_t hstep = (size_t)HALF * K * 2;
    const size_t tstep = 2 * hstep;
    const size_t hstepA = (size_t)HALF * g.lda * 2, tstepA = 2 * hstepA;
    const int nh = g.A2 ? nt / 2 : nt + 4;
    const long a2delta = g.A2 ? ((const char*)g.A2 - (const char*)g.A) - (long)nh * (long)kstep : 0;
    const unsigned ldsw = (unsigned)wid * 1024u;
    const int aoff = lds_byte(wr * 64 + fr, fq * 8), boff = lds_byte(wc * 32 + fr, fq * 8);
#define PG8_SA(b, h) (((b) * 2 + (h)) * HTB)
#define PG8_SB(b, h) ((4 + (b) * 2 + (h)) * HTB)
#define PG8_STAGE(bufoff, gbase, voff) do { _Pragma("unroll") for (int _i = 0; _i < 2; ++_i) \
        __builtin_amdgcn_global_load_lds((const unsigned*)((const char*)(gbase) + (voff)[_i]), (PG8_LAS unsigned*)(lds + (bufoff) + ldsw + _i * 8192), 16, 0, 0); } while (0)
#define PG8_LDA(dst, b, h) do { _Pragma("unroll") for (int m = 0; m < 4; ++m) _Pragma("unroll") for (int k = 0; k < 2; ++k) dst[m][k] = *(const PG8_LAS bf16x8*)(lds + PG8_SA(b, h) + aoff + m * 2048 + k * 1024); } while (0)
#define PG8_LDB(dst, b, h) do { _Pragma("unroll") for (int n = 0; n < 2; ++n) _Pragma("unroll") for (int k = 0; k < 2; ++k) dst[n][k] = *(const PG8_LAS bf16x8*)(lds + PG8_SB(b, h) + boff + n * 2048 + k * 1024); } while (0)
#define PG8_MMA(ai, bj, At, Bt) do { __builtin_amdgcn_s_setprio(1); _Pragma("unroll") for (int m = 0; m < 4; ++m) _Pragma("unroll") for (int n = 0; n < 2; ++n) _Pragma("unroll") for (int k = 0; k < 2; ++k) \
        acc[ai][bj][m][n] = __builtin_amdgcn_mfma_f32_16x16x32_bf16(Bt[n][k], At[m][k], acc[ai][bj][m][n], 0, 0, 0); __builtin_amdgcn_s_setprio(0); } while (0)
#define PG8_WAIT_V(n) asm volatile("s_waitcnt vmcnt(" #n ")" ::: "memory")
#define PG8_WAIT_L(n) asm volatile("s_waitcnt lgkmcnt(" #n ")" ::: "memory")
#define PG8_BAR __builtin_amdgcn_s_barrier()
#define PG8_SCHED __builtin_amdgcn_sched_barrier(0)
    Unit cur, nxt; int ui = 0;
    if (!S.next(0, cur)) return;
    f32x4 acc[2][2][4][2];
#pragma unroll
    for (int a = 0; a < 2; ++a)
#pragma unroll
        for (int b = 0; b < 2; ++b)
#pragma unroll
            for (int m = 0; m < 4; ++m)
#pragma unroll
                for (int n = 0; n < 2; ++n) acc[a][b][m][n] = (f32x4){0.f, 0.f, 0.f, 0.f};
    bf16x8 At[4][2], B0[2][2], B1[2][2];
    const char* cA = (const char*)g.A + (size_t)cur.pm * tstepA; const char* cB = (const char*)g.Bt + (size_t)cur.pn * tstep;
    S.a_ready(cur);
    if constexpr (SP2) {
        PG8_STAGE(PG8_SB(0, 0), cB, voffB); PG8_STAGE(PG8_SB(0, 1), cB + hstep, voffB); PG8_STAGE(PG8_SA(0, 0), cA, voffA); PG8_STAGE(PG8_SA(0, 1), cA + hstepA, voffA);
        if (wr == 1) PG8_BAR;
        PG8_WAIT_V(2); PG8_BAR;
        PG8_STAGE(PG8_SB(1, 0), cB + kstep, voffB); PG8_STAGE(PG8_SA(1, 0), cA + kstep, voffA); PG8_STAGE(PG8_SB(1, 1), cB + hstep + kstep, voffB);
        PG8_WAIT_V(6); PG8_BAR;
    } else {
        PG8_STAGE(PG8_SB(0, 0), cB, voffB); PG8_STAGE(PG8_SA(0, 0), cA, voffA); PG8_STAGE(PG8_SB(0, 1), cB + hstep, voffB); PG8_STAGE(PG8_SA(0, 1), cA + hstepA, voffA);
        if (wr == 1) PG8_BAR;
        PG8_WAIT_V(4); PG8_BAR;
        PG8_STAGE(PG8_SB(1, 0), cB + kstep, voffB); PG8_STAGE(PG8_SA(1, 0), cA + kstep, voffA); PG8_STAGE(PG8_SB(1, 1), cB + hstep + kstep, voffB);
        PG8_WAIT_V(6); PG8_BAR;
    }
    for (;;) {
        const bool has_next = S.next(ui + 1, nxt);
        const char* nA = has_next ? (const char*)g.A + (size_t)nxt.pm * tstepA : cA; const char* nB = has_next ? (const char*)g.Bt + (size_t)nxt.pn * tstep : cB;
        for (int t = 0; t < nt; t += 2) {
            if constexpr (Epi::HAS_MID) { if (t == nt / 2) E.mid(acc, cur, wr, wc, fr, fq); }
            const bool last = (t == nt - 2);
            const char* a1 = cA + (t >= nh ? a2delta : 0) + (size_t)(t + 1) * kstep;
            const char* a2 = last ? nA : cA + (t + 2 >= nh ? a2delta : 0) + (size_t)(t + 2) * kstep; const char* b2 = last ? nB : cB + (size_t)(t + 2) * kstep;
            const char* a3 = a2 + kstep; const char* b3 = b2 + kstep;
            if (last && has_next) S.a_ready(nxt);
            if constexpr (SP2) {
            PG8_LDB(B0, 0, 0); PG8_LDB(B1, 0, 1); PG8_SCHED; PG8_LDA(At, 0, 0); PG8_STAGE(PG8_SA(1, 1), a1 + hstepA, voffA);
            PG8_WAIT_V(8); PG8_WAIT_L(0); PG8_BAR; PG8_MMA(0, 0, At, B0); PG8_MMA(0, 1, At, B1); PG8_BAR; PG8_SCHED;
            PG8_LDA(At, 0, 1); PG8_STAGE(PG8_SB(0, 0), b2, voffB); PG8_STAGE(PG8_SB(0, 1), b2 + hstep, voffB); PG8_STAGE(PG8_SA(0, 0), a2, voffA);
            PG8_WAIT_V(8); PG8_WAIT_L(0); PG8_BAR; PG8_MMA(1, 0, At, B0); PG8_MMA(1, 1, At, B1); PG8_BAR; PG8_SCHED;
            PG8_LDB(B0, 1, 0); PG8_LDB(B1, 1, 1); PG8_SCHED; PG8_LDA(At, 1, 0); PG8_STAGE(PG8_SA(0, 1), a2 + hstepA, voffA);
            PG8_WAIT_V(8); PG8_WAIT_L(0); PG8_BAR; PG8_MMA(0, 0, At, B0); PG8_MMA(0, 1, At, B1); PG8_BAR; PG8_SCHED;
            PG8_LDA(At, 1, 1); PG8_STAGE(PG8_SB(1, 0), b3, voffB); PG8_STAGE(PG8_SB(1, 1), b3 + hstep, voffB); PG8_STAGE(PG8_SA(1, 0), a3, voffA);
            PG8_WAIT_V(8); PG8_WAIT_L(0); PG8_BAR; PG8_MMA(1, 0, At, B0); PG8_MMA(1, 1, At, B1); PG8_BAR; PG8_SCHED;
            } else {
            PG8_LDB(B0, 0, 0); PG8_SCHED; PG8_LDA(At, 0, 0); PG8_STAGE(PG8_SA(1, 1), a1 + hstepA, voffA);
            PG8_WAIT_L(8); PG8_BAR; PG8_WAIT_L(0); PG8_MMA(0, 0, At, B0); PG8_BAR; PG8_SCHED;
            PG8_LDB(B1, 0, 1); PG8_STAGE(PG8_SB(0, 0), b2, voffB);
            PG8_BAR; PG8_WAIT_L(0); PG8_MMA(0, 1, At, B1); PG8_BAR;
            PG8_LDA(At, 0, 1); PG8_STAGE(PG8_SA(0, 0), a2, voffA);
            PG8_BAR; PG8_WAIT_L(0); PG8_MMA(1, 0, At, B0); PG8_BAR; PG8_SCHED;
            PG8_STAGE(PG8_SB(0, 1), b2 + hstep, voffB);
            PG8_WAIT_V(6); PG8_BAR; PG8_MMA(1, 1, At, B1); PG8_BAR;
            PG8_LDB(B0, 1, 0); PG8_SCHED; PG8_LDA(At, 1, 0); PG8_STAGE(PG8_SA(0, 1), a2 + hstepA, voffA);
            PG8_WAIT_L(8); PG8_BAR; PG8_WAIT_L(0); PG8_MMA(0, 0, At, B0); PG8_BAR; PG8_SCHED;
            PG8_LDB(B1, 1, 1); PG8_STAGE(PG8_SB(1, 0), b3, voffB);
            PG8_BAR; PG8_WAIT_L(0); PG8_MMA(0, 1, At, B1); PG8_BAR;
            PG8_LDA(At, 1, 1); PG8_STAGE(PG8_SA(1, 0), a3, voffA);
            PG8_BAR; PG8_WAIT_L(0); PG8_MMA(1, 0, At, B0); PG8_BAR; PG8_SCHED;
            PG8_STAGE(PG8_SB(1, 1), b3 + hstep, voffB);
            PG8_WAIT_V(6); PG8_BAR; PG8_MMA(1, 1, At, B1); PG8_BAR;
            }
        }
        if constexpr (ALIGN_EPI) { if (wr == 0) PG8_BAR; }
        E(acc, cur, wr, wc, fr, fq); S.done(cur);
        if (!has_next) break;
#pragma unroll
        for (int a = 0; a < 2; ++a)
#pragma unroll
            for (int b = 0; b < 2; ++b)
#pragma unroll
                for (int m = 0; m < 4; ++m)
#pragma unroll
                    for (int n = 0; n < 2; ++n) acc[a][b][m][n] = (f32x4){0.f, 0.f, 0.f, 0.f};
        cur = nxt; cA = nA; cB = nB; ++ui;
        if constexpr (ALIGN_EPI) { if (wr == 1) PG8_BAR; }
    }
    PG8_WAIT_V(0);
    if constexpr (!ALIGN_EPI) { if (wr == 0) PG8_BAR; }
    PG8_BAR;
#undef PG8_SA
#undef PG8_SB
#undef PG8_STAGE
#undef PG8_LDA
#undef PG8_LDB
#undef PG8_MMA
#undef PG8_WAIT_V
#undef PG8_WAIT_L
#undef PG8_BAR
#undef PG8_SCHED
}
}

constexpr int NWAVES = 8;
constexpr int DM = 1024, NB = 4, SEQ = 4096, NS = 128, WIN = 128;
constexpr int MP = NB * SEQ;
constexpr int MALL = MP + NS;
constexpr int MPAD = 16640;
constexpr int INW = 6656;
constexpr int NCH = 32;
constexpr float EPSN = 1e-6f;
constexpr float LOG2E = 1.4426950408889634f;
constexpr float QSCALE = 0.125f * LOG2E;

constexpr size_t MiB = 1u << 20;
constexpr size_t WS_CTL = 0, CTL_ZERO_BYTES = 64 * 1024;
constexpr size_t WS_MOD = 1 * MiB;
constexpr size_t WS_WRA = 3 * MiB;
constexpr size_t WS_WRX = 3 * MiB + 128 * 1024;
constexpr size_t WS_KVNEW = 3 * MiB + 256 * 1024;
constexpr size_t WS_AGG = 4 * MiB;
constexpr size_t WS_LBA = 4 * MiB;
constexpr size_t WS_LBH = 3 * MiB + 512 * 1024;
constexpr size_t WS_WIN = 5 * MiB;
constexpr size_t WS_WPP = 18 * MiB;
constexpr size_t WS_WOUT = 22 * MiB;
constexpr size_t WS_XN = 24 * MiB;
constexpr size_t ACT = (size_t)MPAD * DM * 2;
constexpr size_t WS_K = WS_XN + ACT;
constexpr size_t WS_V = WS_K + ACT / 4;
constexpr size_t WS_SGA = WS_V + ACT / 4;
constexpr size_t WS_XR = WS_SGA + ACT;
constexpr size_t WS_SGR = WS_XR + ACT;
constexpr size_t WS_RAT = WS_SGR + ACT;
constexpr size_t WS_SMR = WS_RAT + ACT;
constexpr size_t WS_QT = WS_SMR + ACT;
constexpr size_t WS_YT = WS_QT + 512 * 1024;
constexpr size_t WS_MGT = WS_YT + 512 * 1024;
constexpr size_t WS_END = WS_MGT + 256 * 1024;
static_assert(WS_END <= 256 * MiB, "d_ws map");
constexpr size_t O_YP = 0, O_YS = 16777216, O_KWP = 16908288, O_VWP = 17039360, O_CVP = 17170432, O_HP = 17182720,
                 O_KWS = 17186816, O_VWS = 21381120, O_CVS = 25575424, O_HS = 25968640, O_END = 26099712;
constexpr size_t QM_OFF = (size_t)MP * DM;

constexpr int CW_BAR = 1024, CW_MODC = 64, CW_S1C = 128, CW_TQ = 192;

constexpr int RING_BYTES = 131072;
constexpr int GW_OFF = RING_BYTES, GW_STRIDE = 144, GW_BYTES = 2 * 64 * GW_STRIDE;
constexpr int BT_OFF = GW_OFF + GW_BYTES, BT_BYTES = 16 * 128 * 4;
constexpr int LDSCTL_OFF = BT_OFF + BT_BYTES, MISC_OFF = LDSCTL_OFF + 320;
constexpr int LDS_BYTES = LDSCTL_OFF + 512;

#define GAS __attribute__((address_space(1)))
#define LAS __attribute__((address_space(3)))
typedef unsigned short bf16;
typedef unsigned v4u __attribute__((ext_vector_type(4)));
typedef unsigned v2u __attribute__((ext_vector_type(2)));
typedef float f32x4 __attribute__((ext_vector_type(4)));
typedef float f32x16 __attribute__((ext_vector_type(16)));
typedef short bf16x8 __attribute__((ext_vector_type(8)));
typedef short s16x4 __attribute__((ext_vector_type(4)));
typedef GAS unsigned gu32;
#define RLX_AGENT __ATOMIC_RELAXED, __HIP_MEMORY_SCOPE_AGENT
#define LDS_WAIT() asm volatile("s_waitcnt lgkmcnt(0)" ::: "memory")
#define VM_WAIT() asm volatile("s_waitcnt vmcnt(0)" ::: "memory")
__device__ __forceinline__ unsigned f2bf(float f) { unsigned u = __builtin_bit_cast(unsigned, f); return (u + 0x7fffu + ((u >> 16) & 1u)) >> 16; }
__device__ __forceinline__ unsigned pk2(float lo, float hi) { return f2bf(lo) | (f2bf(hi) << 16); }
__device__ __forceinline__ float bf2f(unsigned b) { return __uint_as_float(b << 16); }
__device__ __forceinline__ float bflo(unsigned w) { return __uint_as_float(w << 16); }
__device__ __forceinline__ float bfhi(unsigned w) { return __uint_as_float(w & 0xffff0000u); }
__device__ __forceinline__ unsigned pk_u8x4(float a, float b, float c, float d) {
    unsigned r = __builtin_amdgcn_cvt_pk_u8_f32(fmaxf(a * 255.0f, 1.0f), 0, 0u); r = __builtin_amdgcn_cvt_pk_u8_f32(fmaxf(b * 255.0f, 1.0f), 1, r);
    r = __builtin_amdgcn_cvt_pk_u8_f32(fmaxf(c * 255.0f, 1.0f), 2, r); return __builtin_amdgcn_cvt_pk_u8_f32(fmaxf(d * 255.0f, 1.0f), 3, r); }
__device__ __forceinline__ float u8f(unsigned w, int i) { return (float)((w >> (8 * i)) & 0xffu); }
__device__ __forceinline__ float fexp2(float x) { return __builtin_amdgcn_exp2f(x); }
__device__ __forceinline__ float frcp(float x) { return __builtin_amdgcn_rcpf(x); }
__device__ __forceinline__ float sigm(float x) { return frcp(1.0f + fexp2(-LOG2E * x)); }

#define XB_TMO      128
#define XB_XCNT(j)  (256  + 64 * (j))
#define XB_XSUB(j)  (1280 + 64 * (j))
#define XB_XGEN(j)  (2304 + 64 * (j))
#define XB_TOP      3328
#define XB_TOPGEN   3392
#define XCD_BAR_WORDS 3456
#define XB_SPIN_CAP (1u << 22)
__device__ __forceinline__ unsigned xb_ld(unsigned* p)              { return __hip_atomic_load(p, __ATOMIC_RELAXED, __HIP_MEMORY_SCOPE_AGENT); }
__device__ __forceinline__ unsigned xb_add(unsigned* p, unsigned v) { return __hip_atomic_fetch_add(p, v, __ATOMIC_RELAXED, __HIP_MEMORY_SCOPE_AGENT); }
__device__ __forceinline__ unsigned xb_xcc_id() { return (unsigned)__builtin_amdgcn_s_getreg((3 << 11) | 20) & 0xFu; }
#define XB_SPIN(cond, bar) do { unsigned _sp = 0; while (cond) { __builtin_amdgcn_s_sleep(1); \
    if ((++_sp & 255u) == 0u) { if (xb_ld(&(bar)[XB_TMO])) break; if (_sp > XB_SPIN_CAP) { atomicAdd(&(bar)[XB_TMO], 1u); break; } } } } while (0)
struct XcdBarrier { unsigned* bar; unsigned x; volatile LAS unsigned* st; };
__device__ __forceinline__ XcdBarrier xcd_barrier_post(unsigned* bar, volatile LAS unsigned* st) {
    XcdBarrier b; b.bar = bar; b.x = xb_xcc_id(); b.st = st;
    if (threadIdx.x == 0) (void)xb_add(&bar[XB_XCNT(b.x)], 1u);
    return b;
}
__device__ __forceinline__ void xcd_barrier_complete(unsigned* bar, unsigned x, unsigned& nloc, unsigned& nx) {
    const unsigned G = gridDim.x * gridDim.y * gridDim.z;
    unsigned sum, cnt, mine, sp = 0u;
    for (;;) {
        sum = 0u; cnt = 0u; mine = 0u;
#pragma unroll
        for (unsigned j = 0; j < 16; ++j) { const unsigned c = xb_ld(&bar[XB_XCNT(j)]); sum += c; cnt += (c > 0u) ? 1u : 0u; mine = (j == x) ? c : mine; }
        if (sum == G) break;
        __builtin_amdgcn_s_sleep(1);
        if ((++sp & 255u) == 0u) { if (xb_ld(&bar[XB_TMO])) break; if (sp > XB_SPIN_CAP) { atomicAdd(&bar[XB_TMO], 1u); break; } }
    }
    nloc = mine > 0u ? mine : 1u; nx = cnt > 0u ? cnt : 1u;
}
__device__ __forceinline__ void xcd_barrier(const XcdBarrier& b) {
    asm volatile("s_waitcnt vmcnt(0)" ::: "memory");
    __syncthreads();
    if (threadIdx.x == 0) {
        unsigned* bar = b.bar;
        __builtin_amdgcn_s_waitcnt(0);
        unsigned nloc = b.st[0], nx = b.st[1];
        if (nloc == 0u) { xcd_barrier_complete(bar, b.x, nloc, nx); b.st[0] = nloc; b.st[1] = nx; }
        const unsigned old = xb_add(&bar[XB_XSUB(b.x)], 1u);
        const unsigned gen = old / nloc;
        if (old + 1u == (gen + 1u) * nloc) {
            __builtin_amdgcn_fence(__ATOMIC_RELEASE, "agent");
            asm volatile("s_waitcnt vmcnt(0)" ::: "memory");
            const unsigned og = xb_add(&bar[XB_TOP], 1u);
            const unsigned tg = og / nx;
            if (og + 1u == (tg + 1u) * nx) xb_add(&bar[XB_TOPGEN], 1u);
            else XB_SPIN(xb_ld(&bar[XB_TOPGEN]) == tg, bar);
            __builtin_amdgcn_fence(__ATOMIC_ACQUIRE, "agent");
            xb_add(&bar[XB_XGEN(b.x)], 1u);
            asm volatile("s_waitcnt vmcnt(0)" ::: "memory");
        } else {
            XB_SPIN(xb_ld(&bar[XB_XGEN(b.x)]) == gen, bar);
            __builtin_amdgcn_fence(__ATOMIC_ACQUIRE, "agent");
            asm volatile("s_waitcnt vmcnt(0)" ::: "memory");
        }
    }
    __syncthreads();
}

__device__ __forceinline__ void soft_arrive(unsigned* cnt, unsigned v) {
    asm volatile("s_waitcnt vmcnt(0)" ::: "memory"); __syncthreads();
    if (threadIdx.x == 0) (void)__hip_atomic_fetch_add(cnt, v, __ATOMIC_RELAXED, __HIP_MEMORY_SCOPE_AGENT);
}
__device__ __forceinline__ void soft_wait(unsigned* cnt, unsigned need) {
    if (threadIdx.x == 0) {
        unsigned sp = 0;
        while (__hip_atomic_load(cnt, __ATOMIC_RELAXED, __HIP_MEMORY_SCOPE_AGENT) < need) { __builtin_amdgcn_s_sleep(2); if (++sp > (1u << 22)) break; }
        __builtin_amdgcn_fence(__ATOMIC_ACQUIRE, "agent");
        asm volatile("s_waitcnt vmcnt(0)" ::: "memory");
    }
    __syncthreads();
}
__device__ __forceinline__ void st_sc1(float* p, float v) { __hip_atomic_store((unsigned*)p, __float_as_uint(v), __ATOMIC_RELAXED, __HIP_MEMORY_SCOPE_AGENT); }
struct Args {
    const float* in[26];
    float* out; unsigned char* ws;
    int ph_lo, ph_hi;
};
enum { I_XP = 0, I_XS, I_CK, I_CV, I_SC, I_SH, I_CP, I_CS, I_REL, I_NG, I_WADA, I_BADA, I_WIN, I_QG, I_KG, I_SINK, I_WCONV, I_BCONV,
       I_WRA, I_BRA, I_WRX, I_BRX, I_LAM, I_WPA, I_WPR, I_WOUT };

struct Frame {
    LAS unsigned char* lds;
    int tid, lane, wave, G, vcu;
    const float* const* in;
    float* out; unsigned char* ws;
};

__device__ __forceinline__ void refresh(Frame& F) {
    int t = threadIdx.x; asm volatile("" : "+v"(t));
    F.tid = t; F.lane = t & 63; F.wave = __builtin_amdgcn_readfirstlane(t >> 6);
}
__device__ const unsigned char BUCKET[128] = {0, 1, 2, 3, 4, 5, 6, 7, 8, 9, 10, 11, 12, 13, 14, 15, 16, 16, 16, 17, 17, 18, 18, 18, 19, 19, 19, 20, 20, 20, 20, 21, 21, 21, 21, 22, 22, 22, 22, 22, 23, 23, 23, 23, 23, 23, 24, 24, 24, 24, 24, 24, 25, 25, 25, 25, 25, 25, 25, 26, 26, 26, 26, 26, 26, 26, 26, 27, 27, 27, 27, 27, 27, 27, 27, 27, 27, 28, 28, 28, 28, 28, 28, 28, 28, 28, 28, 29, 29, 29, 29, 29, 29, 29, 29, 29, 29, 29, 29, 30, 30, 30, 30, 30, 30, 30, 30, 30, 30, 30, 30, 30, 30, 31, 31, 31, 31, 31, 31, 31, 31, 31, 31, 31, 31, 31, 31, 31};

__device__ __forceinline__ void transpose_block(const float* W, int N, int k0, int n0, bf16* WT, int ldk, int drow0, int kofs, LAS float* scr, int lane) {
    f32x4 wv[8];
#pragma unroll
    for (int i = 0; i < 8; ++i) wv[i] = *(const f32x4*)(W + (size_t)(k0 + 8 * i + (lane >> 3)) * N + n0 + 4 * (lane & 7));
#pragma unroll
    for (int i = 0; i < 8; ++i) { LAS float* d = scr + (8 * i + (lane >> 3)) * 33 + 4 * (lane & 7); d[0] = wv[i][0]; d[1] = wv[i][1]; d[2] = wv[i][2]; d[3] = wv[i][3]; }
    LDS_WAIT(); asm volatile("" ::: "memory");
    const int c = lane & 7;
#pragma unroll
    for (int j = 0; j < 4; ++j) { const int n = (lane >> 3) + 8 * j; const LAS float* s = scr + (8 * c) * 33 + n;
        v4u o; o.x = pk2(s[0 * 33], s[1 * 33]); o.y = pk2(s[2 * 33], s[3 * 33]); o.z = pk2(s[4 * 33], s[5 * 33]); o.w = pk2(s[6 * 33], s[7 * 33]);
        *(GAS v4u*)(WT + (size_t)(drow0 + n) * ldk + kofs + k0 + 8 * c) = o; }
    LDS_WAIT(); asm volatile("" ::: "memory");
}
__device__ __forceinline__ int win_row(int n0) {
    if (n0 < 1280) { const int t = n0 >> 8, w = n0 & 255; return (t << 8) + (((w >> 5) & 1) << 7) + ((w >> 6) << 5); }
    if (n0 < 4608) return n0;
    if (n0 < 5632) { const int i = n0 - 4608; return 4608 + ((i >> 7) << 8) + (i & 127); }
    { const int i = n0 - 5632; return 4608 + ((i >> 7) << 8) + 128 + (i & 127); }
}
__device__ __forceinline__ void p0_weights(Frame& F) {
    LAS float* scr = (LAS float*)(F.lds + F.wave * 16384);
    const int gw = F.vcu * NWAVES + F.wave, NGW = F.G * NWAVES;
    bf16* WIN_T = (bf16*)(F.ws + WS_WIN);
    for (int it = gw; it < 16 * 208; it += NGW) { const int kb = it / 208, nb = it % 208; transpose_block(F.in[I_WIN], INW, 64 * kb, 32 * nb, WIN_T, DM, win_row(32 * nb), 0, scr, F.lane); }
}
constexpr int TQ_TR = 200, TQ_ALL = 708;
__device__ __forceinline__ void tail_item(Frame& F, int it) {
    if (it < TQ_TR) {
        LAS float* scr = (LAS float*)(F.lds + F.wave * 16384);
        int r = 8 * it + F.wave;
        bf16* WPP = (bf16*)(F.ws + WS_WPP); bf16* WOUT_T = (bf16*)(F.ws + WS_WOUT);
        if (r < 512) { const int kb = r / 32, nb = r % 32; transpose_block(F.in[I_WPA], DM, 64 * kb, 32 * nb, WPP, 2048, 32 * nb, 0, scr, F.lane); return; } r -= 512;
        if (r < 512) { const int kb = r / 32, nb = r % 32; transpose_block(F.in[I_WPR], DM, 64 * kb, 32 * nb, WPP, 2048, 32 * nb, 1024, scr, F.lane); return; } r -= 512;
        if (r < 512) { const int kb = r / 32, nb = r % 32; transpose_block(F.in[I_WOUT], DM, 64 * kb, 32 * nb, WOUT_T, DM, 32 * nb, 0, scr, F.lane); return; } r -= 512;
        if (r < 32) { const int blk = r >> 1, nb = r & 1; transpose_block(F.in[I_WRA] + blk * 4096, 64, 0, 32 * nb, (bf16*)(F.ws + WS_WRA) + blk * 4096, 64, 32 * nb, 0, scr, F.lane); return; } r -= 32;
        { const int blk = r >> 1, nb = r & 1; transpose_block(F.in[I_WRX] + blk * 4096, 64, 0, 32 * nb, (bf16*)(F.ws + WS_WRX) + blk * 4096, 64, 32 * nb, 0, scr, F.lane); }
        return;
    }
    const int rbase = (it - TQ_TR) * 64 + 8 * F.wave;
    f32x4 v[8]; size_t dsto[8];
#pragma unroll
    for (int i = 0; i < 8; ++i) {
        const int rr = rbase + i, which = rr / 16256, r2 = rr % 16256, bs = r2 / 127, jj = r2 % 127;
        v[i] = ((const f32x4*)F.in[which ? I_CV : I_CK])[((size_t)bs * 128 + jj + 1) * 64 + F.lane];
        dsto[i] = (which ? O_VWS : O_KWS) / 4 + ((size_t)bs * 128 + jj) * 64 + F.lane;
    }
#pragma unroll
    for (int i = 0; i < 8; ++i) ((f32x4*)F.out)[dsto[i]] = v[i];
}

__device__ __forceinline__ void p0_mod_tile(Frame& F, int nt) {
    const float* wada = F.in[I_WADA]; const int lane = F.lane, w = F.wave;
    const int n0 = 16 * nt, kbase = 128 * w;
    f32x4 acc[9];
#pragma unroll
    for (int m = 0; m < 9; ++m) acc[m] = (f32x4){0.f, 0.f, 0.f, 0.f};
    for (int ks = 0; ks < 4; ++ks) {
        const int k0 = kbase + 32 * ks + 8 * (lane >> 4);
        float bv[8];
#pragma unroll
        for (int j = 0; j < 8; ++j) bv[j] = wada[(size_t)(k0 + j) * 3072 + n0 + (lane & 15)];
        v4u bw; bw.x = pk2(bv[0], bv[1]); bw.y = pk2(bv[2], bv[3]); bw.z = pk2(bv[4], bv[5]); bw.w = pk2(bv[6], bv[7]);
        const bf16x8 bfr = __builtin_bit_cast(bf16x8, bw);
#pragma unroll
        for (int m = 0; m < 9; ++m) {
            const int row = 16 * m + (lane & 15);
            v4u aw = (v4u){0u, 0u, 0u, 0u};
            if (row < 132) {
                const float* cr = (row < 4 ? F.in[I_CP] + row * 1024 : F.in[I_CS] + (row - 4) * 1024) + k0;
                const f32x4 a0 = *(const f32x4*)cr, a1 = *(const f32x4*)(cr + 4);
                aw.x = pk2(a0.x, a0.y); aw.y = pk2(a0.z, a0.w); aw.z = pk2(a1.x, a1.y); aw.w = pk2(a1.z, a1.w);
            }
            acc[m] = __builtin_amdgcn_mfma_f32_16x16x32_bf16(__builtin_bit_cast(bf16x8, aw), bfr, acc[m], 0, 0, 0);
        }
    }
    LAS float* part = (LAS float*)F.lds;
#pragma unroll
    for (int m = 0; m < 9; ++m)
#pragma unroll
        for (int r = 0; r < 4; ++r) part[(w * 144 + 16 * m + 4 * (lane >> 4) + r) * 16 + (lane & 15)] = acc[m][r];
    __syncthreads();
    float* mod = (float*)(F.ws + WS_MOD);
    for (int e = F.tid; e < 132 * 16; e += NWAVES * 64) {
        const int row = e >> 4, col = e & 15; float s = F.in[I_BADA][n0 + col];
#pragma unroll
        for (int ww = 0; ww < 8; ++ww) s += part[(ww * 144 + row) * 16 + col];
        st_sc1(&mod[(size_t)row * 3072 + n0 + col], s);
    }
    __syncthreads();
}
__device__ __forceinline__ float wave_sum(float v) {
#pragma unroll
    for (int o = 1; o < 64; o <<= 1) v += __shfl_xor(v, o);
    return v;
}
__device__ __forceinline__ const float* xn_src_row(Frame& F, int m) { return m < MP ? F.in[I_XP] + (size_t)m * DM : F.in[I_XS] + (size_t)(m - MP) * DM; }
__device__ __forceinline__ void p1_xn(Frame& F) {
    const int RPB = (MPAD + F.G - 1) / F.G, rbeg = F.vcu * RPB, rend = (rbeg + RPB < MPAD) ? rbeg + RPB : MPAD;
    const float* mod = (const float*)(F.ws + WS_MOD); bf16* XN = (bf16*)(F.ws + WS_XN);
    const f32x4* gp = (const f32x4*)F.in[I_NG] + F.lane;
    f32x4 gvec[4];
#pragma unroll
    for (int j = 0; j < 4; ++j) gvec[j] = gp[64 * j];
    f32x4 nx[4];
    if (rbeg + F.wave < MALL && rbeg + F.wave < rend) { const f32x4* xr = (const f32x4*)xn_src_row(F, rbeg + F.wave) + F.lane;
#pragma unroll
        for (int j = 0; j < 4; ++j) nx[j] = xr[64 * j]; }
    for (int m = rbeg + F.wave; m < rend; m += NWAVES) {
        GAS unsigned long long* o8 = (GAS unsigned long long*)(XN + (size_t)m * DM) + F.lane;
        if (m >= MALL) {
#pragma unroll
            for (int j = 0; j < 4; ++j) o8[64 * j] = 0ull;
            continue;
        }
        f32x4 v[4];
#pragma unroll
        for (int j = 0; j < 4; ++j) v[j] = nx[j];
        const int mn = m + NWAVES;
        if (mn < MALL && mn < rend) { const f32x4* xr = (const f32x4*)xn_src_row(F, mn) + F.lane;
#pragma unroll
            for (int j = 0; j < 4; ++j) nx[j] = xr[64 * j]; }
        const int mr = m < MP ? (m >> 12) : 4 + (m - MP);
        const f32x4* sh = (const f32x4*)(mod + (size_t)mr * 3072) + F.lane; const f32x4* sc = sh + 256;
        float s = 0.f;
#pragma unroll
        for (int j = 0; j < 4; ++j) s += (v[j].x * v[j].x + v[j].y * v[j].y) + (v[j].z * v[j].z + v[j].w * v[j].w);
        const float rstd = 1.0f / sqrtf(wave_sum(s) * (1.f / DM) + EPSN);
#pragma unroll
        for (int j = 0; j < 4; ++j) {
            const f32x4 a = sc[64 * j], b = sh[64 * j];
            const f32x4 y = v[j] * rstd * gvec[j] * (a + 1.0f) + b;
            o8[64 * j] = (unsigned long long)pk2(y.x, y.y) | ((unsigned long long)pk2(y.z, y.w) << 32);
        }
    }
}

struct EpiZ {
    static constexpr bool PERM = true, HAS_MID = false;
    unsigned char* ws; float* out; const float* qg; const float* kg;
    __device__ __forceinline__ void mid(pg8::f32x4 (&)[2][2][4][2], const pg8::Unit&, int, int, int, int) const {}
    __device__ __forceinline__ void operator()(const pg8::f32x4 (&acc)[2][2][4][2], const pg8::Unit& u, int wr, int wc, int fr, int fq) const {
        asm volatile("" : "+v"(fr), "+v"(fq));
        const int pn = u.pn, pm = u.pm;
        const int rloc = wr * 64 + fr;
        const size_t row0 = (size_t)pm * 256 + rloc;
        if (pn < 5) {
            const bool isq = pn < 4;
            const float* gsrc = (isq ? qg : kg) + 8 * fq;
            f32x4 gv[2][2];
#pragma unroll
            for (int bj = 0; bj < 2; ++bj)
#pragma unroll
                for (int n = 0; n < 2; ++n) gv[bj][n] = *(const f32x4*)(gsrc + 32 * bj + 4 * n);
            const float sc = isq ? QSCALE : 1.0f;
            bf16* dst; int ld, colb;
            if (isq) { dst = (pm < 64) ? (bf16*)(out + O_YP) + QM_OFF + row0 * DM : (bf16*)(ws + WS_QT) + (size_t)rloc * DM; ld = DM; colb = (4 * pn + wc) * 64 + 8 * fq; }
            else { dst = (bf16*)(ws + WS_K) + row0 * 256; ld = 256; colb = wc * 64 + 8 * fq; }
#pragma unroll
            for (int ai = 0; ai < 2; ++ai)
#pragma unroll
                for (int m = 0; m < 4; ++m) {
                    float ss = 0.f;
#pragma unroll
                    for (int bj = 0; bj < 2; ++bj)
#pragma unroll
                        for (int n = 0; n < 2; ++n) { const f32x4 x = acc[ai][bj][m][n]; ss += (x[0] * x[0] + x[1] * x[1]) + (x[2] * x[2] + x[3] * x[3]); }
                    ss += __shfl_xor(ss, 16); ss += __shfl_xor(ss, 32);
                    const float rs = sc / sqrtf(ss * (1.0f / 64.0f) + EPSN);
                    bf16* rp = dst + (size_t)(ai * 128 + m * 16) * ld + colb;
#pragma unroll
                    for (int bj = 0; bj < 2; ++bj) {
                        const f32x4 v0 = acc[ai][bj][m][0] * rs * gv[bj][0], v1 = acc[ai][bj][m][1] * rs * gv[bj][1];
                        v4u w; w.x = pg8::cvt_pk_bf16(v0[0], v0[1]); w.y = pg8::cvt_pk_bf16(v0[2], v0[3]); w.z = pg8::cvt_pk_bf16(v1[0], v1[1]); w.w = pg8::cvt_pk_bf16(v1[2], v1[3]);
                        *(v4u*)(rp + 32 * bj) = w;
                        if (!isq) {
                            float* so = nullptr;
                            if (pm < 64 && (pm & 15) == 15 && ai == 1) so = out + O_KWP + ((size_t)(pm >> 4) * 128 + (wr * 64 + m * 16 + fr)) * 256;
                            else if (pm == 64 && ai == 0) so = (float*)(ws + WS_KVNEW) + (size_t)(wr * 64 + m * 16 + fr) * 256;
                            if (so) { so += wc * 64 + 32 * bj + 8 * fq; *(f32x4*)so = v0; *(f32x4*)(so + 4) = v1; }
                        }
                    }
                }
            return;
        }
        if (pn == 5) {
            bf16* dst = (bf16*)(ws + WS_V) + row0 * 256 + 32 * wc + 8 * fq;
#pragma unroll
            for (int ai = 0; ai < 2; ++ai)
#pragma unroll
                for (int m = 0; m < 4; ++m)
#pragma unroll
                    for (int bj = 0; bj < 2; ++bj) {
                        const f32x4 v0 = acc[ai][bj][m][0], v1 = acc[ai][bj][m][1];
                        v4u w; w.x = pg8::cvt_pk_bf16(v0[0], v0[1]); w.y = pg8::cvt_pk_bf16(v0[2], v0[3]); w.z = pg8::cvt_pk_bf16(v1[0], v1[1]); w.w = pg8::cvt_pk_bf16(v1[2], v1[3]);
                        *(v4u*)(dst + (size_t)(ai * 128 + m * 16) * 256 + 128 * bj) = w;
                        float* so = nullptr;
                        if (pm < 64 && (pm & 15) == 15 && ai == 1) so = out + O_VWP + ((size_t)(pm >> 4) * 128 + (wr * 64 + m * 16 + fr)) * 256;
                        else if (pm == 64 && ai == 0) so = (float*)(ws + WS_KVNEW) + 128 * 256 + (size_t)(wr * 64 + m * 16 + fr) * 256;
                        if (so) { so += 128 * bj + 32 * wc + 8 * fq; *(f32x4*)so = v0; *(f32x4*)(so + 4) = v1; }
                    }
            return;
        }
        if (pn < 18) {
            const int seg = (pn - 6) >> 2;
            const int colt = ((pn - 6) & 3) * 256 + 32 * wc + 8 * fq;
            bf16* dst = (bf16*)(ws + (seg == 0 ? WS_SGA : seg == 1 ? WS_XR : WS_SGR)) + row0 * DM + colt;
#pragma unroll
            for (int ai = 0; ai < 2; ++ai)
#pragma unroll
                for (int m = 0; m < 4; ++m)
#pragma unroll
                    for (int bj = 0; bj < 2; ++bj) {
                        f32x4 v0 = acc[ai][bj][m][0], v1 = acc[ai][bj][m][1];
                        if (seg != 1) {
#pragma unroll
                            for (int e = 0; e < 4; ++e) { v0[e] = v0[e] * sigm(v0[e]); v1[e] = v1[e] * sigm(v1[e]); }
                        }
                        v4u w; w.x = pg8::cvt_pk_bf16(v0[0], v0[1]); w.y = pg8::cvt_pk_bf16(v0[2], v0[3]); w.z = pg8::cvt_pk_bf16(v1[0], v1[1]); w.w = pg8::cvt_pk_bf16(v1[2], v1[3]);
                        *(v4u*)(dst + (size_t)(ai * 128 + m * 16) * DM + 128 * bj) = w;
                        if (seg == 1 && pm < 64 && (pm & 15) == 15 && ai == 1 && wr == 1 && m == 3 && fr >= 13) {
                            float* so = out + O_CVP + ((size_t)(pm >> 4) * 3 + (fr - 13)) * DM + colt + 128 * bj;
                            *(f32x4*)so = v0; *(f32x4*)(so + 4) = v1;
                        }
                    }
            return;
        }
        {
            const int colt = (pn - 18) * 128 + 32 * wc + 8 * fq;
            unsigned char* da = ws + WS_RAT + row0 * DM + colt; unsigned char* ds = ws + WS_SMR + row0 * DM + colt;
#pragma unroll
            for (int ai = 0; ai < 2; ++ai)
#pragma unroll
                for (int m = 0; m < 4; ++m) {
                    float sa[8], sm[8];
#pragma unroll
                    for (int n = 0; n < 2; ++n)
#pragma unroll
                        for (int e = 0; e < 4; ++e) { sa[4 * n + e] = sigm(acc[ai][0][m][n][e]); sm[4 * n + e] = sigm(acc[ai][1][m][n][e]); }
                    v2u w; w.x = pk_u8x4(sa[0], sa[1], sa[2], sa[3]); w.y = pk_u8x4(sa[4], sa[5], sa[6], sa[7]);
                    *(v2u*)(da + (size_t)(ai * 128 + m * 16) * DM) = w;
                    w.x = pk_u8x4(sm[0], sm[1], sm[2], sm[3]); w.y = pk_u8x4(sm[4], sm[5], sm[6], sm[7]);
                    *(v2u*)(ds + (size_t)(ai * 128 + m * 16) * DM) = w;
                }
        }
    }
};

struct EpiMerge {
    static constexpr bool PERM = true, HAS_MID = true;
    const unsigned char* sma; const unsigned char* smr; bf16* mg;
    __device__ __forceinline__ void mid(pg8::f32x4 (&acc)[2][2][4][2], const pg8::Unit& u, int wr, int wc, int fr, int fq) const {
        asm volatile("" : "+v"(fr), "+v"(fq));
        const size_t off = ((size_t)u.pm * 256 + wr * 64 + fr) * DM + u.pn * 256 + 32 * wc + 8 * fq;
#pragma unroll
        for (int ai = 0; ai < 2; ++ai)
#pragma unroll
            for (int m = 0; m < 4; ++m)
#pragma unroll
                for (int bj = 0; bj < 2; ++bj) {
                    const size_t o = off + (size_t)(ai * 128 + m * 16) * DM + 128 * bj;
                    const v2u a = *(const v2u*)(sma + o), r = *(const v2u*)(smr + o);
                    acc[ai][bj][m][0] *= (pg8::f32x4){u8f(a.x, 0) * frcp(u8f(r.x, 0)), u8f(a.x, 1) * frcp(u8f(r.x, 1)), u8f(a.x, 2) * frcp(u8f(r.x, 2)), u8f(a.x, 3) * frcp(u8f(r.x, 3))};
                    acc[ai][bj][m][1] *= (pg8::f32x4){u8f(a.y, 0) * frcp(u8f(r.y, 0)), u8f(a.y, 1) * frcp(u8f(r.y, 1)), u8f(a.y, 2) * frcp(u8f(r.y, 2)), u8f(a.y, 3) * frcp(u8f(r.y, 3))};
                }
    }
    __device__ __forceinline__ void operator()(const pg8::f32x4 (&acc)[2][2][4][2], const pg8::Unit& u, int wr, int wc, int fr, int fq) const {
        asm volatile("" : "+v"(fr), "+v"(fq));
        const size_t off = ((size_t)u.pm * 256 + wr * 64 + fr) * DM + u.pn * 256 + 32 * wc + 8 * fq;
        const float i255 = 1.0f / 255.0f;
#pragma unroll
        for (int ai = 0; ai < 2; ++ai)
#pragma unroll
            for (int m = 0; m < 4; ++m)
#pragma unroll
                for (int bj = 0; bj < 2; ++bj) {
                    const size_t o = off + (size_t)(ai * 128 + m * 16) * DM + 128 * bj;
                    const v2u r = *(const v2u*)(smr + o);
                    const pg8::f32x4 v0 = acc[ai][bj][m][0] * ((pg8::f32x4){u8f(r.x, 0), u8f(r.x, 1), u8f(r.x, 2), u8f(r.x, 3)} * i255);
                    const pg8::f32x4 v1 = acc[ai][bj][m][1] * ((pg8::f32x4){u8f(r.y, 0), u8f(r.y, 1), u8f(r.y, 2), u8f(r.y, 3)} * i255);
                    v4u w; w.x = pg8::cvt_pk_bf16(v0[0], v0[1]); w.y = pg8::cvt_pk_bf16(v0[2], v0[3]); w.z = pg8::cvt_pk_bf16(v1[0], v1[1]); w.w = pg8::cvt_pk_bf16(v1[2], v1[3]);
                    *(v4u*)(mg + o) = w;
                }
    }
};
struct EpiOut {
    static constexpr bool PERM = false, HAS_MID = false;
    const float* x; const float* mod; float* y;
    __device__ __forceinline__ void mid(pg8::f32x4 (&)[2][2][4][2], const pg8::Unit&, int, int, int, int) const {}
    __device__ __forceinline__ void operator()(const pg8::f32x4 (&acc)[2][2][4][2], const pg8::Unit& u, int wr, int wc, int fr, int fq) const {
        asm volatile("" : "+v"(fr), "+v"(fq));
        const int col0 = u.pn * 256 + wc * 32 + 4 * fq;
        const float* gp = mod + (size_t)(u.pm >> 4) * 3072 + 2048 + col0;
        f32x4 gv[2][2];
#pragma unroll
        for (int bj = 0; bj < 2; ++bj)
#pragma unroll
            for (int n = 0; n < 2; ++n) gv[bj][n] = *(const f32x4*)(gp + 128 * bj + 16 * n);
#pragma unroll
        for (int ai = 0; ai < 2; ++ai)
#pragma unroll
            for (int m = 0; m < 4; ++m) {
                const size_t off = ((size_t)u.pm * 256 + ai * 128 + wr * 64 + m * 16 + fr) * DM + col0;
#pragma unroll
                for (int bj = 0; bj < 2; ++bj)
#pragma unroll
                    for (int n = 0; n < 2; ++n) {
                        const f32x4 xv = *(const f32x4*)(x + off + 128 * bj + 16 * n);
                        *(f32x4*)(y + off + 128 * bj + 16 * n) = xv + gv[bj][n] * acc[ai][bj][m][n];
                    }
            }
    }
};

template <int KQ  >
__device__ __forceinline__ f32x4 mini_partial(const bf16* A, const bf16* B) {
    bf16x8 a[KQ], b[KQ];
#pragma unroll
    for (int ks = 0; ks < KQ; ++ks) { a[ks] = *(const bf16x8*)(A + 32 * ks); b[ks] = *(const bf16x8*)(B + 32 * ks); }
    f32x4 acc = (f32x4){0.f, 0.f, 0.f, 0.f};
#pragma unroll
    for (int ks = 0; ks < KQ; ++ks) acc = __builtin_amdgcn_mfma_f32_16x16x32_bf16(a[ks], b[ks], acc, 0, 0, 0);
    return acc;
}
__device__ __forceinline__ void mini_merge_block(Frame& F, int pair) {
    const int lane = F.lane, w = F.wave, tile = 2 * pair + (w >> 2), kq = w & 3, rt = tile >> 6, ct = tile & 63;
    const bf16* A = (const bf16*)(F.ws + WS_YT) + (size_t)(16 * rt + (lane & 15)) * 2048 + 8 * (lane >> 4) + 512 * kq;
    const bf16* B = (const bf16*)(F.ws + WS_WPP) + (size_t)(16 * ct + (lane & 15)) * 2048 + 8 * (lane >> 4) + 512 * kq;
    const f32x4 acc = mini_partial<16>(A, B);
    LAS float* part = (LAS float*)F.lds;
#pragma unroll
    for (int r = 0; r < 4; ++r) part[w * 256 + (4 * (lane >> 4) + r) * 16 + (lane & 15)] = acc[r];
    __syncthreads();
    {
        const int t2 = F.tid >> 8, e = F.tid & 255, row = e >> 4, col = e & 15, tl = 2 * pair + t2, rl = 16 * (tl >> 6) + row, cg = 16 * (tl & 63) + col;
        const LAS float* p = part + t2 * 1024 + e;
        const float sa_ = (float)(F.ws + WS_RAT)[(size_t)(MP + rl) * DM + cg], sr_ = (float)(F.ws + WS_SMR)[(size_t)(MP + rl) * DM + cg];
        const float rat = sa_ / sr_, sm = sr_ * (1.0f / 255.0f);
        const float v = ((p[0] + p[256]) * rat + (p[512] + p[768])) * sm;
        ((bf16*)(F.ws + WS_MGT))[(size_t)rl * DM + cg] = (bf16)f2bf(v);
    }
    __syncthreads();
}
__device__ __forceinline__ void mini_out_block(Frame& F, int pair) {
    const int lane = F.lane, w = F.wave, tile = 2 * pair + (w >> 2), kq = w & 3, rt = tile >> 6, ct = tile & 63;
    const bf16* A = (const bf16*)(F.ws + WS_MGT) + (size_t)(16 * rt + (lane & 15)) * DM + 8 * (lane >> 4) + 256 * kq;
    const bf16* B = (const bf16*)(F.ws + WS_WOUT) + (size_t)(16 * ct + (lane & 15)) * DM + 8 * (lane >> 4) + 256 * kq;
    const f32x4 acc = mini_partial<8>(A, B);
    LAS float* part = (LAS float*)F.lds;
#pragma unroll
    for (int r = 0; r < 4; ++r) part[w * 256 + (4 * (lane >> 4) + r) * 16 + (lane & 15)] = acc[r];
    __syncthreads();
    {
        const int t2 = F.tid >> 8, e = F.tid & 255, row = e >> 4, col = e & 15, tl = 2 * pair + t2, rl = 16 * (tl >> 6) + row, cg = 16 * (tl & 63) + col;
        const LAS float* p = part + t2 * 1024 + e;
        const float* mod = (const float*)(F.ws + WS_MOD);
        F.out[O_YS + (size_t)rl * DM + cg] = F.in[I_XS][(size_t)rl * DM + cg] + mod[(size_t)(4 + rl) * 3072 + 2048 + cg] * ((p[0] + p[256]) + (p[512] + p[768]));
    }
    __syncthreads();
}

struct ChanConst { float w0, w1, w2, w3, bc, bra, brx, c1, nbra, nbrx; };
__device__ __forceinline__ ChanConst chan_const(Frame& F, int ch) {
    ChanConst c; const float* wc = F.in[I_WCONV];
    c.w0 = wc[ch]; c.w1 = wc[DM + ch]; c.w2 = wc[2 * DM + ch]; c.w3 = wc[3 * DM + ch]; c.bc = F.in[I_BCONV][ch];
    c.bra = F.in[I_BRA][ch]; c.brx = F.in[I_BRX][ch];
    c.c1 = -8.0f * log1pf(expf(-F.in[I_LAM][ch])) * LOG2E;
    c.nbra = -LOG2E * c.bra; c.nbrx = -LOG2E * c.brx;
    return c;
}
__device__ __forceinline__ void sample_rnn_unit(Frame& F, int bs, int j);
__device__ __forceinline__ void stage_gate_weights(Frame& F, int j) {
    for (int cidx = F.tid; cidx < 1024; cidx += NWAVES * 64) {
        const int gsel = cidx >> 9, row = (cidx >> 3) & 63, c8 = cidx & 7;
        const v4u v = *(const v4u*)((const bf16*)(F.ws + (gsel ? WS_WRX : WS_WRA)) + j * 4096 + row * 64 + 8 * c8);
        *(LAS v4u*)(F.lds + GW_OFF + (gsel * 64 + row) * GW_STRIDE + 16 * c8) = v;
    }
}
template <int PASS>
__device__ __forceinline__ void scan_unit(Frame& F, int b, int c, int j, LAS unsigned char* wl) {
    const int lane = F.lane, r32 = lane & 31, hi = lane >> 5, ch = 64 * j + lane;
    const ChanConst cc = chan_const(F, ch);
    const bf16* XR = (const bf16*)(F.ws + WS_XR); const bf16* SGR = (const bf16*)(F.ws + WS_SGR);
    float* agg = (float*)(F.ws + WS_AGG);
    bf16* YM = (bf16*)(F.out + O_YP);
    LAS bf16* xt = (LAS bf16*)wl; LAS bf16* st = (LAS bf16*)(wl + 4096); LAS float* gt = (LAS float*)(wl + 8192);
    const size_t rowb = (size_t)b * SEQ + 128 * c;
    const int lrow = lane >> 3, lc8 = lane & 7;
    const bf16* xsrc = XR + (rowb + lrow) * DM + 64 * j + 8 * lc8;
    const bf16* ssrc = SGR + (rowb + lrow) * DM + 64 * j + 8 * lc8;
    v4u xn[4], sn[4];
#pragma unroll
    for (int i = 0; i < 4; ++i) { xn[i] = *(const v4u*)(xsrc + (size_t)(8 * i) * DM); if (PASS == 2) sn[i] = *(const v4u*)(ssrc + (size_t)(8 * i) * DM); }
    float xm3 = 0.f, xm2 = 0.f, xm1 = 0.f;
    if (c > 0) { xm3 = bf2f(XR[(rowb - 3) * DM + ch]); xm2 = bf2f(XR[(rowb - 2) * DM + ch]); xm1 = bf2f(XR[(rowb - 1) * DM + ch]); }
    float h = 0.f, ap = 1.f;
    if (PASS == 2) {
        for (int q = 0; q < c; ++q) { const float a = agg[((size_t)(b * NCH + q) * 2 + 0) * DM + ch], hl = agg[((size_t)(b * NCH + q) * 2 + 1) * DM + ch]; h = a * h + hl; }
    }
    const LAS unsigned char* gwr = F.lds + GW_OFF + r32 * GW_STRIDE + 16 * hi;
    for (int sc = 0; sc < 4; ++sc) {
        const size_t r0 = rowb + 32 * sc;
#pragma unroll
        for (int i = 0; i < 4; ++i) { *(LAS v4u*)(xt + (lrow + 8 * i) * 64 + 8 * lc8) = xn[i]; if (PASS == 2) *(LAS v4u*)(st + (lrow + 8 * i) * 64 + 8 * lc8) = sn[i]; }
        if (sc < 3) {
#pragma unroll
            for (int i = 0; i < 4; ++i) { xn[i] = *(const v4u*)(xsrc + (size_t)(32 * (sc + 1) + 8 * i) * DM); if (PASS == 2) sn[i] = *(const v4u*)(ssrc + (size_t)(32 * (sc + 1) + 8 * i) * DM); }
        }
        LDS_WAIT(); asm volatile("" ::: "memory");
        float xc[32];
#pragma unroll
        for (int t = 0; t < 32; ++t) {
            const float x = bf2f(xt[t * 64 + lane]);
            xc[t] = cc.bc + cc.w0 * xm3 + cc.w1 * xm2 + cc.w2 * xm1 + cc.w3 * x;
            xm3 = xm2; xm2 = xm1; xm1 = x;
            xt[t * 64 + lane] = (bf16)pg8::cvt_pk_bf16(xc[t], 0.f);
        }
        LDS_WAIT(); asm volatile("" ::: "memory");
        bf16x8 af[4];
#pragma unroll
        for (int d0 = 0; d0 < 4; ++d0) af[d0] = *(const LAS bf16x8*)(xt + r32 * 64 + 16 * d0 + 8 * hi);
        float zr[32];
#pragma unroll
        for (int oh = 0; oh < 2; ++oh) {
            f32x16 d = {};
#pragma unroll
            for (int d0 = 0; d0 < 4; ++d0) d = __builtin_amdgcn_mfma_f32_32x32x16_bf16(af[d0], *(const LAS bf16x8*)(gwr + (32 * oh) * GW_STRIDE + 32 * d0), d, 0, 0, 0);
#pragma unroll
            for (int r = 0; r < 16; ++r) gt[((r & 3) + 8 * (r >> 2) + 4 * hi) * 64 + 32 * oh + r32] = d[r];
        }
        LDS_WAIT(); asm volatile("" ::: "memory");
#pragma unroll
        for (int t = 0; t < 32; ++t) zr[t] = gt[t * 64 + lane];
        LDS_WAIT(); asm volatile("" ::: "memory");
#pragma unroll
        for (int oh = 0; oh < 2; ++oh) {
            f32x16 d = {};
#pragma unroll
            for (int d0 = 0; d0 < 4; ++d0) d = __builtin_amdgcn_mfma_f32_32x32x16_bf16(af[d0], *(const LAS bf16x8*)(gwr + (64 + 32 * oh) * GW_STRIDE + 32 * d0), d, 0, 0, 0);
#pragma unroll
            for (int r = 0; r < 16; ++r) gt[((r & 3) + 8 * (r >> 2) + 4 * hi) * 64 + 32 * oh + r32] = d[r];
        }
        LDS_WAIT(); asm volatile("" ::: "memory");
#pragma unroll
        for (int t = 0; t < 32; ++t) {
            const float zi = gt[t * 64 + lane];
            const float rg = frcp(1.0f + fexp2(__builtin_fmaf(zr[t], -LOG2E, cc.nbra))), ig = frcp(1.0f + fexp2(__builtin_fmaf(zi, -LOG2E, cc.nbrx)));
            const float a = fexp2(cc.c1 * rg);
            const float s = __builtin_amdgcn_sqrtf(__builtin_fmaf(-a, a, 1.0f));
            const float uu = s * ig * xc[t];
            h = a * h + uu;
            if (PASS == 1) ap *= a;
            if (PASS == 2) st[t * 64 + lane] = (bf16)pg8::cvt_pk_bf16(h * bf2f(st[t * 64 + lane]), 0.f);
        }
        LDS_WAIT(); asm volatile("" ::: "memory");
        if (PASS == 2) {
#pragma unroll
            for (int i = 0; i < 4; ++i) *(v4u*)(YM + (r0 + lrow + 8 * i) * DM + 64 * j + 8 * lc8) = *(const LAS v4u*)(st + (lrow + 8 * i) * 64 + 8 * lc8);
            LDS_WAIT(); asm volatile("" ::: "memory");
        }
    }
    if (PASS == 1) { st_sc1(&agg[((size_t)(b * NCH + c) * 2 + 0) * DM + ch], ap); st_sc1(&agg[((size_t)(b * NCH + c) * 2 + 1) * DM + ch], h); }
    if (PASS == 2 && c == NCH - 1) F.out[O_HP + (size_t)b * DM + ch] = h;
}
typedef GAS unsigned long long gu64;
__device__ __forceinline__ void gr_store(unsigned long long* g, float v) { __hip_atomic_store(g, (1ull << 32) | (unsigned long long)__float_as_uint(v), __ATOMIC_RELAXED, __HIP_MEMORY_SCOPE_AGENT); }
__device__ __forceinline__ unsigned long long gr_load(unsigned long long* g) { return __hip_atomic_load(g, __ATOMIC_RELAXED, __HIP_MEMORY_SCOPE_AGENT); }
__device__ __forceinline__ void scan_lb_block(Frame& F, int bu) {
    const int j = bu & 15, ib = (bu >> 4) & 3, b = bu >> 6, w = F.wave, q = 8 * ib + w;
    stage_gate_weights(F, j);
    LDS_WAIT(); __syncthreads();
    sample_rnn_unit(F, (bu >> 4) * 8 + w, j);
    const int lane = F.lane, r32 = lane & 31, hi = lane >> 5, ch = 64 * j + lane;
    LAS unsigned char* wl = F.lds + w * 16384;
    const ChanConst cc = chan_const(F, ch);
    const bf16* XR = (const bf16*)(F.ws + WS_XR); const bf16* SGR = (const bf16*)(F.ws + WS_SGR);
    bf16* YM = (bf16*)(F.out + O_YP);
    LAS bf16* xt = (LAS bf16*)wl; LAS bf16* st = (LAS bf16*)(wl + 4096); LAS float* gt = (LAS float*)(wl + 8192);
    LAS float* xch = (LAS float*)(F.lds + BT_OFF);
    unsigned long long* lba = (unsigned long long*)(F.ws + WS_LBA) + ((size_t)(b * 16 + j) * 16) * 128 + lane;
    unsigned long long* lbh = (unsigned long long*)(F.ws + WS_LBH) + ((size_t)(b * 16 + j) * 4) * 64 + lane;
    const int lrow = lane >> 3, lc8 = lane & 7;
    const size_t row0 = (size_t)b * SEQ + 32 * q;
    const bf16* xsrc = XR + (row0 + lrow) * DM + 64 * j + 8 * lc8;
    const bf16* ssrc = SGR + (row0 + lrow) * DM + 64 * j + 8 * lc8;
    v4u xn[4], sn[4];
#pragma unroll
    for (int i = 0; i < 4; ++i) { xn[i] = *(const v4u*)(xsrc + (size_t)(8 * i) * DM); sn[i] = *(const v4u*)(ssrc + (size_t)(8 * i) * DM); }
    float hx3 = 0.f, hx2 = 0.f, hx1 = 0.f;
    if (q > 0) { hx3 = bf2f(XR[(row0 - 3) * DM + ch]); hx2 = bf2f(XR[(row0 - 2) * DM + ch]); hx1 = bf2f(XR[(row0 - 1) * DM + ch]); }
    const LAS unsigned char* gwr = F.lds + GW_OFF + r32 * GW_STRIDE + 16 * hi;
    for (int r = 0; r < 4; ++r) {
        const size_t r0 = row0 + 1024 * r;
#pragma unroll
        for (int i = 0; i < 4; ++i) { *(LAS v4u*)(xt + (lrow + 8 * i) * 64 + 8 * lc8) = xn[i]; *(LAS v4u*)(st + (lrow + 8 * i) * 64 + 8 * lc8) = sn[i]; }
        float xm3 = hx3, xm2 = hx2, xm1 = hx1;
        if (r < 3) {
#pragma unroll
            for (int i = 0; i < 4; ++i) { xn[i] = *(const v4u*)(xsrc + (size_t)(1024 * (r + 1) + 8 * i) * DM); sn[i] = *(const v4u*)(ssrc + (size_t)(1024 * (r + 1) + 8 * i) * DM); }
            hx3 = bf2f(XR[(r0 + 1024 - 3) * DM + ch]); hx2 = bf2f(XR[(r0 + 1024 - 2) * DM + ch]); hx1 = bf2f(XR[(r0 + 1024 - 1) * DM + ch]);
        }
        LDS_WAIT(); asm volatile("" ::: "memory");
        float xc[32];
#pragma unroll
        for (int t = 0; t < 32; ++t) {
            const float x = bf2f(xt[t * 64 + lane]);
            xc[t] = cc.bc + cc.w0 * xm3 + cc.w1 * xm2 + cc.w2 * xm1 + cc.w3 * x;
            xm3 = xm2; xm2 = xm1; xm1 = x;
            xt[t * 64 + lane] = (bf16)pg8::cvt_pk_bf16(xc[t], 0.f);
        }
        LDS_WAIT(); asm volatile("" ::: "memory");
        bf16x8 af[4];
#pragma unroll
        for (int d0 = 0; d0 < 4; ++d0) af[d0] = *(const LAS bf16x8*)(xt + r32 * 64 + 16 * d0 + 8 * hi);
        float av[32], uv[32];
#pragma unroll
        for (int oh = 0; oh < 2; ++oh) {
            f32x16 d = {};
#pragma unroll
            for (int d0 = 0; d0 < 4; ++d0) d = __builtin_amdgcn_mfma_f32_32x32x16_bf16(af[d0], *(const LAS bf16x8*)(gwr + (32 * oh) * GW_STRIDE + 32 * d0), d, 0, 0, 0);
#pragma unroll
            for (int g4 = 0; g4 < 4; ++g4) *(LAS f32x4*)(gt + (32 * oh + r32) * 32 + (((2 * g4 + hi) ^ (((32 * oh + r32) >> 1) & 7)) << 2)) = (f32x4){d[4 * g4], d[4 * g4 + 1], d[4 * g4 + 2], d[4 * g4 + 3]};
        }
        LDS_WAIT(); asm volatile("" ::: "memory");
#pragma unroll
        for (int c = 0; c < 8; ++c) { const f32x4 v4 = *(const LAS f32x4*)(gt + lane * 32 + ((c ^ ((lane >> 1) & 7)) << 2)); av[4 * c] = v4[0]; av[4 * c + 1] = v4[1]; av[4 * c + 2] = v4[2]; av[4 * c + 3] = v4[3]; }
        LDS_WAIT(); asm volatile("" ::: "memory");
#pragma unroll
        for (int oh = 0; oh < 2; ++oh) {
            f32x16 d = {};
#pragma unroll
            for (int d0 = 0; d0 < 4; ++d0) d = __builtin_amdgcn_mfma_f32_32x32x16_bf16(af[d0], *(const LAS bf16x8*)(gwr + (64 + 32 * oh) * GW_STRIDE + 32 * d0), d, 0, 0, 0);
#pragma unroll
            for (int g4 = 0; g4 < 4; ++g4) *(LAS f32x4*)(gt + (32 * oh + r32) * 32 + (((2 * g4 + hi) ^ (((32 * oh + r32) >> 1) & 7)) << 2)) = (f32x4){d[4 * g4], d[4 * g4 + 1], d[4 * g4 + 2], d[4 * g4 + 3]};
        }
        LDS_WAIT(); asm volatile("" ::: "memory");
        float hl = 0.f, ap = 1.f;
        typedef float f2 __attribute__((ext_vector_type(2)));
#pragma unroll
        for (int c = 0; c < 8; ++c) {
            const f32x4 z4 = *(const LAS f32x4*)(gt + lane * 32 + ((c ^ ((lane >> 1) & 7)) << 2));
#pragma unroll
            for (int p = 0; p < 2; ++p) {
                const int t = 4 * c + 2 * p;
                const f2 zr2 = {av[t], av[t + 1]}, zi2 = {z4[2 * p], z4[2 * p + 1]}, xc2 = {xc[t], xc[t + 1]};
                f2 er = zr2 * (-LOG2E) + cc.nbra, ei = zi2 * (-LOG2E) + cc.nbrx;
                er = (f2){fexp2(er.x), fexp2(er.y)} + 1.0f; ei = (f2){fexp2(ei.x), fexp2(ei.y)} + 1.0f;
                const f2 rg = {frcp(er.x), frcp(er.y)}, ig = {frcp(ei.x), frcp(ei.y)};
                const f2 la = rg * cc.c1;
                const f2 a2 = {fexp2(la.x), fexp2(la.y)};
                const f2 om = 1.0f - a2 * a2;
                const f2 sq = {__builtin_amdgcn_sqrtf(om.x), __builtin_amdgcn_sqrtf(om.y)};
                const f2 u2 = sq * ig * xc2;
                av[t] = a2.x; av[t + 1] = a2.y; uv[t] = u2.x; uv[t + 1] = u2.y;
                hl = a2.x * hl + u2.x; hl = a2.y * hl + u2.y; ap *= a2.x * a2.y;
            }
        }
        LAS float* xw = xch + (r & 1) * 1024;
        xw[(w * 2 + 0) * 64 + lane] = ap; xw[(w * 2 + 1) * 64 + lane] = hl;
        LDS_WAIT(); __syncthreads();
        float pa = 1.f, ph = 0.f;
        for (int k = 0; k < w; ++k) { const float ak = xw[(k * 2 + 0) * 64 + lane], hk = xw[(k * 2 + 1) * 64 + lane]; ph = ak * ph + hk; pa = ak * pa; }
        if (w == 7 && ib < 3) { gr_store(lba + (size_t)(r * 4 + ib) * 128, ap * pa); gr_store(lba + (size_t)(r * 4 + ib) * 128 + 64, ap * ph + hl); }
        float hin = 0.f;
        {
            unsigned long long gh = (1ull << 32), ga[3] = {1ull << 32, 1ull << 32, 1ull << 32}, gb[3] = {1ull << 32, 1ull << 32, 1ull << 32};
            unsigned sp = 0;
            for (;;) {
                if (r > 0) gh = gr_load(lbh + (size_t)(r - 1) * 64);
#pragma unroll
                for (int k = 0; k < 3; ++k) if (k < ib) { ga[k] = gr_load(lba + (size_t)(r * 4 + k) * 128); gb[k] = gr_load(lba + (size_t)(r * 4 + k) * 128 + 64); }
                bool ok = (gh >> 32) == 1ull;
#pragma unroll
                for (int k = 0; k < 3; ++k) ok = ok && (ga[k] >> 32) == 1ull && (gb[k] >> 32) == 1ull;
                if (__all(ok)) break;
                __builtin_amdgcn_s_sleep(2);
                if (++sp > (1u << 20)) break;
            }
            if (r > 0) hin = __uint_as_float((unsigned)gh);
#pragma unroll
            for (int k = 0; k < 3; ++k) if (k < ib) hin = __uint_as_float((unsigned)ga[k]) * hin + __uint_as_float((unsigned)gb[k]);
            hin = pa * hin + ph;
        }
        float h = hin;
#pragma unroll
        for (int t = 0; t < 32; ++t) {
            h = av[t] * h + uv[t];
            st[t * 64 + lane] = (bf16)pg8::cvt_pk_bf16(h * bf2f(st[t * 64 + lane]), 0.f);
        }
        LDS_WAIT(); asm volatile("" ::: "memory");
#pragma unroll
        for (int i = 0; i < 4; ++i) *(v4u*)(YM + (r0 + lrow + 8 * i) * DM + 64 * j + 8 * lc8) = *(const LAS v4u*)(st + (lrow + 8 * i) * 64 + 8 * lc8);
        if (q == 31) { if (r < 3) gr_store(lbh + (size_t)r * 64, h); else F.out[O_HP + (size_t)b * DM + ch] = h; }
        LDS_WAIT(); asm volatile("" ::: "memory");
    }
    __syncthreads();
}
template <int PASS>
__device__ __forceinline__ void scan_block(Frame& F, int bu) {
    const int j = bu & 15, ub = (bu >> 4) * 8 + F.wave;
    stage_gate_weights(F, j);
    LDS_WAIT(); __syncthreads();
    if (PASS == 1) sample_rnn_unit(F, ub, j);
    scan_unit<PASS>(F, ub >> 5, ub & 31, j, F.lds + F.wave * 16384);
    __syncthreads();
}
__device__ __forceinline__ void sample_rnn_unit(Frame& F, int bs, int j) {
    const int lane = F.lane, ch = 64 * j + lane;
    const ChanConst cc = chan_const(F, ch);
    const float* scv = F.in[I_SC] + (size_t)bs * 3 * DM;
    const float x0 = scv[ch], x1 = scv[DM + ch], x2 = scv[2 * DM + ch];
    const float x3 = bf2f(((const bf16*)(F.ws + WS_XR))[(size_t)(MP + bs) * DM + ch]);
    const float h0 = F.in[I_SH][(size_t)bs * DM + ch];
    const float sg = bf2f(((const bf16*)(F.ws + WS_SGR))[(size_t)(MP + bs) * DM + ch]);
    const float xc = cc.bc + cc.w0 * x0 + cc.w1 * x1 + cc.w2 * x2 + cc.w3 * x3;
    const int xci = __float_as_int(xc);
    const LAS unsigned char* gw = F.lds + GW_OFF + lane * GW_STRIDE;
    float zr = 0.f, zi = 0.f;
#pragma unroll
    for (int k8 = 0; k8 < 8; ++k8) {
        const v4u wr4 = *(const LAS v4u*)(gw + 16 * k8), wi4 = *(const LAS v4u*)(gw + 64 * GW_STRIDE + 16 * k8);
        const unsigned wrw[4] = {wr4.x, wr4.y, wr4.z, wr4.w}, wiw[4] = {wi4.x, wi4.y, wi4.z, wi4.w};
#pragma unroll
        for (int e = 0; e < 4; ++e) {
            const float xa = __int_as_float(__builtin_amdgcn_readlane(xci, 8 * k8 + 2 * e)), xb = __int_as_float(__builtin_amdgcn_readlane(xci, 8 * k8 + 2 * e + 1));
            zr += xa * bflo(wrw[e]); zr += xb * bfhi(wrw[e]); zi += xa * bflo(wiw[e]); zi += xb * bfhi(wiw[e]);
        }
    }
    const float rg = sigm(zr + cc.bra), ig = sigm(zi + cc.brx);
    const float a = fexp2(cc.c1 * rg);
    const float sq = sqrtf(fmaxf(1.0f - a * a, 0.f));
    const float h = a * h0 + sq * ig * xc;
    F.out[O_HS + (size_t)bs * DM + ch] = h;
    float* cv = F.out + O_CVS + (size_t)bs * 3 * DM;
    cv[ch] = x1; cv[DM + ch] = x2; cv[2 * DM + ch] = x3;
    ((bf16*)(F.ws + WS_YT))[(size_t)bs * 2048 + 1024 + ch] = (bf16)f2bf(h * sg);
}

__device__ __forceinline__ float logit_bound(Frame& F) {
    float mq = fabsf(F.in[I_QG][F.lane]), mk = fabsf(F.in[I_KG][F.lane]), mb = 0.f;
#pragma unroll
    for (int i = 0; i < 8; ++i) mb = fmaxf(mb, fabsf(F.in[I_REL][F.lane + 64 * i]));
#pragma unroll
    for (int o = 1; o < 64; o <<= 1) { mq = fmaxf(mq, __shfl_xor(mq, o)); mk = fmaxf(mk, __shfl_xor(mk, o)); mb = fmaxf(mb, __shfl_xor(mb, o)); }
    return (8.0f * mq * mk + mb) * LOG2E;
}

__device__ __forceinline__ void build_bias_table(Frame& F) {
    LAS float* bt = (LAS float*)(F.lds + BT_OFF);
    for (int e = F.tid; e < 16 * 128; e += NWAVES * 64) bt[e] = F.in[I_REL][BUCKET[e & 127] * 16 + (e >> 7)] * LOG2E;
}
__device__ __forceinline__ void sample_attn_block(Frame& F, int pair, float M0) {
    const int lane = F.lane, w = F.wave, u = 2 * pair + (w >> 2), bs = u >> 2, g = u & 3, kq = w & 3;
    const int dch = lane & 15, ksub = lane >> 4;
    const LAS float* bt = (const LAS float*)(F.lds + BT_OFF);
    LAS float* part = (LAS float*)F.lds;
    const bf16* QT = (const bf16*)(F.ws + WS_QT) + (size_t)bs * DM + g * 256;
    float q[4][4];
#pragma unroll
    for (int hh = 0; hh < 4; ++hh) { const v2u qq = *(const v2u*)(QT + hh * 64 + 4 * dch); q[hh][0] = bflo(qq.x); q[hh][1] = bfhi(qq.x); q[hh][2] = bflo(qq.y); q[hh][3] = bfhi(qq.y); }
    const float* ck = F.in[I_CK] + (((size_t)bs * 128 + 32 * kq + ksub) * 4 + g) * 64 + 4 * dch;
    const float* cv = F.in[I_CV] + (((size_t)bs * 128 + 32 * kq + ksub) * 4 + g) * 64 + 4 * dch;
    f32x4 kv[8], vv[8];
#pragma unroll
    for (int i = 0; i < 8; ++i) kv[i] = *(const f32x4*)(ck + (size_t)i * 1024);
#pragma unroll
    for (int i = 0; i < 8; ++i) vv[i] = *(const f32x4*)(cv + (size_t)i * 1024);
    float l[4] = {0.f, 0.f, 0.f, 0.f}; float o[4][4];
#pragma unroll
    for (int hh = 0; hh < 4; ++hh)
#pragma unroll
        for (int e = 0; e < 4; ++e) o[hh][e] = 0.f;
#pragma unroll
    for (int i = 0; i < 8; ++i) {
        const int key = 32 * kq + 4 * i + ksub;
#pragma unroll
        for (int hh = 0; hh < 4; ++hh) {
            float sdot = (kv[i][0] * q[hh][0] + kv[i][1] * q[hh][1]) + (kv[i][2] * q[hh][2] + kv[i][3] * q[hh][3]);
            sdot += __shfl_xor(sdot, 1); sdot += __shfl_xor(sdot, 2); sdot += __shfl_xor(sdot, 4); sdot += __shfl_xor(sdot, 8);
            const float ev = (key >= 1) ? fexp2(sdot + bt[(4 * g + hh) * 128 + ((128 - key) & 127)] - M0) : 0.f;
            l[hh] += ev;
#pragma unroll
            for (int e = 0; e < 4; ++e) o[hh][e] += ev * vv[i][e];
        }
    }
#pragma unroll
    for (int hh = 0; hh < 4; ++hh) {
        l[hh] += __shfl_xor(l[hh], 16); l[hh] += __shfl_xor(l[hh], 32);
#pragma unroll
        for (int e = 0; e < 4; ++e) { o[hh][e] += __shfl_xor(o[hh][e], 16); o[hh][e] += __shfl_xor(o[hh][e], 32); }
    }
    if (ksub == 0) {
#pragma unroll
        for (int hh = 0; hh < 4; ++hh) *(LAS f32x4*)(part + (w * 4 + hh) * 64 + 4 * dch) = (f32x4){o[hh][0], o[hh][1], o[hh][2], o[hh][3]};
    }
    if (lane < 4) part[8 * 256 + w * 4 + lane] = (lane == 0) ? l[0] : (lane == 1) ? l[1] : (lane == 2) ? l[2] : l[3];
    LDS_WAIT(); __syncthreads();
    if (kq == 0) {
        const float* kn = (const float*)(F.ws + WS_KVNEW) + (size_t)bs * 256 + g * 64; const float* vn = kn + 128 * 256;
        const float knew = kn[lane], vnew = vn[lane];
        F.out[O_KWS + (((size_t)bs * 128 + 127) * 4 + g) * 64 + lane] = knew; F.out[O_VWS + (((size_t)bs * 128 + 127) * 4 + g) * 64 + lane] = vnew;
        const bf16* sga = (const bf16*)(F.ws + WS_SGA) + (size_t)(MP + bs) * DM + g * 256;
        bf16* yt = (bf16*)(F.ws + WS_YT) + (size_t)bs * 2048 + g * 256;
#pragma unroll
        for (int hh = 0; hh < 4; ++hh) {
            float sn = bf2f(QT[hh * 64 + lane]) * knew;
#pragma unroll
            for (int ofs = 1; ofs < 64; ofs <<= 1) sn += __shfl_xor(sn, ofs);
            const float en = fexp2(sn + bt[(4 * g + hh) * 128] - M0);
            float osum = 0.f, lsum = 0.f;
#pragma unroll
            for (int k4 = 0; k4 < 4; ++k4) { osum += part[((w + k4) * 4 + hh) * 64 + lane]; lsum += part[8 * 256 + (w + k4) * 4 + hh]; }
            const float den = lsum + en + fexp2(F.in[I_SINK][4 * g + hh] * LOG2E - M0);
            const float ov = (osum + en * vnew) / den;
            yt[hh * 64 + lane] = (bf16)f2bf(ov * bf2f(sga[hh * 64 + lane]));
        }
    }
    LDS_WAIT(); __syncthreads();
}

constexpr int KT_STRIDE = 144;
constexpr int VT_STRIDE = 520;
constexpr int AT_K = 0, AT_V = 256 * KT_STRIDE, AT_T = AT_V + 64 * VT_STRIDE, AT_END = AT_T + 4 * 384 * 4;
static_assert(AT_END <= RING_BYTES, "attention LDS");
struct KVRegs { v4u k[4], v[4]; };
__device__ __forceinline__ void attn_load_kv(Frame& F, int b, int n, int g, KVRegs& r) {
    const bf16* Kb = (const bf16*)(F.ws + WS_K); const bf16* Vb = (const bf16*)(F.ws + WS_V);
    const long krow0 = (long)b * SEQ + 128 * (n - 1);
#pragma unroll
    for (int i = 0; i < 4; ++i) {
        const int cidx = F.tid + 512 * i; int kl = cidx >> 3; const int c8 = cidx & 7;
        if (n == 0 && kl < 128) kl += 128;
        const size_t off = (size_t)(krow0 + kl) * 256 + g * 64 + 8 * c8;
        r.k[i] = *(const v4u*)(Kb + off); r.v[i] = *(const v4u*)(Vb + off);
    }
}
__device__ __forceinline__ void attn_store_kv(Frame& F, const KVRegs& r) {
    LAS unsigned char* L = F.lds;
#pragma unroll
    for (int i = 0; i < 4; ++i) {
        const int cidx = F.tid + 512 * i, kl = cidx >> 3, c8 = cidx & 7;
        *(LAS v4u*)(L + AT_K + kl * KT_STRIDE + 16 * c8) = r.k[i];
        LAS bf16* vt = (LAS bf16*)(L + AT_V) + kl;
        const unsigned ww[4] = {r.v[i].x, r.v[i].y, r.v[i].z, r.v[i].w};
#pragma unroll
        for (int e = 0; e < 4; ++e) { vt[(8 * c8 + 2 * e) * (VT_STRIDE / 2)] = (bf16)(ww[e] & 0xffffu); vt[(8 * c8 + 2 * e + 1) * (VT_STRIDE / 2)] = (bf16)(ww[e] >> 16); }
    }
}
__device__ __forceinline__ void attn_compute(Frame& F, int b, int n, int g, float M0) {
    const int lane = F.lane, r32 = lane & 31, hi = lane >> 5, w = F.wave;
    LAS unsigned char* L = F.lds;
    const int hq = w >> 1, head = 4 * g + hq;
    const bf16* Q = (const bf16*)(F.out + O_YP) + QM_OFF;
    const bf16* SGA = (const bf16*)(F.ws + WS_SGA);
    bf16* YM = (bf16*)(F.ws + WS_XN);
    const float sinkv = fexp2(F.in[I_SINK][head] * LOG2E - M0);
    const unsigned onew = (r32 == 0 || r32 == 4) ? 0x3f803f80u : 0u;
    const bf16x8 onesf = __builtin_bit_cast(bf16x8, (v4u){onew, onew, onew, onew});
    for (int sb = 0; sb < 2; ++sb) {
        const int s = 2 * (w & 1) + sb;
        const size_t qrow = (size_t)b * SEQ + 128 * n + 32 * s + r32;
        bf16x8 qf[4];
#pragma unroll
        for (int d0 = 0; d0 < 4; ++d0) qf[d0] = *(const bf16x8*)(Q + qrow * DM + head * 64 + 16 * d0 + 8 * hi);
        const bf16* sg = SGA + qrow * DM + head * 64 + 4 * hi;
        v2u sgw[8];
#pragma unroll
        for (int q4 = 0; q4 < 4; ++q4) { sgw[q4] = *(const v2u*)(sg + 8 * q4); sgw[4 + q4] = *(const v2u*)(sg + 32 + 8 * q4); }
        f32x16 o0 = {}, o1 = {}, o2 = {};
        for (int kk = 0; kk < 3; ++kk) {
            const int kt = (s >> 1) + kk;
            if (n == 0 && kt < 2) continue;
            f32x16 p0 = {}, p1 = {};
            const LAS unsigned char* kb = L + AT_K + (64 * kt + r32) * KT_STRIDE + 16 * hi;
#pragma unroll
            for (int d0 = 0; d0 < 4; ++d0) {
                const bf16x8 a0 = *(const LAS bf16x8*)(kb + 32 * d0);
                const bf16x8 a1 = *(const LAS bf16x8*)(kb + 32 * KT_STRIDE + 32 * d0);
                p0 = __builtin_amdgcn_mfma_f32_32x32x16_bf16(a0, qf[d0], p0, 0, 0, 0);
                p1 = __builtin_amdgcn_mfma_f32_32x32x16_bf16(a1, qf[d0], p1, 0, 0, 0);
            }
            const int dbase = 128 + 32 * s + r32 - 64 * kt - 4 * hi;
            const LAS float* tb = (const LAS float*)(L + AT_T) + hq * 384 + 128 + dbase - 59;
#pragma unroll
            for (int r = 0; r < 16; ++r) {
                const int c = (r & 3) + 8 * (r >> 2);
                p0[r] = fexp2(p0[r] + tb[59 - c]); p1[r] = fexp2(p1[r] + tb[27 - c]);
            }
            const LAS unsigned char* vb = L + AT_V + r32 * VT_STRIDE + (64 * kt + 4 * hi) * 2;
#pragma unroll
            for (int ks = 0; ks < 4; ++ks) {
                v4u pw;
                if (ks == 0)      { pw.x = pg8::cvt_pk_bf16(p0[0], p0[1]);   pw.y = pg8::cvt_pk_bf16(p0[2], p0[3]);   pw.z = pg8::cvt_pk_bf16(p0[4], p0[5]);   pw.w = pg8::cvt_pk_bf16(p0[6], p0[7]); }
                else if (ks == 1) { pw.x = pg8::cvt_pk_bf16(p0[8], p0[9]);   pw.y = pg8::cvt_pk_bf16(p0[10], p0[11]); pw.z = pg8::cvt_pk_bf16(p0[12], p0[13]); pw.w = pg8::cvt_pk_bf16(p0[14], p0[15]); }
                else if (ks == 2) { pw.x = pg8::cvt_pk_bf16(p1[0], p1[1]);   pw.y = pg8::cvt_pk_bf16(p1[2], p1[3]);   pw.z = pg8::cvt_pk_bf16(p1[4], p1[5]);   pw.w = pg8::cvt_pk_bf16(p1[6], p1[7]); }
                else              { pw.x = pg8::cvt_pk_bf16(p1[8], p1[9]);   pw.y = pg8::cvt_pk_bf16(p1[10], p1[11]); pw.z = pg8::cvt_pk_bf16(p1[12], p1[13]); pw.w = pg8::cvt_pk_bf16(p1[14], p1[15]); }
                const bf16x8 pb = __builtin_bit_cast(bf16x8, pw);
                const v2u va0 = *(const LAS v2u*)(vb + 32 * ks), va1 = *(const LAS v2u*)(vb + 32 * ks + 16);
                const v2u vc0 = *(const LAS v2u*)(vb + 32 * VT_STRIDE + 32 * ks), vc1 = *(const LAS v2u*)(vb + 32 * VT_STRIDE + 32 * ks + 16);
                const bf16x8 fa = __builtin_bit_cast(bf16x8, (v4u){va0.x, va0.y, va1.x, va1.y});
                const bf16x8 fc = __builtin_bit_cast(bf16x8, (v4u){vc0.x, vc0.y, vc1.x, vc1.y});
                o0 = __builtin_amdgcn_mfma_f32_32x32x16_bf16(fa, pb, o0, 0, 0, 0);
                o1 = __builtin_amdgcn_mfma_f32_32x32x16_bf16(fc, pb, o1, 0, 0, 0);
                o2 = __builtin_amdgcn_mfma_f32_32x32x16_bf16(onesf, pb, o2, 0, 0, 0);
            }
        }
        const float inv = 1.0f / (o2[0] + sinkv);
        bf16* yo = YM + qrow * DM + head * 64 + 4 * hi;
#pragma unroll
        for (int q4 = 0; q4 < 4; ++q4) {
            {
                const v2u sw = sgw[q4];
                v2u ow; ow.x = pg8::cvt_pk_bf16(o0[4 * q4] * inv * bflo(sw.x), o0[4 * q4 + 1] * inv * bfhi(sw.x)); ow.y = pg8::cvt_pk_bf16(o0[4 * q4 + 2] * inv * bflo(sw.y), o0[4 * q4 + 3] * inv * bfhi(sw.y));
                *(v2u*)(yo + 8 * q4) = ow;
            }
            {
                const v2u sw = sgw[4 + q4];
                v2u ow; ow.x = pg8::cvt_pk_bf16(o1[4 * q4] * inv * bflo(sw.x), o1[4 * q4 + 1] * inv * bfhi(sw.x)); ow.y = pg8::cvt_pk_bf16(o1[4 * q4 + 2] * inv * bflo(sw.y), o1[4 * q4 + 3] * inv * bfhi(sw.y));
                *(v2u*)(yo + 32 + 8 * q4) = ow;
            }
        }
    }
}
__device__ __forceinline__ void attn_phase(Frame& F, float M0) {
    const int NU = NB * 32 * 4;
    int u = blockIdx.x; if (u >= NU) return;
    KVRegs r; attn_load_kv(F, u >> 7, (u >> 2) & 31, u & 3, r);
    for (; u < NU; u += F.G) {
        attn_store_kv(F, r);
        {
            const int g_ = u & 3; LAS float* tb = (LAS float*)(F.lds + AT_T);
#pragma unroll
            for (int i = 0; i < 3; ++i) { const int e = F.tid + 512 * i, hh = e / 384, dist = e % 384 - 128;
                tb[e] = ((unsigned)dist < 128u) ? F.in[I_REL][BUCKET[dist & 127] * 16 + 4 * g_ + hh] * LOG2E - M0 : -1e30f; }
        }
        const int un = u + F.G;
        if (un < NU) attn_load_kv(F, un >> 7, (un >> 2) & 31, un & 3, r);
        LDS_WAIT(); __syncthreads();
        attn_compute(F, u >> 7, (u >> 2) & 31, u & 3, M0);
        __syncthreads();
    }
}

constexpr int REP[7] = {1, 1, 1, 1, 1, 1, 1};
constexpr int REPS[4] = {1, 1, 1, 1};
__global__ void __launch_bounds__(NWAVES * 64, 2) hyb_fwd(Args args) {
    extern __shared__ __attribute__((aligned(16))) unsigned char lds[];
    Frame F;
    F.lds = (LAS unsigned char*)lds;
    F.tid = threadIdx.x; F.lane = F.tid & 63; F.wave = __builtin_amdgcn_readfirstlane(F.tid >> 6);
    F.G = gridDim.x; { const int bx = blockIdx.x; F.vcu = (F.G % 8 == 0) ? (bx % 8) * (F.G / 8) + bx / 8 : bx; }
    F.in = args.in; F.out = args.out; F.ws = args.ws;
    volatile LAS unsigned* MISC = (volatile LAS unsigned*)(F.lds + MISC_OFF);
    for (int u = F.tid; u < (LDS_BYTES - LDSCTL_OFF) / 4; u += NWAVES * 64) ((LAS unsigned*)(F.lds + LDSCTL_OFF))[u] = 0u;
    __syncthreads();
    const int lo = args.ph_lo, hi = args.ph_hi;
    const bool one = (hi - lo) > 1;
    XcdBarrier bar; bar.bar = (unsigned*)(F.ws + WS_CTL) + CW_BAR; bar.x = 0; bar.st = nullptr;
    if (one) bar = xcd_barrier_post((unsigned*)(F.ws + WS_CTL) + CW_BAR, MISC + 8);
#define IN(k) (lo <= (k) && (k) < hi)
#define SEAM(k) do { if (IN(k) && IN((k) + 1)) xcd_barrier(bar); } while (0)
    const int gw = F.vcu * NWAVES + F.wave, NGW = F.G * NWAVES;
    LAS unsigned char* wl = F.lds + F.wave * 16384;

    unsigned* ctlw = (unsigned*)(F.ws + WS_CTL);
    for (int rep = 0; rep < REP[0]; ++rep)
    if (IN(0)) {
        refresh(F);
        for (int t = blockIdx.x; t < 192; t += F.G) { p0_mod_tile(F, t); soft_arrive(ctlw + CW_MODC, 1u); }
        p0_weights(F);
        {
            const int gt_ = F.vcu * (NWAVES * 64) + F.tid, NGT = F.G * NWAVES * 64;
            unsigned long long* za = (unsigned long long*)(F.ws + WS_LBA); unsigned long long* zh = (unsigned long long*)(F.ws + WS_LBH);
            for (int e = gt_; e < 131072; e += NGT) __hip_atomic_store(za + e, 0ull, __ATOMIC_RELAXED, __HIP_MEMORY_SCOPE_AGENT);
            for (int e = gt_; e < 16384; e += NGT) __hip_atomic_store(zh + e, 0ull, __ATOMIC_RELAXED, __HIP_MEMORY_SCOPE_AGENT);
        }
        __syncthreads();
    }
    for (int rep = 0; rep < REP[1]; ++rep)
    if (IN(1)) { refresh(F); soft_wait(ctlw + CW_MODC, 192u); p1_xn(F); }
    SEAM(1);
    for (int rep = 0; rep < REP[2]; ++rep)
    if (IN(2)) {
        pg8::Gemm g{(const bf16*)(F.ws + WS_XN), (const bf16*)(F.ws + WS_WIN), MPAD, INW, DM, nullptr, DM};
        pg8::StaticOrder S; S.init(MPAD, INW, F.G, (int)blockIdx.x);
        EpiZ E{F.ws, F.out, F.in[I_QG], F.in[I_KG]};
        pg8::gemm_phase<EpiZ, pg8::StaticOrder, true, true>(F.lds, g, S, E);
        refresh(F);
        for (;;) {
            if (F.tid == 0) MISC[10] = __hip_atomic_fetch_add(ctlw + CW_TQ, 1u, __ATOMIC_RELAXED, __HIP_MEMORY_SCOPE_AGENT);
            __syncthreads();
            const int it = (int)MISC[10];
            __syncthreads();
            if (it >= TQ_ALL) break;
            tail_item(F, it);
        }
    }
    SEAM(2);
    for (int rep = 0; rep < REP[3]; ++rep)
    if (IN(3)) {
        refresh(F);
        const float M0 = logit_bound(F);
        build_bias_table(F);
        LDS_WAIT(); __syncthreads();
        for (int rs = 0; rs < REPS[0]; ++rs) {
        for (int u = F.vcu; u < NS * 2; u += F.G) sample_attn_block(F, u, M0);
        }
        if (F.G == 256) {
            scan_lb_block(F, F.vcu);
            build_bias_table(F); LDS_WAIT(); __syncthreads();
        } else {
            for (int u = F.vcu; u < 256; u += F.G) scan_block<1>(F, u);
            soft_arrive(ctlw + CW_S1C, 1u);
        }
        for (int rs = 0; rs < REPS[2]; ++rs)
        attn_phase(F, M0);
    }
    for (int rep = 0; rep < REP[4]; ++rep)
    if (IN(4) && F.G != 256) {
        refresh(F);
        soft_wait(ctlw + CW_S1C, (unsigned)F.G);
        for (int u = F.vcu; u < 256; u += F.G) scan_block<2>(F, u);
        __syncthreads();
    }
    SEAM(4);
    for (int rep = 0; rep < REP[5]; ++rep)
    if (IN(5)) {
        pg8::Gemm g{(const bf16*)(F.ws + WS_XN), (const bf16*)(F.ws + WS_WPP), MP, DM, 2048, (const bf16*)(F.out + O_YP), DM};
        pg8::StaticOrder S; S.init(MP, DM, F.G, (int)blockIdx.x);
        EpiMerge E{F.ws + WS_RAT, F.ws + WS_SMR, (bf16*)(F.ws + WS_SGA)};
        pg8::gemm_phase<EpiMerge, pg8::StaticOrder, false, true>(F.lds, g, S, E);
        refresh(F);
        for (int t = F.vcu; t < 256; t += F.G) mini_merge_block(F, t);
    }
    SEAM(5);
    for (int rep = 0; rep < REP[6]; ++rep)
    if (IN(6)) {
        pg8::Gemm g{(const bf16*)(F.ws + WS_SGA), (const bf16*)(F.ws + WS_WOUT), MP, DM, DM, nullptr, DM};
        pg8::StaticOrder S; S.init(MP, DM, F.G, (int)blockIdx.x);
        EpiOut E{F.in[I_XP], (const float*)(F.ws + WS_MOD), F.out + O_YP};
        pg8::gemm_phase<EpiOut, pg8::StaticOrder, false, true>(F.lds, g, S, E);
        refresh(F);
        for (int t = F.vcu; t < 256; t += F.G) mini_out_block(F, t);
    }
#undef IN
#undef SEAM
}

#ifndef MK_N_LAUNCHES
#define MK_N_LAUNCHES 1
#endif
constexpr int N_PHASES = 7;

extern "C" void kernel_launch(void* const* d_in, const int* in_sizes, int n_in, void* d_out, int out_size, void* d_ws, size_t ws_size, hipStream_t stream) {
    static int grid = 0;
    if (grid == 0) {
        if (n_in != 26 || out_size != (int)O_END || ws_size < WS_END) { fprintf(stderr, "kernel_launch: unexpected shapes (n_in %d out %d ws %zu)\n", n_in, out_size, ws_size); grid = -1; return; }
        int dev = 0, cus = 0, per_cu = 0;
        if (hipGetDevice(&dev) != hipSuccess || hipDeviceGetAttribute(&cus, hipDeviceAttributeMultiprocessorCount, dev) != hipSuccess) { grid = -1; return; }
        if (hipFuncSetAttribute((const void*)hyb_fwd, hipFuncAttributeMaxDynamicSharedMemorySize, LDS_BYTES) != hipSuccess) { fprintf(stderr, "kernel_launch: hipFuncSetAttribute failed\n"); grid = -1; return; }
        if (hipOccupancyMaxActiveBlocksPerMultiprocessor(&per_cu, (const void*)hyb_fwd, NWAVES * 64, LDS_BYTES) != hipSuccess || per_cu < 1) { fprintf(stderr, "kernel_launch: occupancy query says %d\n", per_cu); per_cu = 1; }
        (void)hipGetLastError();
        grid = cus * (per_cu < 1 ? 1 : 1);
    }
    if (grid < 0) return;
    (void)hipMemsetAsync((char*)d_ws + WS_CTL, 0, CTL_ZERO_BYTES, stream);
    Args a{};
    for (int i = 0; i < 26; ++i) a.in[i] = (const float*)d_in[i];
    a.out = (float*)d_out; a.ws = (unsigned char*)d_ws;
    if (MK_N_LAUNCHES == 1) {
        a.ph_lo = 0; a.ph_hi = N_PHASES;
        void* kargs[] = {&a};
        hipError_t e = hipLaunchCooperativeKernel((const void*)hyb_fwd, dim3(grid), dim3(NWAVES * 64), kargs, LDS_BYTES, stream);
        if (e != hipSuccess) fprintf(stderr, "kernel_launch: cooperative launch failed: %s (grid %d)\n", hipGetErrorString(e), grid);
    } else {
        for (int p = 0; p < N_PHASES; ++p) {
            a.ph_lo = p; a.ph_hi = p + 1;
            hipLaunchKernelGGL(hyb_fwd, dim3(grid), dim3(NWAVES * 64), LDS_BYTES, stream, a);
        }
    }
}
```

```cpp
#include <hip/hip_runtime.h>
#include <cstdio>
#include <cstdint>

namespace pg8 {
#define PG8_LAS __attribute__((address_space(3)))
typedef unsigned short bf16_t;
typedef short bf16x8 __attribute__((ext_vector_type(8)));
typedef float f32x4 __attribute__((ext_vector_type(4)));
typedef unsigned u32x4 __attribute__((ext_vector_type(4)));
constexpr int BM = 256, BK = 64, HALF = 128, HTB = HALF * BK * 2, STAGE_BYTES = 8 * HTB, NXCD = 8, WGM = 8;

__host__ __device__ __forceinline__ int lds_byte(int r, int c) { const int st = (r >> 4) * 2 + (c >> 5), rr = r & 15, cc = c & 31, ob = rr * 64 + cc * 2; return st * 1024 + (ob ^ (((ob >> 9) & 1) << 5)); }
__host__ __device__ __forceinline__ void stage_rc(int b, int& R, int& C) { const int st = b / 1024, sb = b % 1024, swz = sb ^ (((sb >> 9) & 1) << 5); R = (st >> 1) * 16 + swz / 64; C = (st & 1) * 32 + (swz % 64) / 2; }
__host__ __device__ __forceinline__ int perm32(int rho) { const int n = rho >> 4, i = rho & 15; return 8 * (i >> 2) + 4 * n + (i & 3); }

struct Unit { int pm, pn; };
struct Gemm { const bf16_t* A; const bf16_t* Bt; int M, N, K; const bf16_t* A2; int lda; };

struct StaticOrder {
    int nM, nN, nwg, G, c;
    __host__ __device__ void init(int M, int N, int G_, int c_) { nM = M / BM; nN = N / BM; nwg = nM * nN; G = G_; c = c_; }
    __host__ __device__ bool next(int i, Unit& u) const {
        const long L = (long)i * G + c; if (L >= nwg) return false;
        int wgid = (int)L; { const int q = nwg / NXCD, r = nwg % NXCD, xcd = wgid % NXCD, off = wgid / NXCD; wgid = (xcd < r ? xcd * (q + 1) : r * (q + 1) + (xcd - r) * q) + off; }
        const int nig = WGM * nN, gid = wgid / nig, fm = gid * WGM, gsz = (nM - fm) < WGM ? (nM - fm) : WGM;
        u.pm = fm + ((wgid % nig) % gsz); u.pn = (wgid % nig) / gsz; return true;
    }
    __device__ __forceinline__ void a_ready(const Unit&) const {}
    __device__ __forceinline__ void done(const Unit&) const {}
};

typedef float f32x2_t __attribute__((ext_vector_type(2))); typedef __bf16 bf16x2_t __attribute__((ext_vector_type(2)));
__device__ __forceinline__ unsigned cvt_pk_bf16(float lo, float hi) { f32x2_t v = {lo, hi}; bf16x2_t b = __builtin_convertvector(v, bf16x2_t); return __builtin_bit_cast(unsigned, b); }

template <class Epi, class Sched, bool ALIGN_EPI = false, bool SP2 = false>
__device__ __forceinline__ void gemm_phase(PG8_LAS unsigned char* lds, const Gemm g, const Sched& S, const Epi& E) {
    int tid_ = threadIdx.x; asm volatile("" : "+v"(tid_));
    const int tid = tid_, wid = __builtin_amdgcn_readfirstlane(tid >> 6), lane = tid & 63, wr = wid >> 2, wc = wid & 3, fr = lane & 15, fq = lane >> 4;
    const int K = g.K, nt = K / BK;
    unsigned voffA[2], voffB[2];
#pragma unroll
    for (int i = 0; i < 2; ++i) { int R, C; stage_rc(tid * 16 + i * 8192, R, C); const int Rb = Epi::PERM ? ((R & ~31) + perm32(R & 31)) : R;
        voffA[i] = (unsigned)(R * g.lda + C) * 2u; voffB[i] = (unsigned)(Rb * K + C) * 2u; }
    const size_t kstep = (size_t)(BK * 2);
    const size_t hstep = (size_t)HALF * K * 2;
    const size_t tstep = 2 * hstep;
    const size_t hstepA = (size_t)HALF * g.lda * 2, tstepA = 2 * hstepA;
    const int nh = g.A2 ? nt / 2 : nt + 4;
    const long a2delta = g.A2 ? ((const char*)g.A2 - (const char*)g.A) - (long)nh * (long)kstep : 0;
    const unsigned ldsw = (unsigned)wid * 1024u;
    const int aoff = lds_byte(wr * 64 + fr, fq * 8), boff = lds_byte(wc * 32 + fr, fq * 8);
#define PG8_SA(b, h) (((b) * 2 + (h)) * HTB)
#define PG8_SB(b, h) ((4 + (b) * 2 + (h)) * HTB)
#define PG8_STAGE(bufoff, gbase, voff) do { _Pragma("unroll") for (int _i = 0; _i < 2; ++_i) \
        __builtin_amdgcn_global_load_lds((const unsigned*)((const char*)(gbase) + (voff)[_i]), (PG8_LAS unsigned*)(lds + (bufoff) + ldsw + _i * 8192), 16, 0, 0); } while (0)
#define PG8_LDA(dst, b, h) do { _Pragma("unroll") for (int m = 0; m < 4; ++m) _Pragma("unroll") for (int k = 0; k < 2; ++k) dst[m][k] = *(const PG8_LAS bf16x8*)(lds + PG8_SA(b, h) + aoff + m * 2048 + k * 1024); } while (0)
#define PG8_LDB(dst, b, h) do { _Pragma("unroll") for (int n = 0; n < 2; ++n) _Pragma("unroll") for (int k = 0; k < 2; ++k) dst[n][k] = *(const PG8_LAS bf16x8*)(lds + PG8_SB(b, h) + boff + n * 2048 + k * 1024); } while (0)
#define PG8_MMA(ai, bj, At, Bt) do { __builtin_amdgcn_s_setprio(1); _Pragma("unroll") for (int m = 0; m < 4; ++m) _Pragma("unroll") for (int n = 0; n < 2; ++n) _Pragma("unroll") for (int k = 0; k < 2; ++k) \
        acc[ai][bj][m][n] = __builtin_amdgcn_mfma_f32_16x16x32_bf16(Bt[n][k], At[m][k], acc[ai][bj][m][n], 0, 0, 0); __builtin_amdgcn_s_setprio(0); } while (0)
#define PG8_WAIT_V(n) asm volatile("s_waitcnt vmcnt(" #n ")" ::: "memory")
#define PG8_WAIT_L(n) asm volatile("s_waitcnt lgkmcnt(" #n ")" ::: "memory")
#define PG8_BAR __builtin_amdgcn_s_barrier()
#define PG8_SCHED __builtin_amdgcn_sched_barrier(0)
    Unit cur, nxt; int ui = 0;
    if (!S.next(0, cur)) return;
    f32x4 acc[2][2][4][2];
#pragma unroll
    for (int a = 0; a < 2; ++a)
#pragma unroll
        for (int b = 0; b < 2; ++b)
#pragma unroll
            for (int m = 0; m < 4; ++m)
#pragma unroll
                for (int n = 0; n < 2; ++n) acc[a][b][m][n] = (f32x4){0.f, 0.f, 0.f, 0.f};
    bf16x8 At[4][2], B0[2][2], B1[2][2];
    const char* cA = (const char*)g.A + (size_t)cur.pm * tstepA; const char* cB = (const char*)g.Bt + (size_t)cur.pn * tstep;
    S.a_ready(cur);
    if constexpr (SP2) {
        PG8_STAGE(PG8_SB(0, 0), cB, voffB); PG8_STAGE(PG8_SB(0, 1), cB + hstep, voffB); PG8_STAGE(PG8_SA(0, 0), cA, voffA); PG8_STAGE(PG8_SA(0, 1), cA + hstepA, voffA);
        if (wr == 1) PG8_BAR;
        PG8_WAIT_V(2); PG8_BAR;
        PG8_STAGE(PG8_SB(1, 0), cB + kstep, voffB); PG8_STAGE(PG8_SA(1, 0), cA + kstep, voffA); PG8_STAGE(PG8_SB(1, 1), cB + hstep + kstep, voffB);
        PG8_WAIT_V(6); PG8_BAR;
    } else {
        PG8_STAGE(PG8_SB(0, 0), cB, voffB); PG8_STAGE(PG8_SA(0, 0), cA, voffA); PG8_STAGE(PG8_SB(0, 1), cB + hstep, voffB); PG8_STAGE(PG8_SA(0, 1), cA + hstepA, voffA);
        if (wr == 1) PG8_BAR;
        PG8_WAIT_V(4); PG8_BAR;
        PG8_STAGE(PG8_SB(1, 0), cB + kstep, voffB); PG8_STAGE(PG8_SA(1, 0), cA + kstep, voffA); PG8_STAGE(PG8_SB(1, 1), cB + hstep + kstep, voffB);
        PG8_WAIT_V(6); PG8_BAR;
    }
    for (;;) {
        const bool has_next = S.next(ui + 1, nxt);
        const char* nA = has_next ? (const char*)g.A + (size_t)nxt.pm * tstepA : cA; const char* nB = has_next ? (const char*)g.Bt + (size_t)nxt.pn * tstep : cB;
        for (int t = 0; t < nt; t += 2) {
            if constexpr (Epi::HAS_MID) { if (t == nt / 2) E.mid(acc, cur, wr, wc, fr, fq); }
            const bool last = (t == nt - 2);
            const char* a1 = cA + (t >= nh ? a2delta : 0) + (size_t)(t + 1) * kstep;
            const char* a2 = last ? nA : cA + (t + 2 >= nh ? a2delta : 0) + (size_t)(t + 2) * kstep; const char* b2 = last ? nB : cB + (size_t)(t + 2) * kstep;
            const char* a3 = a2 + kstep; const char* b3 = b2 + kstep;
            if (last && has_next) S.a_ready(nxt);
            if constexpr (SP2) {
            PG8_LDB(B0, 0, 0); PG8_LDB(B1, 0, 1); PG8_SCHED; PG8_LDA(At, 0, 0); PG8_STAGE(PG8_SA(1, 1), a1 + hstepA, voffA);
            PG8_WAIT_V(8); PG8_WAIT_L(0); PG8_BAR; PG8_MMA(0, 0, At, B0); PG8_MMA(0, 1, At, B1); PG8_BAR; PG8_SCHED;
            PG8_LDA(At, 0, 1); PG8_STAGE(PG8_SB(0, 0), b2, voffB); PG8_STAGE(PG8_SB(0, 1), b2 + hstep, voffB); PG8_STAGE(PG8_SA(0, 0), a2, voffA);
            PG8_WAIT_V(8); PG8_WAIT_L(0); PG8_BAR; PG8_MMA(1, 0, At, B0); PG8_MMA(1, 1, At, B1); PG8_BAR; PG8_SCHED;
            PG8_LDB(B0, 1, 0); PG8_LDB(B1, 1, 1); PG8_SCHED; PG8_LDA(At, 1, 0); PG8_STAGE(PG8_SA(0, 1), a2 + hstepA, voffA);
            PG8_WAIT_V(8); PG8_WAIT_L(0); PG8_BAR; PG8_MMA(0, 0, At, B0); PG8_MMA(0, 1, At, B1); PG8_BAR; PG8_SCHED;
            PG8_LDA(At, 1, 1); PG8_STAGE(PG8_SB(1, 0), b3, voffB); PG8_STAGE(PG8_SB(1, 1), b3 + hstep, voffB); PG8_STAGE(PG8_SA(1, 0), a3, voffA);
            PG8_WAIT_V(8); PG8_WAIT_L(0); PG8_BAR; PG8_MMA(1, 0, At, B0); PG8_MMA(1, 1, At, B1); PG8_BAR; PG8_SCHED;
            } else {
            PG8_LDB(B0, 0, 0); PG8_SCHED; PG8_LDA(At, 0, 0); PG8_STAGE(PG8_SA(1, 1), a1 + hstepA, voffA);
            PG8_WAIT_L(8); PG8_BAR; PG8_WAIT_L(0); PG8_MMA(0, 0, At, B0); PG8_BAR; PG8_SCHED;
            PG8_LDB(B1, 0, 1); PG8_STAGE(PG8_SB(0, 0), b2, voffB);
            PG8_BAR; PG8_WAIT_L(0); PG8_MMA(0, 1, At, B1); PG8_BAR;
            PG8_LDA(At, 0, 1); PG8_STAGE(PG8_SA(0, 0), a2, voffA);
            PG8_BAR; PG8_WAIT_L(0); PG8_MMA(1, 0, At, B0); PG8_BAR; PG8_SCHED;
            PG8_STAGE(PG8_SB(0, 1), b2 + hstep, voffB);
            PG8_WAIT_V(6); PG8_BAR; PG8_MMA(1, 1, At, B1); PG8_BAR;
            PG8_LDB(B0, 1, 0); PG8_SCHED; PG8_LDA(At, 1, 0); PG8_STAGE(PG8_SA(0, 1), a2 + hstepA, voffA);
            PG8_WAIT_L(8); PG8_BAR; PG8_WAIT_L(0); PG8_MMA(0, 0, At, B0); PG8_BAR; PG8_SCHED;
            PG8_LDB(B1, 1, 1); PG8_STAGE(PG8_SB(1, 0), b3, voffB);
            PG8_BAR; PG8_WAIT_L(0); PG8_MMA(0, 1, At, B1); PG8_BAR;
            PG8_LDA(At, 1, 1); PG8_STAGE(PG8_SA(1, 0), a3, voffA);
            PG8_BAR; PG8_WAIT_L(0); PG8_MMA(1, 0, At, B0); PG8_BAR; PG8_SCHED;
            PG8_STAGE(PG8_SB(1, 1), b3 + hstep, voffB);
            PG8_WAIT_V(6); PG8_BAR; PG8_MMA(1, 1, At, B1); PG8_BAR;
            }
        }
        if constexpr (ALIGN_EPI) { if (wr == 0) PG8_BAR; }
        E(acc, cur, wr, wc, fr, fq); S.done(cur);
        if (!has_next) break;
#pragma unroll
        for (int a = 0; a < 2; ++a)
#pragma unroll
            for (int b = 0; b < 2; ++b)
#pragma unroll
                for (int m = 0; m < 4; ++m)
#pragma unroll
                    for (int n = 0; n < 2; ++n) acc[a][b][m][n] = (f32x4){0.f, 0.f, 0.f, 0.f};
        cur = nxt; cA = nA; cB = nB; ++ui;
        if constexpr (ALIGN_EPI) { if (wr == 1) PG8_BAR; }
    }
    PG8_WAIT_V(0);
    if constexpr (!ALIGN_EPI) { if (wr == 0) PG8_BAR; }
    PG8_BAR;
#undef PG8_SA
#undef PG8_SB
#undef PG8_STAGE
#undef PG8_LDA
#undef PG8_LDB
#undef PG8_MMA
#undef PG8_WAIT_V
#undef PG8_WAIT_L
#undef PG8_BAR
#undef PG8_SCHED
}
}

constexpr int NWAVES = 8;
constexpr int DM = 1024, NB = 4, SEQ = 4096, NS = 128, WIN = 128;
constexpr int MP = NB * SEQ;
constexpr int MALL = MP + NS;
constexpr int MPAD = 16640;
constexpr int INW = 6656;
constexpr int NCH = 32;
constexpr float EPSN = 1e-6f;
constexpr float LOG2E = 1.4426950408889634f;
constexpr float QSCALE = 0.125f * LOG2E;

constexpr size_t MiB = 1u << 20;
constexpr size_t WS_CTL = 0, CTL_ZERO_BYTES = 64 * 1024;
constexpr size_t WS_MOD = 1 * MiB;
constexpr size_t WS_WRA = 3 * MiB;
constexpr size_t WS_WRX = 3 * MiB + 128 * 1024;
constexpr size_t WS_KVNEW = 3 * MiB + 256 * 1024;
constexpr size_t WS_AGG = 4 * MiB;
constexpr size_t WS_LBA = 4 * MiB;
constexpr size_t WS_LBH = 3 * MiB + 512 * 1024;
constexpr size_t WS_WIN = 5 * MiB;
constexpr size_t WS_WPP = 18 * MiB;
constexpr size_t WS_WOUT = 22 * MiB;
constexpr size_t WS_XN = 24 * MiB;
constexpr size_t ACT = (size_t)MPAD * DM * 2;
constexpr size_t WS_K = WS_XN + ACT;
constexpr size_t WS_V = WS_K + ACT / 4;
constexpr size_t WS_SGA = WS_V + ACT / 4;
constexpr size_t WS_XR = WS_SGA + ACT;
constexpr size_t WS_SGR = WS_XR + ACT;
constexpr size_t WS_RAT = WS_SGR + ACT;
constexpr size_t WS_SMR = WS_RAT + ACT;
constexpr size_t WS_QT = WS_SMR + ACT;
constexpr size_t WS_YT = WS_QT + 512 * 1024;
constexpr size_t WS_MGT = WS_YT + 512 * 1024;
constexpr size_t WS_END = WS_MGT + 256 * 1024;
static_assert(WS_END <= 256 * MiB, "d_ws map");
constexpr size_t O_YP = 0, O_YS = 16777216, O_KWP = 16908288, O_VWP = 17039360, O_CVP = 17170432, O_HP = 17182720,
                 O_KWS = 17186816, O_VWS = 21381120, O_CVS = 25575424, O_HS = 25968640, O_END = 26099712;
constexpr size_t QM_OFF = (size_t)MP * DM;

constexpr int CW_BAR = 1024, CW_MODC = 64, CW_S1C = 128, CW_TQ = 192;

constexpr int RING_BYTES = 131072;
constexpr int GW_OFF = RING_BYTES, GW_STRIDE = 144, GW_BYTES = 2 * 64 * GW_STRIDE;
constexpr int BT_OFF = GW_OFF + GW_BYTES, BT_BYTES = 16 * 128 * 4;
constexpr int LDSCTL_OFF = BT_OFF + BT_BYTES, MISC_OFF = LDSCTL_OFF + 320;
constexpr int LDS_BYTES = LDSCTL_OFF + 512;

#define GAS __attribute__((address_space(1)))
#define LAS __attribute__((address_space(3)))
typedef unsigned short bf16;
typedef unsigned v4u __attribute__((ext_vector_type(4)));
typedef unsigned v2u __attribute__((ext_vector_type(2)));
typedef float f32x4 __attribute__((ext_vector_type(4)));
typedef float f32x16 __attribute__((ext_vector_type(16)));
typedef short bf16x8 __attribute__((ext_vector_type(8)));
typedef short s16x4 __attribute__((ext_vector_type(4)));
typedef GAS unsigned gu32;
#define RLX_AGENT __ATOMIC_RELAXED, __HIP_MEMORY_SCOPE_AGENT
#define LDS_WAIT() asm volatile("s_waitcnt lgkmcnt(0)" ::: "memory")
#define VM_WAIT() asm volatile("s_waitcnt vmcnt(0)" ::: "memory")
__device__ __forceinline__ unsigned f2bf(float f) { unsigned u = __builtin_bit_cast(unsigned, f); return (u + 0x7fffu + ((u >> 16) & 1u)) >> 16; }
__device__ __forceinline__ unsigned pk2(float lo, float hi) { return f2bf(lo) | (f2bf(hi) << 16); }
__device__ __forceinline__ float bf2f(unsigned b) { return __uint_as_float(b << 16); }
__device__ __forceinline__ float bflo(unsigned w) { return __uint_as_float(w << 16); }
__device__ __forceinline__ float bfhi(unsigned w) { return __uint_as_float(w & 0xffff0000u); }
__device__ __forceinline__ unsigned pk_u8x4(float a, float b, float c, float d) {
    unsigned r = __builtin_amdgcn_cvt_pk_u8_f32(fmaxf(a * 255.0f, 1.0f), 0, 0u); r = __builtin_amdgcn_cvt_pk_u8_f32(fmaxf(b * 255.0f, 1.0f), 1, r);
    r = __builtin_amdgcn_cvt_pk_u8_f32(fmaxf(c * 255.0f, 1.0f), 2, r); return __builtin_amdgcn_cvt_pk_u8_f32(fmaxf(d * 255.0f, 1.0f), 3, r); }
__device__ __forceinline__ float u8f(unsigned w, int i) { return (float)((w >> (8 * i)) & 0xffu); }
__device__ __forceinline__ float fexp2(float x) { return __builtin_amdgcn_exp2f(x); }
__device__ __forceinline__ float frcp(float x) { return __builtin_amdgcn_rcpf(x); }
__device__ __forceinline__ float sigm(float x) { return frcp(1.0f + fexp2(-LOG2E * x)); }

#define XB_TMO      128
#define XB_XCNT(j)  (256  + 64 * (j))
#define XB_XSUB(j)  (1280 + 64 * (j))
#define XB_XGEN(j)  (2304 + 64 * (j))
#define XB_TOP      3328
#define XB_TOPGEN   3392
#define XCD_BAR_WORDS 3456
#define XB_SPIN_CAP (1u << 22)
__device__ __forceinline__ unsigned xb_ld(unsigned* p)              { return __hip_atomic_load(p, __ATOMIC_RELAXED, __HIP_MEMORY_SCOPE_AGENT); }
__device__ __forceinline__ unsigned xb_add(unsigned* p, unsigned v) { return __hip_atomic_fetch_add(p, v, __ATOMIC_RELAXED, __HIP_MEMORY_SCOPE_AGENT); }
__device__ __forceinline__ unsigned xb_xcc_id() { return (unsigned)__builtin_amdgcn_s_getreg((3 << 11) | 20) & 0xFu; }
#define XB_SPIN(cond, bar) do { unsigned _sp = 0; while (cond) { __builtin_amdgcn_s_sleep(1); \
    if ((++_sp & 255u) == 0u) { if (xb_ld(&(bar)[XB_TMO])) break; if (_sp > XB_SPIN_CAP) { atomicAdd(&(bar)[XB_TMO], 1u); break; } } } } while (0)
struct XcdBarrier { unsigned* bar; unsigned x; volatile LAS unsigned* st; };
__device__ __forceinline__ XcdBarrier xcd_barrier_post(unsigned* bar, volatile LAS unsigned* st) {
    XcdBarrier b; b.bar = bar; b.x = xb_xcc_id(); b.st = st;
    if (threadIdx.x == 0) (void)xb_add(&bar[XB_XCNT(b.x)], 1u);
    return b;
}
__device__ __forceinline__ void xcd_barrier_complete(unsigned* bar, unsigned x, unsigned& nloc, unsigned& nx) {
    const unsigned G = gridDim.x * gridDim.y * gridDim.z;
    unsigned sum, cnt, mine, sp = 0u;
    for (;;) {
        sum = 0u; cnt = 0u; mine = 0u;
#pragma unroll
        for (unsigned j = 0; j < 16; ++j) { const unsigned c = xb_ld(&bar[XB_XCNT(j)]); sum += c; cnt += (c > 0u) ? 1u : 0u; mine = (j == x) ? c : mine; }
        if (sum == G) break;
        __builtin_amdgcn_s_sleep(1);
        if ((++sp & 255u) == 0u) { if (xb_ld(&bar[XB_TMO])) break; if (sp > XB_SPIN_CAP) { atomicAdd(&bar[XB_TMO], 1u); break; } }
    }
    nloc = mine > 0u ? mine : 1u; nx = cnt > 0u ? cnt : 1u;
}
__device__ __forceinline__ void xcd_barrier(const XcdBarrier& b) {
    asm volatile("s_waitcnt vmcnt(0)" ::: "memory");
    __syncthreads();
    if (threadIdx.x == 0) {
        unsigned* bar = b.bar;
        __builtin_amdgcn_s_waitcnt(0);
        unsigned nloc = b.st[0], nx = b.st[1];
        if (nloc == 0u) { xcd_barrier_complete(bar, b.x, nloc, nx); b.st[0] = nloc; b.st[1] = nx; }
        const unsigned old = xb_add(&bar[XB_XSUB(b.x)], 1u);
        const unsigned gen = old / nloc;
        if (old + 1u == (gen + 1u) * nloc) {
            __builtin_amdgcn_fence(__ATOMIC_RELEASE, "agent");
            asm volatile("s_waitcnt vmcnt(0)" ::: "memory");
            const unsigned og = xb_add(&bar[XB_TOP], 1u);
            const unsigned tg = og / nx;
            if (og + 1u == (tg + 1u) * nx) xb_add(&bar[XB_TOPGEN], 1u);
            else XB_SPIN(xb_ld(&bar[XB_TOPGEN]) == tg, bar);
            __builtin_amdgcn_fence(__ATOMIC_ACQUIRE, "agent");
            xb_add(&bar[XB_XGEN(b.x)], 1u);
            asm volatile("s_waitcnt vmcnt(0)" ::: "memory");
        } else {
            XB_SPIN(xb_ld(&bar[XB_XGEN(b.x)]) == gen, bar);
            __builtin_amdgcn_fence(__ATOMIC_ACQUIRE, "agent");
            asm volatile("s_waitcnt vmcnt(0)" ::: "memory");
        }
    }
    __syncthreads();
}

__device__ __forceinline__ void soft_arrive(unsigned* cnt, unsigned v) {
    asm volatile("s_waitcnt vmcnt(0)" ::: "memory"); __syncthreads();
    if (threadIdx.x == 0) (void)__hip_atomic_fetch_add(cnt, v, __ATOMIC_RELAXED, __HIP_MEMORY_SCOPE_AGENT);
}
__device__ __forceinline__ void soft_wait(unsigned* cnt, unsigned need) {
    if (threadIdx.x == 0) {
        unsigned sp = 0;
        while (__hip_atomic_load(cnt, __ATOMIC_RELAXED, __HIP_MEMORY_SCOPE_AGENT) < need) { __builtin_amdgcn_s_sleep(2); if (++sp > (1u << 22)) break; }
        __builtin_amdgcn_fence(__ATOMIC_ACQUIRE, "agent");
        asm volatile("s_waitcnt vmcnt(0)" ::: "memory");
    }
    __syncthreads();
}
__device__ __forceinline__ void st_sc1(float* p, float v) { __hip_atomic_store((unsigned*)p, __float_as_uint(v), __ATOMIC_RELAXED, __HIP_MEMORY_SCOPE_AGENT); }
struct Args {
    const float* in[26];
    float* out; unsigned char* ws;
    int ph_lo, ph_hi;
};
enum { I_XP = 0, I_XS, I_CK, I_CV, I_SC, I_SH, I_CP, I_CS, I_REL, I_NG, I_WADA, I_BADA, I_WIN, I_QG, I_KG, I_SINK, I_WCONV, I_BCONV,
       I_WRA, I_BRA, I_WRX, I_BRX, I_LAM, I_WPA, I_WPR, I_WOUT };

struct Frame {
    LAS unsigned char* lds;
    int tid, lane, wave, G, vcu;
    const float* const* in;
    float* out; unsigned char* ws;
};

__device__ __forceinline__ void refresh(Frame& F) {
    int t = threadIdx.x; asm volatile("" : "+v"(t));
    F.tid = t; F.lane = t & 63; F.wave = __builtin_amdgcn_readfirstlane(t >> 6);
}
__device__ __forceinline__ int rel_bucket(int n) { const int big = 16 + (int)(__builtin_amdgcn_logf((float)n * 0.0625f) * (16.0f / 3.0f)); return n < 16 ? n : (big < 31 ? big : 31); }
__device__ const unsigned char BUCKET[128] = {0, 1, 2, 3, 4, 5, 6, 7, 8, 9, 10, 11, 12, 13, 14, 15, 16, 16, 16, 17, 17, 18, 18, 18, 19, 19, 19, 20, 20, 20, 20, 21, 21, 21, 21, 22, 22, 22, 22, 22, 23, 23, 23, 23, 23, 23, 24, 24, 24, 24, 24, 24, 25, 25, 25, 25, 25, 25, 25, 26, 26, 26, 26, 26, 26, 26, 26, 27, 27, 27, 27, 27, 27, 27, 27, 27, 27, 28, 28, 28, 28, 28, 28, 28, 28, 28, 28, 29, 29, 29, 29, 29, 29, 29, 29, 29, 29, 29, 29, 30, 30, 30, 30, 30, 30, 30, 30, 30, 30, 30, 30, 30, 30, 31, 31, 31, 31, 31, 31, 31, 31, 31, 31, 31, 31, 31, 31, 31};

__device__ __forceinline__ void transpose_block(const float* W, int N, int k0, int n0, bf16* WT, int ldk, int drow0, int kofs, LAS float* scr, int lane) {
    f32x4 wv[8];
#pragma unroll
    for (int i = 0; i < 8; ++i) wv[i] = *(const f32x4*)(W + (size_t)(k0 + 8 * i + (lane >> 3)) * N + n0 + 4 * (lane & 7));
#pragma unroll
    for (int i = 0; i < 8; ++i) { LAS float* d = scr + (8 * i + (lane >> 3)) * 33 + 4 * (lane & 7); d[0] = wv[i][0]; d[1] = wv[i][1]; d[2] = wv[i][2]; d[3] = wv[i][3]; }
    LDS_WAIT(); asm volatile("" ::: "memory");
    const int c = lane & 7;
#pragma unroll
    for (int j = 0; j < 4; ++j) { const int n = (lane >> 3) + 8 * j; const LAS float* s = scr + (8 * c) * 33 + n;
        v4u o; o.x = pk2(s[0 * 33], s[1 * 33]); o.y = pk2(s[2 * 33], s[3 * 33]); o.z = pk2(s[4 * 33], s[5 * 33]); o.w = pk2(s[6 * 33], s[7 * 33]);
        *(GAS v4u*)(WT + (size_t)(drow0 + n) * ldk + kofs + k0 + 8 * c) = o; }
    LDS_WAIT(); asm volatile("" ::: "memory");
}
__device__ __forceinline__ int win_row(int n0) {
    if (n0 < 1280) { const int t = n0 >> 8, w = n0 & 255; return (t << 8) + (((w >> 5) & 1) << 7) + ((w >> 6) << 5); }
    if (n0 < 4608) return n0;
    if (n0 < 5632) { const int i = n0 - 4608; return 4608 + ((i >> 7) << 8) + (i & 127); }
    { const int i = n0 - 5632; return 4608 + ((i >> 7) << 8) + 128 + (i & 127); }
}
__device__ __forceinline__ void p0_weights(Frame& F) {
    LAS float* scr = (LAS float*)(F.lds + F.wave * 16384);
    const int gw = F.vcu * NWAVES + F.wave, NGW = F.G * NWAVES;
    bf16* WIN_T = (bf16*)(F.ws + WS_WIN);
    for (int it = gw; it < 16 * 208; it += NGW) { const int kb = it / 208, nb = it % 208; transpose_block(F.in[I_WIN], INW, 64 * kb, 32 * nb, WIN_T, DM, win_row(32 * nb), 0, scr, F.lane); }
}
constexpr int TQ_TR = 200, TQ_ALL = 708;
__device__ __forceinline__ void tail_item(Frame& F, int it) {
    if (it < TQ_TR) {
        LAS float* scr = (LAS float*)(F.lds + F.wave * 16384);
        int r = 8 * it + F.wave;
        bf16* WPP = (bf16*)(F.ws + WS_WPP); bf16* WOUT_T = (bf16*)(F.ws + WS_WOUT);
        if (r < 512) { const int kb = r / 32, nb = r % 32; transpose_block(F.in[I_WPA], DM, 64 * kb, 32 * nb, WPP, 2048, 32 * nb, 0, scr, F.lane); return; } r -= 512;
        if (r < 512) { const int kb = r / 32, nb = r % 32; transpose_block(F.in[I_WPR], DM, 64 * kb, 32 * nb, WPP, 2048, 32 * nb, 1024, scr, F.lane); return; } r -= 512;
        if (r < 512) { const int kb = r / 32, nb = r % 32; transpose_block(F.in[I_WOUT], DM, 64 * kb, 32 * nb, WOUT_T, DM, 32 * nb, 0, scr, F.lane); return; } r -= 512;
        if (r < 32) { const int blk = r >> 1, nb = r & 1; transpose_block(F.in[I_WRA] + blk * 4096, 64, 0, 32 * nb, (bf16*)(F.ws + WS_WRA) + blk * 4096, 64, 32 * nb, 0, scr, F.lane); return; } r -= 32;
        { const int blk = r >> 1, nb = r & 1; transpose_block(F.in[I_WRX] + blk * 4096, 64, 0, 32 * nb, (bf16*)(F.ws + WS_WRX) + blk * 4096, 64, 32 * nb, 0, scr, F.lane); }
        return;
    }
    const int rbase = (it - TQ_TR) * 64 + 8 * F.wave;
    f32x4 v[8]; size_t dsto[8];
#pragma unroll
    for (int i = 0; i < 8; ++i) {
        const int rr = rbase + i, which = rr / 16256, r2 = rr % 16256, bs = r2 / 127, jj = r2 % 127;
        v[i] = ((const f32x4*)F.in[which ? I_CV : I_CK])[((size_t)bs * 128 + jj + 1) * 64 + F.lane];
        dsto[i] = (which ? O_VWS : O_KWS) / 4 + ((size_t)bs * 128 + jj) * 64 + F.lane;
    }
#pragma unroll
    for (int i = 0; i < 8; ++i) ((f32x4*)F.out)[dsto[i]] = v[i];
}

__device__ __forceinline__ void p0_mod_tile(Frame& F, int nt) {
    const float* wada = F.in[I_WADA]; const int lane = F.lane, w = F.wave;
    const int n0 = 16 * nt, kbase = 128 * w;
    f32x4 acc[9];
#pragma unroll
    for (int m = 0; m < 9; ++m) acc[m] = (f32x4){0.f, 0.f, 0.f, 0.f};
    float bvv[4][8];
#pragma unroll
    for (int ks = 0; ks < 4; ++ks)
#pragma unroll
        for (int j = 0; j < 8; ++j) bvv[ks][j] = wada[(size_t)(kbase + 32 * ks + 8 * (lane >> 4) + j) * 3072 + n0 + (lane & 15)];
#pragma unroll
    for (int ks = 0; ks < 4; ++ks) {
        const int k0 = kbase + 32 * ks + 8 * (lane >> 4);
        f32x4 a0[9], a1[9];
#pragma unroll
        for (int m = 0; m < 9; ++m) {
            const int row = 16 * m + (lane & 15);
            const int rr = row < 132 ? row : 131;
            const float* cr = (rr < 4 ? F.in[I_CP] + rr * 1024 : F.in[I_CS] + (rr - 4) * 1024) + k0;
            a0[m] = *(const f32x4*)cr; a1[m] = *(const f32x4*)(cr + 4);
        }
        v4u bw; bw.x = pk2(bvv[ks][0], bvv[ks][1]); bw.y = pk2(bvv[ks][2], bvv[ks][3]); bw.z = pk2(bvv[ks][4], bvv[ks][5]); bw.w = pk2(bvv[ks][6], bvv[ks][7]);
        const bf16x8 bfr = __builtin_bit_cast(bf16x8, bw);
#pragma unroll
        for (int m = 0; m < 9; ++m) {
            const int row = 16 * m + (lane & 15);
            v4u aw; aw.x = pk2(a0[m].x, a0[m].y); aw.y = pk2(a0[m].z, a0[m].w); aw.z = pk2(a1[m].x, a1[m].y); aw.w = pk2(a1[m].z, a1[m].w);
            if (row >= 132) aw = (v4u){0u, 0u, 0u, 0u};
            acc[m] = __builtin_amdgcn_mfma_f32_16x16x32_bf16(__builtin_bit_cast(bf16x8, aw), bfr, acc[m], 0, 0, 0);
        }
    }
    LAS float* part = (LAS float*)F.lds;
#pragma unroll
    for (int m = 0; m < 9; ++m)
#pragma unroll
        for (int r = 0; r < 4; ++r) part[(w * 144 + 16 * m + 4 * (lane >> 4) + r) * 16 + (lane & 15)] = acc[m][r];
    __syncthreads();
    float* mod = (float*)(F.ws + WS_MOD);
    for (int e = F.tid; e < 132 * 16; e += NWAVES * 64) {
        const int row = e >> 4, col = e & 15; float s = F.in[I_BADA][n0 + col];
#pragma unroll
        for (int ww = 0; ww < 8; ++ww) s += part[(ww * 144 + row) * 16 + col];
        st_sc1(&mod[(size_t)row * 3072 + n0 + col], s);
    }
    __syncthreads();
}
__device__ __forceinline__ float wave_sum(float v) {
#pragma unroll
    for (int o = 1; o < 64; o <<= 1) v += __shfl_xor(v, o);
    return v;
}
__device__ __forceinline__ const float* xn_src_row(Frame& F, int m) { return m < MP ? F.in[I_XP] + (size_t)m * DM : F.in[I_XS] + (size_t)(m - MP) * DM; }
__device__ __forceinline__ void p1_xn(Frame& F) {
    const int RPB = (MPAD + F.G - 1) / F.G, rbeg = F.vcu * RPB, rend = (rbeg + RPB < MPAD) ? rbeg + RPB : MPAD;
    const float* mod = (const float*)(F.ws + WS_MOD); bf16* XN = (bf16*)(F.ws + WS_XN);
    const f32x4* gp = (const f32x4*)F.in[I_NG] + F.lane;
    f32x4 gvec[4];
#pragma unroll
    for (int j = 0; j < 4; ++j) gvec[j] = gp[64 * j];
    f32x4 nx[4];
    if (rbeg + F.wave < MALL && rbeg + F.wave < rend) { const f32x4* xr = (const f32x4*)xn_src_row(F, rbeg + F.wave) + F.lane;
#pragma unroll
        for (int j = 0; j < 4; ++j) nx[j] = xr[64 * j]; }
    int mr_c = -1; f32x4 scv[4], shv[4];
#pragma unroll
    for (int j = 0; j < 4; ++j) { scv[j] = (f32x4){0.f, 0.f, 0.f, 0.f}; shv[j] = scv[j]; }
    for (int m = rbeg + F.wave; m < rend; m += NWAVES) {
        GAS unsigned long long* o8 = (GAS unsigned long long*)(XN + (size_t)m * DM) + F.lane;
        if (m >= MALL) {
#pragma unroll
            for (int j = 0; j < 4; ++j) o8[64 * j] = 0ull;
            continue;
        }
        f32x4 v[4];
#pragma unroll
        for (int j = 0; j < 4; ++j) v[j] = nx[j];
        const int mn = m + NWAVES;
        if (mn < MALL && mn < rend) { const f32x4* xr = (const f32x4*)xn_src_row(F, mn) + F.lane;
#pragma unroll
            for (int j = 0; j < 4; ++j) nx[j] = xr[64 * j]; }
        const int mr = m < MP ? (m >> 12) : 4 + (m - MP);
        if (mr != mr_c) {
            const f32x4* sh = (const f32x4*)(mod + (size_t)mr * 3072) + F.lane; const f32x4* sc = sh + 256;
#pragma unroll
            for (int j = 0; j < 4; ++j) { scv[j] = sc[64 * j] + 1.0f; shv[j] = sh[64 * j]; }
            mr_c = mr;
        }
        float s = 0.f;
#pragma unroll
        for (int j = 0; j < 4; ++j) s += (v[j].x * v[j].x + v[j].y * v[j].y) + (v[j].z * v[j].z + v[j].w * v[j].w);
        const float rstd = 1.0f / sqrtf(wave_sum(s) * (1.f / DM) + EPSN);
        unsigned long long ov[4];
#pragma unroll
        for (int j = 0; j < 4; ++j) {
            const f32x4 y = v[j] * rstd * gvec[j] * scv[j] + shv[j];
            ov[j] = (unsigned long long)pk2(y.x, y.y) | ((unsigned long long)pk2(y.z, y.w) << 32);
        }
#pragma unroll
        for (int j = 0; j < 4; ++j) o8[64 * j] = ov[j];
    }
}

struct EpiZ {
    static constexpr bool PERM = true, HAS_MID = false;
    unsigned char* ws; float* out; const float* qg; const float* kg;
    __device__ __forceinline__ void mid(pg8::f32x4 (&)[2][2][4][2], const pg8::Unit&, int, int, int, int) const {}
    __device__ __forceinline__ void operator()(const pg8::f32x4 (&acc)[2][2][4][2], const pg8::Unit& u, int wr, int wc, int fr, int fq) const {
        asm volatile("" : "+v"(fr), "+v"(fq));
        const int pn = u.pn, pm = u.pm;
        const int rloc = wr * 64 + fr;
        const size_t row0 = (size_t)pm * 256 + rloc;
        if (pn < 5) {
            const bool isq = pn < 4;
            const float* gsrc = (isq ? qg : kg) + 8 * fq;
            f32x4 gv[2][2];
#pragma unroll
            for (int bj = 0; bj < 2; ++bj)
#pragma unroll
                for (int n = 0; n < 2; ++n) gv[bj][n] = *(const f32x4*)(gsrc + 32 * bj + 4 * n);
            const float sc = isq ? QSCALE : 1.0f;
            bf16* dst; int ld, colb;
            if (isq) { dst = (pm < 64) ? (bf16*)(out + O_YP) + QM_OFF + row0 * DM : (bf16*)(ws + WS_QT) + (size_t)rloc * DM; ld = DM; colb = (4 * pn + wc) * 64 + 8 * fq; }
            else { dst = (bf16*)(ws + WS_K) + row0 * 256; ld = 256; colb = wc * 64 + 8 * fq; }
#pragma unroll
            for (int ai = 0; ai < 2; ++ai)
#pragma unroll
                for (int m = 0; m < 4; ++m) {
                    float ss = 0.f;
#pragma unroll
                    for (int bj = 0; bj < 2; ++bj)
#pragma unroll
                        for (int n = 0; n < 2; ++n) { const f32x4 x = acc[ai][bj][m][n]; ss += (x[0] * x[0] + x[1] * x[1]) + (x[2] * x[2] + x[3] * x[3]); }
                    ss += __shfl_xor(ss, 16); ss += __shfl_xor(ss, 32);
                    const float rs = sc / sqrtf(ss * (1.0f / 64.0f) + EPSN);
                    bf16* rp = dst + (size_t)(ai * 128 + m * 16) * ld + colb;
#pragma unroll
                    for (int bj = 0; bj < 2; ++bj) {
                        const f32x4 v0 = acc[ai][bj][m][0] * rs * gv[bj][0], v1 = acc[ai][bj][m][1] * rs * gv[bj][1];
                        v4u w; w.x = pg8::cvt_pk_bf16(v0[0], v0[1]); w.y = pg8::cvt_pk_bf16(v0[2], v0[3]); w.z = pg8::cvt_pk_bf16(v1[0], v1[1]); w.w = pg8::cvt_pk_bf16(v1[2], v1[3]);
                        *(v4u*)(rp + 32 * bj) = w;
                        if (!isq) {
                            float* so = nullptr;
                            if (pm < 64 && (pm & 15) == 15 && ai == 1) so = out + O_KWP + ((size_t)(pm >> 4) * 128 + (wr * 64 + m * 16 + fr)) * 256;
                            else if (pm == 64 && ai == 0) so = (float*)(ws + WS_KVNEW) + (size_t)(wr * 64 + m * 16 + fr) * 256;
                            if (so) { so += wc * 64 + 32 * bj + 8 * fq; *(f32x4*)so = v0; *(f32x4*)(so + 4) = v1; }
                        }
                    }
                }
            return;
        }
        if (pn == 5) {
            bf16* dst = (bf16*)(ws + WS_V) + row0 * 256 + 32 * wc + 8 * fq;
#pragma unroll
            for (int ai = 0; ai < 2; ++ai)
#pragma unroll
                for (int m = 0; m < 4; ++m)
#pragma unroll
                    for (int bj = 0; bj < 2; ++bj) {
                        const f32x4 v0 = acc[ai][bj][m][0], v1 = acc[ai][bj][m][1];
                        v4u w; w.x = pg8::cvt_pk_bf16(v0[0], v0[1]); w.y = pg8::cvt_pk_bf16(v0[2], v0[3]); w.z = pg8::cvt_pk_bf16(v1[0], v1[1]); w.w = pg8::cvt_pk_bf16(v1[2], v1[3]);
                        *(v4u*)(dst + (size_t)(ai * 128 + m * 16) * 256 + 128 * bj) = w;
                        float* so = nullptr;
                        if (pm < 64 && (pm & 15) == 15 && ai == 1) so = out + O_VWP + ((size_t)(pm >> 4) * 128 + (wr * 64 + m * 16 + fr)) * 256;
                        else if (pm == 64 && ai == 0) so = (float*)(ws + WS_KVNEW) + 128 * 256 + (size_t)(wr * 64 + m * 16 + fr) * 256;
                        if (so) { so += 128 * bj + 32 * wc + 8 * fq; *(f32x4*)so = v0; *(f32x4*)(so + 4) = v1; }
                    }
            return;
        }
        if (pn < 18) {
            const int seg = (pn - 6) >> 2;
            const int colt = ((pn - 6) & 3) * 256 + 32 * wc + 8 * fq;
            bf16* dst = (bf16*)(ws + (seg == 0 ? WS_SGA : seg == 1 ? WS_XR : WS_SGR)) + row0 * DM + colt;
#pragma unroll
            for (int ai = 0; ai < 2; ++ai)
#pragma unroll
                for (int m = 0; m < 4; ++m)
#pragma unroll
                    for (int bj = 0; bj < 2; ++bj) {
                        f32x4 v0 = acc[ai][bj][m][0], v1 = acc[ai][bj][m][1];
                        if (seg != 1) {
#pragma unroll
                            for (int e = 0; e < 4; ++e) { v0[e] = v0[e] * sigm(v0[e]); v1[e] = v1[e] * sigm(v1[e]); }
                        }
                        v4u w; w.x = pg8::cvt_pk_bf16(v0[0], v0[1]); w.y = pg8::cvt_pk_bf16(v0[2], v0[3]); w.z = pg8::cvt_pk_bf16(v1[0], v1[1]); w.w = pg8::cvt_pk_bf16(v1[2], v1[3]);
                        *(v4u*)(dst + (size_t)(ai * 128 + m * 16) * DM + 128 * bj) = w;
                        if (seg == 1 && pm < 64 && (pm & 15) == 15 && ai == 1 && wr == 1 && m == 3 && fr >= 13) {
                            float* so = out + O_CVP + ((size_t)(pm >> 4) * 3 + (fr - 13)) * DM + colt + 128 * bj;
                            *(f32x4*)so = v0; *(f32x4*)(so + 4) = v1;
                        }
                    }
            return;
        }
        {
            const int colt = (pn - 18) * 128 + 32 * wc + 8 * fq;
            unsigned char* da = ws + WS_RAT + row0 * DM + colt; unsigned char* ds = ws + WS_SMR + row0 * DM + colt;
#pragma unroll
            for (int ai = 0; ai < 2; ++ai)
#pragma unroll
                for (int m = 0; m < 4; ++m) {
                    float sa[8], sm[8];
#pragma unroll
                    for (int n = 0; n < 2; ++n)
#pragma unroll
                        for (int e = 0; e < 4; ++e) { sa[4 * n + e] = sigm(acc[ai][0][m][n][e]); sm[4 * n + e] = sigm(acc[ai][1][m][n][e]); }
                    v2u w; w.x = pk_u8x4(sa[0], sa[1], sa[2], sa[3]); w.y = pk_u8x4(sa[4], sa[5], sa[6], sa[7]);
                    *(v2u*)(da + (size_t)(ai * 128 + m * 16) * DM) = w;
                    w.x = pk_u8x4(sm[0], sm[1], sm[2], sm[3]); w.y = pk_u8x4(sm[4], sm[5], sm[6], sm[7]);
                    *(v2u*)(ds + (size_t)(ai * 128 + m * 16) * DM) = w;
                }
        }
    }
};

struct EpiMerge {
    static constexpr bool PERM = true, HAS_MID = true;
    const unsigned char* sma; const unsigned char* smr; bf16* mg;
    __device__ __forceinline__ void mid(pg8::f32x4 (&acc)[2][2][4][2], const pg8::Unit& u, int wr, int wc, int fr, int fq) const {
        asm volatile("" : "+v"(fr), "+v"(fq));
        const size_t off = ((size_t)u.pm * 256 + wr * 64 + fr) * DM + u.pn * 256 + 32 * wc + 8 * fq;
        v2u ga[16], gr[16];
#pragma unroll
        for (int ai = 0; ai < 2; ++ai)
#pragma unroll
            for (int m = 0; m < 4; ++m)
#pragma unroll
                for (int bj = 0; bj < 2; ++bj) {
                    const size_t o = off + (size_t)(ai * 128 + m * 16) * DM + 128 * bj;
                    ga[(ai * 4 + m) * 2 + bj] = *(const v2u*)(sma + o); gr[(ai * 4 + m) * 2 + bj] = *(const v2u*)(smr + o);
                }
        __builtin_amdgcn_sched_barrier(0);
#pragma unroll
        for (int ai = 0; ai < 2; ++ai)
#pragma unroll
            for (int m = 0; m < 4; ++m)
#pragma unroll
                for (int bj = 0; bj < 2; ++bj) {
                    const v2u a = ga[(ai * 4 + m) * 2 + bj], r = gr[(ai * 4 + m) * 2 + bj];
                    acc[ai][bj][m][0] *= (pg8::f32x4){u8f(a.x, 0) * frcp(u8f(r.x, 0)), u8f(a.x, 1) * frcp(u8f(r.x, 1)), u8f(a.x, 2) * frcp(u8f(r.x, 2)), u8f(a.x, 3) * frcp(u8f(r.x, 3))};
                    acc[ai][bj][m][1] *= (pg8::f32x4){u8f(a.y, 0) * frcp(u8f(r.y, 0)), u8f(a.y, 1) * frcp(u8f(r.y, 1)), u8f(a.y, 2) * frcp(u8f(r.y, 2)), u8f(a.y, 3) * frcp(u8f(r.y, 3))};
                }
    }
    __device__ __forceinline__ void operator()(const pg8::f32x4 (&acc)[2][2][4][2], const pg8::Unit& u, int wr, int wc, int fr, int fq) const {
        asm volatile("" : "+v"(fr), "+v"(fq));
        const size_t off = ((size_t)u.pm * 256 + wr * 64 + fr) * DM + u.pn * 256 + 32 * wc + 8 * fq;
        const float i255 = 1.0f / 255.0f;
        v2u gr[16];
#pragma unroll
        for (int ai = 0; ai < 2; ++ai)
#pragma unroll
            for (int m = 0; m < 4; ++m)
#pragma unroll
                for (int bj = 0; bj < 2; ++bj) gr[(ai * 4 + m) * 2 + bj] = *(const v2u*)(smr + off + (size_t)(ai * 128 + m * 16) * DM + 128 * bj);
        __builtin_amdgcn_sched_barrier(0);
#pragma unroll
        for (int ai = 0; ai < 2; ++ai)
#pragma unroll
            for (int m = 0; m < 4; ++m)
#pragma unroll
                for (int bj = 0; bj < 2; ++bj) {
                    const size_t o = off + (size_t)(ai * 128 + m * 16) * DM + 128 * bj;
                    const v2u r = gr[(ai * 4 + m) * 2 + bj];
                    const pg8::f32x4 v0 = acc[ai][bj][m][0] * ((pg8::f32x4){u8f(r.x, 0), u8f(r.x, 1), u8f(r.x, 2), u8f(r.x, 3)} * i255);
                    const pg8::f32x4 v1 = acc[ai][bj][m][1] * ((pg8::f32x4){u8f(r.y, 0), u8f(r.y, 1), u8f(r.y, 2), u8f(r.y, 3)} * i255);
                    v4u w; w.x = pg8::cvt_pk_bf16(v0[0], v0[1]); w.y = pg8::cvt_pk_bf16(v0[2], v0[3]); w.z = pg8::cvt_pk_bf16(v1[0], v1[1]); w.w = pg8::cvt_pk_bf16(v1[2], v1[3]);
                    *(v4u*)(mg + o) = w;
                }
    }
};
struct EpiOut {
    static constexpr bool PERM = false, HAS_MID = false;
    const float* x; const float* mod; float* y;
    __device__ __forceinline__ void mid(pg8::f32x4 (&)[2][2][4][2], const pg8::Unit&, int, int, int, int) const {}
    __device__ __forceinline__ void operator()(const pg8::f32x4 (&acc)[2][2][4][2], const pg8::Unit& u, int wr, int wc, int fr, int fq) const {
        asm volatile("" : "+v"(fr), "+v"(fq));
        const int col0 = u.pn * 256 + wc * 32 + 4 * fq;
        const float* gp = mod + (size_t)(u.pm >> 4) * 3072 + 2048 + col0;
        f32x4 gv[2][2];
#pragma unroll
        for (int bj = 0; bj < 2; ++bj)
#pragma unroll
            for (int n = 0; n < 2; ++n) gv[bj][n] = *(const f32x4*)(gp + 128 * bj + 16 * n);
#pragma unroll
        for (int ai = 0; ai < 2; ++ai) {
            f32x4 xv[4][2][2];
#pragma unroll
            for (int m = 0; m < 4; ++m) {
                const size_t off = ((size_t)u.pm * 256 + ai * 128 + wr * 64 + m * 16 + fr) * DM + col0;
#pragma unroll
                for (int bj = 0; bj < 2; ++bj)
#pragma unroll
                    for (int n = 0; n < 2; ++n) xv[m][bj][n] = *(const f32x4*)(x + off + 128 * bj + 16 * n);
            }
            __builtin_amdgcn_sched_barrier(0);
#pragma unroll
            for (int m = 0; m < 4; ++m) {
                const size_t off = ((size_t)u.pm * 256 + ai * 128 + wr * 64 + m * 16 + fr) * DM + col0;
#pragma unroll
                for (int bj = 0; bj < 2; ++bj)
#pragma unroll
                    for (int n = 0; n < 2; ++n) *(f32x4*)(y + off + 128 * bj + 16 * n) = xv[m][bj][n] + gv[bj][n] * acc[ai][bj][m][n];
            }
            __builtin_amdgcn_sched_barrier(0);
        }
    }
};

template <int KQ  >
__device__ __forceinline__ f32x4 mini_partial(const bf16* A, const bf16* B) {
    bf16x8 a[KQ], b[KQ];
#pragma unroll
    for (int ks = 0; ks < KQ; ++ks) { a[ks] = *(const bf16x8*)(A + 32 * ks); b[ks] = *(const bf16x8*)(B + 32 * ks); }
    f32x4 acc = (f32x4){0.f, 0.f, 0.f, 0.f};
#pragma unroll
    for (int ks = 0; ks < KQ; ++ks) acc = __builtin_amdgcn_mfma_f32_16x16x32_bf16(a[ks], b[ks], acc, 0, 0, 0);
    return acc;
}
__device__ __forceinline__ void mini_merge_block(Frame& F, int pair) {
    const int lane = F.lane, w = F.wave, tile = 2 * pair + (w >> 2), kq = w & 3, rt = tile >> 6, ct = tile & 63;
    const bf16* A = (const bf16*)(F.ws + WS_YT) + (size_t)(16 * rt + (lane & 15)) * 2048 + 8 * (lane >> 4) + 512 * kq;
    const bf16* B = (const bf16*)(F.ws + WS_WPP) + (size_t)(16 * ct + (lane & 15)) * 2048 + 8 * (lane >> 4) + 512 * kq;
    const f32x4 acc = mini_partial<16>(A, B);
    LAS float* part = (LAS float*)F.lds;
#pragma unroll
    for (int r = 0; r < 4; ++r) part[w * 256 + (4 * (lane >> 4) + r) * 16 + (lane & 15)] = acc[r];
    __syncthreads();
    {
        const int t2 = F.tid >> 8, e = F.tid & 255, row = e >> 4, col = e & 15, tl = 2 * pair + t2, rl = 16 * (tl >> 6) + row, cg = 16 * (tl & 63) + col;
        const LAS float* p = part + t2 * 1024 + e;
        const float sa_ = (float)(F.ws + WS_RAT)[(size_t)(MP + rl) * DM + cg], sr_ = (float)(F.ws + WS_SMR)[(size_t)(MP + rl) * DM + cg];
        const float rat = sa_ / sr_, sm = sr_ * (1.0f / 255.0f);
        const float v = ((p[0] + p[256]) * rat + (p[512] + p[768])) * sm;
        ((bf16*)(F.ws + WS_MGT))[(size_t)rl * DM + cg] = (bf16)f2bf(v);
    }
    __syncthreads();
}
__device__ __forceinline__ void mini_out_block(Frame& F, int pair) {
    const int lane = F.lane, w = F.wave, tile = 2 * pair + (w >> 2), kq = w & 3, rt = tile >> 6, ct = tile & 63;
    const bf16* A = (const bf16*)(F.ws + WS_MGT) + (size_t)(16 * rt + (lane & 15)) * DM + 8 * (lane >> 4) + 256 * kq;
    const bf16* B = (const bf16*)(F.ws + WS_WOUT) + (size_t)(16 * ct + (lane & 15)) * DM + 8 * (lane >> 4) + 256 * kq;
    const f32x4 acc = mini_partial<8>(A, B);
    LAS float* part = (LAS float*)F.lds;
#pragma unroll
    for (int r = 0; r < 4; ++r) part[w * 256 + (4 * (lane >> 4) + r) * 16 + (lane & 15)] = acc[r];
    __syncthreads();
    {
        const int t2 = F.tid >> 8, e = F.tid & 255, row = e >> 4, col = e & 15, tl = 2 * pair + t2, rl = 16 * (tl >> 6) + row, cg = 16 * (tl & 63) + col;
        const LAS float* p = part + t2 * 1024 + e;
        const float* mod = (const float*)(F.ws + WS_MOD);
        F.out[O_YS + (size_t)rl * DM + cg] = F.in[I_XS][(size_t)rl * DM + cg] + mod[(size_t)(4 + rl) * 3072 + 2048 + cg] * ((p[0] + p[256]) + (p[512] + p[768]));
    }
    __syncthreads();
}

struct ChanConst { float w0, w1, w2, w3, bc, bra, brx, c1, nbra, nbrx; };
__device__ __forceinline__ ChanConst chan_const(Frame& F, int ch) {
    ChanConst c; const float* wc = F.in[I_WCONV];
    c.w0 = wc[ch]; c.w1 = wc[DM + ch]; c.w2 = wc[2 * DM + ch]; c.w3 = wc[3 * DM + ch]; c.bc = F.in[I_BCONV][ch];
    c.bra = F.in[I_BRA][ch]; c.brx = F.in[I_BRX][ch];
    c.c1 = -8.0f * log1pf(expf(-F.in[I_LAM][ch])) * LOG2E;
    c.nbra = -LOG2E * c.bra; c.nbrx = -LOG2E * c.brx;
    return c;
}
__device__ __forceinline__ void sample_rnn_unit(Frame& F, int bs, int j);
__device__ __forceinline__ void stage_gate_weights(Frame& F, int j) {
    for (int cidx = F.tid; cidx < 1024; cidx += NWAVES * 64) {
        const int gsel = cidx >> 9, row = (cidx >> 3) & 63, c8 = cidx & 7;
        const v4u v = *(const v4u*)((const bf16*)(F.ws + (gsel ? WS_WRX : WS_WRA)) + j * 4096 + row * 64 + 8 * c8);
        *(LAS v4u*)(F.lds + GW_OFF + (gsel * 64 + row) * GW_STRIDE + 16 * c8) = v;
    }
}
template <int PASS>
__device__ __forceinline__ void scan_unit(Frame& F, int b, int c, int j, LAS unsigned char* wl) {
    const int lane = F.lane, r32 = lane & 31, hi = lane >> 5, ch = 64 * j + lane;
    const ChanConst cc = chan_const(F, ch);
    const bf16* XR = (const bf16*)(F.ws + WS_XR); const bf16* SGR = (const bf16*)(F.ws + WS_SGR);
    float* agg = (float*)(F.ws + WS_AGG);
    bf16* YM = (bf16*)(F.out + O_YP);
    LAS bf16* xt = (LAS bf16*)wl; LAS bf16* st = (LAS bf16*)(wl + 4096); LAS float* gt = (LAS float*)(wl + 8192);
    const size_t rowb = (size_t)b * SEQ + 128 * c;
    const int lrow = lane >> 3, lc8 = lane & 7;
    const bf16* xsrc = XR + (rowb + lrow) * DM + 64 * j + 8 * lc8;
    const bf16* ssrc = SGR + (rowb + lrow) * DM + 64 * j + 8 * lc8;
    v4u xn[4], sn[4];
#pragma unroll
    for (int i = 0; i < 4; ++i) { xn[i] = *(const v4u*)(xsrc + (size_t)(8 * i) * DM); if (PASS == 2) sn[i] = *(const v4u*)(ssrc + (size_t)(8 * i) * DM); }
    float xm3 = 0.f, xm2 = 0.f, xm1 = 0.f;
    if (c > 0) { xm3 = bf2f(XR[(rowb - 3) * DM + ch]); xm2 = bf2f(XR[(rowb - 2) * DM + ch]); xm1 = bf2f(XR[(rowb - 1) * DM + ch]); }
    float h = 0.f, ap = 1.f;
    if (PASS == 2) {
        for (int q = 0; q < c; ++q) { const float a = agg[((size_t)(b * NCH + q) * 2 + 0) * DM + ch], hl = agg[((size_t)(b * NCH + q) * 2 + 1) * DM + ch]; h = a * h + hl; }
    }
    const LAS unsigned char* gwr = F.lds + GW_OFF + r32 * GW_STRIDE + 16 * hi;
    for (int sc = 0; sc < 4; ++sc) {
        const size_t r0 = rowb + 32 * sc;
#pragma unroll
        for (int i = 0; i < 4; ++i) { *(LAS v4u*)(xt + (lrow + 8 * i) * 64 + 8 * lc8) = xn[i]; if (PASS == 2) *(LAS v4u*)(st + (lrow + 8 * i) * 64 + 8 * lc8) = sn[i]; }
        if (sc < 3) {
#pragma unroll
            for (int i = 0; i < 4; ++i) { xn[i] = *(const v4u*)(xsrc + (size_t)(32 * (sc + 1) + 8 * i) * DM); if (PASS == 2) sn[i] = *(const v4u*)(ssrc + (size_t)(32 * (sc + 1) + 8 * i) * DM); }
        }
        LDS_WAIT(); asm volatile("" ::: "memory");
        float xc[32];
#pragma unroll
        for (int t = 0; t < 32; ++t) {
            const float x = bf2f(xt[t * 64 + lane]);
            xc[t] = cc.bc + cc.w0 * xm3 + cc.w1 * xm2 + cc.w2 * xm1 + cc.w3 * x;
            xm3 = xm2; xm2 = xm1; xm1 = x;
            xt[t * 64 + lane] = (bf16)pg8::cvt_pk_bf16(xc[t], 0.f);
        }
        LDS_WAIT(); asm volatile("" ::: "memory");
        bf16x8 af[4];
#pragma unroll
        for (int d0 = 0; d0 < 4; ++d0) af[d0] = *(const LAS bf16x8*)(xt + r32 * 64 + 16 * d0 + 8 * hi);
        float zr[32];
#pragma unroll
        for (int oh = 0; oh < 2; ++oh) {
            f32x16 d = {};
#pragma unroll
            for (int d0 = 0; d0 < 4; ++d0) d = __builtin_amdgcn_mfma_f32_32x32x16_bf16(af[d0], *(const LAS bf16x8*)(gwr + (32 * oh) * GW_STRIDE + 32 * d0), d, 0, 0, 0);
#pragma unroll
            for (int r = 0; r < 16; ++r) gt[((r & 3) + 8 * (r >> 2) + 4 * hi) * 64 + 32 * oh + r32] = d[r];
        }
        LDS_WAIT(); asm volatile("" ::: "memory");
#pragma unroll
        for (int t = 0; t < 32; ++t) zr[t] = gt[t * 64 + lane];
        LDS_WAIT(); asm volatile("" ::: "memory");
#pragma unroll
        for (int oh = 0; oh < 2; ++oh) {
            f32x16 d = {};
#pragma unroll
            for (int d0 = 0; d0 < 4; ++d0) d = __builtin_amdgcn_mfma_f32_32x32x16_bf16(af[d0], *(const LAS bf16x8*)(gwr + (64 + 32 * oh) * GW_STRIDE + 32 * d0), d, 0, 0, 0);
#pragma unroll
            for (int r = 0; r < 16; ++r) gt[((r & 3) + 8 * (r >> 2) + 4 * hi) * 64 + 32 * oh + r32] = d[r];
        }
        LDS_WAIT(); asm volatile("" ::: "memory");
#pragma unroll
        for (int t = 0; t < 32; ++t) {
            const float zi = gt[t * 64 + lane];
            const float rg = frcp(1.0f + fexp2(__builtin_fmaf(zr[t], -LOG2E, cc.nbra))), ig = frcp(1.0f + fexp2(__builtin_fmaf(zi, -LOG2E, cc.nbrx)));
            const float a = fexp2(cc.c1 * rg);
            const float s = __builtin_amdgcn_sqrtf(__builtin_fmaf(-a, a, 1.0f));
            const float uu = s * ig * xc[t];
            h = a * h + uu;
            if (PASS == 1) ap *= a;
            if (PASS == 2) st[t * 64 + lane] = (bf16)pg8::cvt_pk_bf16(h * bf2f(st[t * 64 + lane]), 0.f);
        }
        LDS_WAIT(); asm volatile("" ::: "memory");
        if (PASS == 2) {
#pragma unroll
            for (int i = 0; i < 4; ++i) *(v4u*)(YM + (r0 + lrow + 8 * i) * DM + 64 * j + 8 * lc8) = *(const LAS v4u*)(st + (lrow + 8 * i) * 64 + 8 * lc8);
            LDS_WAIT(); asm volatile("" ::: "memory");
        }
    }
    if (PASS == 1) { st_sc1(&agg[((size_t)(b * NCH + c) * 2 + 0) * DM + ch], ap); st_sc1(&agg[((size_t)(b * NCH + c) * 2 + 1) * DM + ch], h); }
    if (PASS == 2 && c == NCH - 1) F.out[O_HP + (size_t)b * DM + ch] = h;
}
typedef GAS unsigned long long gu64;
__device__ __forceinline__ void gr_store(unsigned long long* g, float v) { __hip_atomic_store(g, (1ull << 32) | (unsigned long long)__float_as_uint(v), __ATOMIC_RELAXED, __HIP_MEMORY_SCOPE_AGENT); }
__device__ __forceinline__ unsigned long long gr_load(unsigned long long* g) { return __hip_atomic_load(g, __ATOMIC_RELAXED, __HIP_MEMORY_SCOPE_AGENT); }
__device__ __forceinline__ void scan_lb_block(Frame& F, int bu) {
    const int j = bu & 15, ib = (bu >> 4) & 3, b = bu >> 6, w = F.wave, q = 8 * ib + w;
    stage_gate_weights(F, j);
    LDS_WAIT(); __syncthreads();
    sample_rnn_unit(F, (bu >> 4) * 8 + w, j);
    const int lane = F.lane, r32 = lane & 31, hi = lane >> 5, ch = 64 * j + lane;
    LAS unsigned char* wl = F.lds + w * 16384;
    const ChanConst cc = chan_const(F, ch);
    const bf16* XR = (const bf16*)(F.ws + WS_XR); const bf16* SGR = (const bf16*)(F.ws + WS_SGR);
    bf16* YM = (bf16*)(F.out + O_YP);
    LAS bf16* xt = (LAS bf16*)wl; LAS bf16* st = (LAS bf16*)(wl + 4096); LAS float* gt = (LAS float*)(wl + 8192);
    LAS float* xch = (LAS float*)(F.lds + BT_OFF);
    unsigned long long* lba = (unsigned long long*)(F.ws + WS_LBA) + ((size_t)(b * 16 + j) * 16) * 128 + lane;
    unsigned long long* lbh = (unsigned long long*)(F.ws + WS_LBH) + ((size_t)(b * 16 + j) * 4) * 64 + lane;
    const int lrow = lane >> 3, lc8 = lane & 7;
    const size_t row0 = (size_t)b * SEQ + 32 * q;
    const bf16* xsrc = XR + (row0 + lrow) * DM + 64 * j + 8 * lc8;
    const bf16* ssrc = SGR + (row0 + lrow) * DM + 64 * j + 8 * lc8;
    v4u xn[4], sn[4];
#pragma unroll
    for (int i = 0; i < 4; ++i) { xn[i] = *(const v4u*)(xsrc + (size_t)(8 * i) * DM); sn[i] = *(const v4u*)(ssrc + (size_t)(8 * i) * DM); }
    float hx3 = 0.f, hx2 = 0.f, hx1 = 0.f;
    if (q > 0) { hx3 = bf2f(XR[(row0 - 3) * DM + ch]); hx2 = bf2f(XR[(row0 - 2) * DM + ch]); hx1 = bf2f(XR[(row0 - 1) * DM + ch]); }
    const LAS unsigned char* gwr = F.lds + GW_OFF + r32 * GW_STRIDE + 16 * hi;
    for (int r = 0; r < 4; ++r) {
        const size_t r0 = row0 + 1024 * r;
#pragma unroll
        for (int i = 0; i < 4; ++i) { *(LAS v4u*)(xt + (lrow + 8 * i) * 64 + 8 * lc8) = xn[i]; *(LAS v4u*)(st + (lrow + 8 * i) * 64 + 8 * lc8) = sn[i]; }
        float xm3 = hx3, xm2 = hx2, xm1 = hx1;
        if (r < 3) {
#pragma unroll
            for (int i = 0; i < 4; ++i) { xn[i] = *(const v4u*)(xsrc + (size_t)(1024 * (r + 1) + 8 * i) * DM); sn[i] = *(const v4u*)(ssrc + (size_t)(1024 * (r + 1) + 8 * i) * DM); }
            hx3 = bf2f(XR[(r0 + 1024 - 3) * DM + ch]); hx2 = bf2f(XR[(r0 + 1024 - 2) * DM + ch]); hx1 = bf2f(XR[(r0 + 1024 - 1) * DM + ch]);
        }
        LDS_WAIT(); asm volatile("" ::: "memory");
        float xc[32];
#pragma unroll
        for (int t = 0; t < 32; ++t) {
            const float x = bf2f(xt[t * 64 + lane]);
            xc[t] = cc.bc + cc.w0 * xm3 + cc.w1 * xm2 + cc.w2 * xm1 + cc.w3 * x;
            xm3 = xm2; xm2 = xm1; xm1 = x;
            xt[t * 64 + lane] = (bf16)pg8::cvt_pk_bf16(xc[t], 0.f);
        }
        LDS_WAIT(); asm volatile("" ::: "memory");
        bf16x8 af[4];
#pragma unroll
        for (int d0 = 0; d0 < 4; ++d0) af[d0] = *(const LAS bf16x8*)(xt + r32 * 64 + 16 * d0 + 8 * hi);
        float av[32], uv[32];
#pragma unroll
        for (int oh = 0; oh < 2; ++oh) {
            f32x16 d = {};
#pragma unroll
            for (int d0 = 0; d0 < 4; ++d0) d = __builtin_amdgcn_mfma_f32_32x32x16_bf16(af[d0], *(const LAS bf16x8*)(gwr + (32 * oh) * GW_STRIDE + 32 * d0), d, 0, 0, 0);
#pragma unroll
            for (int g4 = 0; g4 < 4; ++g4) *(LAS f32x4*)(gt + (32 * oh + r32) * 32 + (((2 * g4 + hi) ^ (((32 * oh + r32) >> 1) & 7)) << 2)) = (f32x4){d[4 * g4], d[4 * g4 + 1], d[4 * g4 + 2], d[4 * g4 + 3]};
        }
        LDS_WAIT(); asm volatile("" ::: "memory");
#pragma unroll
        for (int c = 0; c < 8; ++c) { const f32x4 v4 = *(const LAS f32x4*)(gt + lane * 32 + ((c ^ ((lane >> 1) & 7)) << 2)); av[4 * c] = v4[0]; av[4 * c + 1] = v4[1]; av[4 * c + 2] = v4[2]; av[4 * c + 3] = v4[3]; }
        LDS_WAIT(); asm volatile("" ::: "memory");
#pragma unroll
        for (int oh = 0; oh < 2; ++oh) {
            f32x16 d = {};
#pragma unroll
            for (int d0 = 0; d0 < 4; ++d0) d = __builtin_amdgcn_mfma_f32_32x32x16_bf16(af[d0], *(const LAS bf16x8*)(gwr + (64 + 32 * oh) * GW_STRIDE + 32 * d0), d, 0, 0, 0);
#pragma unroll
            for (int g4 = 0; g4 < 4; ++g4) *(LAS f32x4*)(gt + (32 * oh + r32) * 32 + (((2 * g4 + hi) ^ (((32 * oh + r32) >> 1) & 7)) << 2)) = (f32x4){d[4 * g4], d[4 * g4 + 1], d[4 * g4 + 2], d[4 * g4 + 3]};
        }
        LDS_WAIT(); asm volatile("" ::: "memory");
        float hl = 0.f, ap = 1.f;
        typedef float f2 __attribute__((ext_vector_type(2)));
#pragma unroll
        for (int c = 0; c < 8; ++c) {
            const f32x4 z4 = *(const LAS f32x4*)(gt + lane * 32 + ((c ^ ((lane >> 1) & 7)) << 2));
#pragma unroll
            for (int p = 0; p < 2; ++p) {
                const int t = 4 * c + 2 * p;
                const f2 zr2 = {av[t], av[t + 1]}, zi2 = {z4[2 * p], z4[2 * p + 1]}, xc2 = {xc[t], xc[t + 1]};
                f2 er = zr2 * (-LOG2E) + cc.nbra, ei = zi2 * (-LOG2E) + cc.nbrx;
                er = (f2){fexp2(er.x), fexp2(er.y)} + 1.0f; ei = (f2){fexp2(ei.x), fexp2(ei.y)} + 1.0f;
                const f2 rg = {frcp(er.x), frcp(er.y)}, ig = {frcp(ei.x), frcp(ei.y)};
                const f2 la = rg * cc.c1;
                const f2 a2 = {fexp2(la.x), fexp2(la.y)};
                const f2 om = 1.0f - a2 * a2;
                const f2 sq = {__builtin_amdgcn_sqrtf(om.x), __builtin_amdgcn_sqrtf(om.y)};
                const f2 u2 = sq * ig * xc2;
                av[t] = a2.x; av[t + 1] = a2.y; uv[t] = u2.x; uv[t + 1] = u2.y;
                hl = a2.x * hl + u2.x; hl = a2.y * hl + u2.y; ap *= a2.x * a2.y;
            }
        }
        LAS float* xw = xch + (r & 1) * 1024;
        xw[(w * 2 + 0) * 64 + lane] = ap; xw[(w * 2 + 1) * 64 + lane] = hl;
        LDS_WAIT(); __syncthreads();
        float pa = 1.f, ph = 0.f;
        for (int k = 0; k < w; ++k) { const float ak = xw[(k * 2 + 0) * 64 + lane], hk = xw[(k * 2 + 1) * 64 + lane]; ph = ak * ph + hk; pa = ak * pa; }
        if (w == 7 && ib < 3) { gr_store(lba + (size_t)(r * 4 + ib) * 128, ap * pa); gr_store(lba + (size_t)(r * 4 + ib) * 128 + 64, ap * ph + hl); }
        float hin = 0.f;
        {
            unsigned long long gh = (1ull << 32), ga[3] = {1ull << 32, 1ull << 32, 1ull << 32}, gb[3] = {1ull << 32, 1ull << 32, 1ull << 32};
            unsigned sp = 0;
            for (;;) {
                if (r > 0) gh = gr_load(lbh + (size_t)(r - 1) * 64);
#pragma unroll
                for (int k = 0; k < 3; ++k) if (k < ib) { ga[k] = gr_load(lba + (size_t)(r * 4 + k) * 128); gb[k] = gr_load(lba + (size_t)(r * 4 + k) * 128 + 64); }
                bool ok = (gh >> 32) == 1ull;
#pragma unroll
                for (int k = 0; k < 3; ++k) ok = ok && (ga[k] >> 32) == 1ull && (gb[k] >> 32) == 1ull;
                if (__all(ok)) break;
                __builtin_amdgcn_s_sleep(2);
                if (++sp > (1u << 20)) break;
            }
            if (r > 0) hin = __uint_as_float((unsigned)gh);
#pragma unroll
            for (int k = 0; k < 3; ++k) if (k < ib) hin = __uint_as_float((unsigned)ga[k]) * hin + __uint_as_float((unsigned)gb[k]);
            hin = pa * hin + ph;
        }
        float h = hin;
#pragma unroll
        for (int t = 0; t < 32; ++t) {
            h = av[t] * h + uv[t];
            st[t * 64 + lane] = (bf16)pg8::cvt_pk_bf16(h * bf2f(st[t * 64 + lane]), 0.f);
        }
        LDS_WAIT(); asm volatile("" ::: "memory");
#pragma unroll
        for (int i = 0; i < 4; ++i) *(v4u*)(YM + (r0 + lrow + 8 * i) * DM + 64 * j + 8 * lc8) = *(const LAS v4u*)(st + (lrow + 8 * i) * 64 + 8 * lc8);
        if (q == 31) { if (r < 3) gr_store(lbh + (size_t)r * 64, h); else F.out[O_HP + (size_t)b * DM + ch] = h; }
        LDS_WAIT(); asm volatile("" ::: "memory");
    }
    __syncthreads();
}
template <int PASS>
__device__ __forceinline__ void scan_block(Frame& F, int bu) {
    const int j = bu & 15, ub = (bu >> 4) * 8 + F.wave;
    stage_gate_weights(F, j);
    LDS_WAIT(); __syncthreads();
    if (PASS == 1) sample_rnn_unit(F, ub, j);
    scan_unit<PASS>(F, ub >> 5, ub & 31, j, F.lds + F.wave * 16384);
    __syncthreads();
}
__device__ __forceinline__ void sample_rnn_unit(Frame& F, int bs, int j) {
    const int lane = F.lane, ch = 64 * j + lane;
    const ChanConst cc = chan_const(F, ch);
    const float* scv = F.in[I_SC] + (size_t)bs * 3 * DM;
    const float x0 = scv[ch], x1 = scv[DM + ch], x2 = scv[2 * DM + ch];
    const float x3 = bf2f(((const bf16*)(F.ws + WS_XR))[(size_t)(MP + bs) * DM + ch]);
    const float h0 = F.in[I_SH][(size_t)bs * DM + ch];
    const float sg = bf2f(((const bf16*)(F.ws + WS_SGR))[(size_t)(MP + bs) * DM + ch]);
    const float xc = cc.bc + cc.w0 * x0 + cc.w1 * x1 + cc.w2 * x2 + cc.w3 * x3;
    const int xci = __float_as_int(xc);
    const LAS unsigned char* gw = F.lds + GW_OFF + lane * GW_STRIDE;
    float zr = 0.f, zi = 0.f;
#pragma unroll
    for (int k8 = 0; k8 < 8; ++k8) {
        const v4u wr4 = *(const LAS v4u*)(gw + 16 * k8), wi4 = *(const LAS v4u*)(gw + 64 * GW_STRIDE + 16 * k8);
        const unsigned wrw[4] = {wr4.x, wr4.y, wr4.z, wr4.w}, wiw[4] = {wi4.x, wi4.y, wi4.z, wi4.w};
#pragma unroll
        for (int e = 0; e < 4; ++e) {
            const float xa = __int_as_float(__builtin_amdgcn_readlane(xci, 8 * k8 + 2 * e)), xb = __int_as_float(__builtin_amdgcn_readlane(xci, 8 * k8 + 2 * e + 1));
            zr += xa * bflo(wrw[e]); zr += xb * bfhi(wrw[e]); zi += xa * bflo(wiw[e]); zi += xb * bfhi(wiw[e]);
        }
    }
    const float rg = sigm(zr + cc.bra), ig = sigm(zi + cc.brx);
    const float a = fexp2(cc.c1 * rg);
    const float sq = sqrtf(fmaxf(1.0f - a * a, 0.f));
    const float h = a * h0 + sq * ig * xc;
    F.out[O_HS + (size_t)bs * DM + ch] = h;
    float* cv = F.out + O_CVS + (size_t)bs * 3 * DM;
    cv[ch] = x1; cv[DM + ch] = x2; cv[2 * DM + ch] = x3;
    ((bf16*)(F.ws + WS_YT))[(size_t)bs * 2048 + 1024 + ch] = (bf16)f2bf(h * sg);
}

__device__ __forceinline__ float logit_bound(Frame& F) {
    float mq = fabsf(F.in[I_QG][F.lane]), mk = fabsf(F.in[I_KG][F.lane]), mb = 0.f;
#pragma unroll
    for (int i = 0; i < 8; ++i) mb = fmaxf(mb, fabsf(F.in[I_REL][F.lane + 64 * i]));
#pragma unroll
    for (int o = 1; o < 64; o <<= 1) { mq = fmaxf(mq, __shfl_xor(mq, o)); mk = fmaxf(mk, __shfl_xor(mk, o)); mb = fmaxf(mb, __shfl_xor(mb, o)); }
    return (8.0f * mq * mk + mb) * LOG2E;
}

__device__ __forceinline__ void build_bias_table(Frame& F) {
    LAS float* bt = (LAS float*)(F.lds + BT_OFF);
    float rv[4];
#pragma unroll
    for (int i = 0; i < 4; ++i) { const int e = F.tid + 512 * i; rv[i] = F.in[I_REL][rel_bucket(e & 127) * 16 + (e >> 7)]; }
#pragma unroll
    for (int i = 0; i < 4; ++i) bt[F.tid + 512 * i] = rv[i] * LOG2E;
}
__device__ __forceinline__ void sample_attn_block(Frame& F, int pair, float M0) {
    const int lane = F.lane, w = F.wave, u = 2 * pair + (w >> 2), bs = u >> 2, g = u & 3, kq = w & 3;
    const int dch = lane & 15, ksub = lane >> 4;
    const LAS float* bt = (const LAS float*)(F.lds + BT_OFF);
    LAS float* part = (LAS float*)F.lds;
    const bf16* QT = (const bf16*)(F.ws + WS_QT) + (size_t)bs * DM + g * 256;
    float q[4][4];
#pragma unroll
    for (int hh = 0; hh < 4; ++hh) { const v2u qq = *(const v2u*)(QT + hh * 64 + 4 * dch); q[hh][0] = bflo(qq.x); q[hh][1] = bfhi(qq.x); q[hh][2] = bflo(qq.y); q[hh][3] = bfhi(qq.y); }
    const float* ck = F.in[I_CK] + (((size_t)bs * 128 + 32 * kq + ksub) * 4 + g) * 64 + 4 * dch;
    const float* cv = F.in[I_CV] + (((size_t)bs * 128 + 32 * kq + ksub) * 4 + g) * 64 + 4 * dch;
    f32x4 kv[8], vv[8];
#pragma unroll
    for (int i = 0; i < 8; ++i) kv[i] = *(const f32x4*)(ck + (size_t)i * 1024);
#pragma unroll
    for (int i = 0; i < 8; ++i) vv[i] = *(const f32x4*)(cv + (size_t)i * 1024);
    float l[4] = {0.f, 0.f, 0.f, 0.f}; float o[4][4];
#pragma unroll
    for (int hh = 0; hh < 4; ++hh)
#pragma unroll
        for (int e = 0; e < 4; ++e) o[hh][e] = 0.f;
#pragma unroll
    for (int i = 0; i < 8; ++i) {
        const int key = 32 * kq + 4 * i + ksub;
#pragma unroll
        for (int hh = 0; hh < 4; ++hh) {
            float sdot = (kv[i][0] * q[hh][0] + kv[i][1] * q[hh][1]) + (kv[i][2] * q[hh][2] + kv[i][3] * q[hh][3]);
            sdot += __shfl_xor(sdot, 1); sdot += __shfl_xor(sdot, 2); sdot += __shfl_xor(sdot, 4); sdot += __shfl_xor(sdot, 8);
            const float ev = (key >= 1) ? fexp2(sdot + bt[(4 * g + hh) * 128 + ((128 - key) & 127)] - M0) : 0.f;
            l[hh] += ev;
#pragma unroll
            for (int e = 0; e < 4; ++e) o[hh][e] += ev * vv[i][e];
        }
    }
#pragma unroll
    for (int hh = 0; hh < 4; ++hh) {
        l[hh] += __shfl_xor(l[hh], 16); l[hh] += __shfl_xor(l[hh], 32);
#pragma unroll
        for (int e = 0; e < 4; ++e) { o[hh][e] += __shfl_xor(o[hh][e], 16); o[hh][e] += __shfl_xor(o[hh][e], 32); }
    }
    if (ksub == 0) {
#pragma unroll
        for (int hh = 0; hh < 4; ++hh) *(LAS f32x4*)(part + (w * 4 + hh) * 64 + 4 * dch) = (f32x4){o[hh][0], o[hh][1], o[hh][2], o[hh][3]};
    }
    if (lane < 4) part[8 * 256 + w * 4 + lane] = (lane == 0) ? l[0] : (lane == 1) ? l[1] : (lane == 2) ? l[2] : l[3];
    LDS_WAIT(); __syncthreads();
    if (kq == 0) {
        const float* kn = (const float*)(F.ws + WS_KVNEW) + (size_t)bs * 256 + g * 64; const float* vn = kn + 128 * 256;
        const float knew = kn[lane], vnew = vn[lane];
        const bf16* sga = (const bf16*)(F.ws + WS_SGA) + (size_t)(MP + bs) * DM + g * 256;
        bf16* yt = (bf16*)(F.ws + WS_YT) + (size_t)bs * 2048 + g * 256;
        float qh[4], sgv[4], snk[4];
#pragma unroll
        for (int hh = 0; hh < 4; ++hh) { qh[hh] = bf2f(QT[hh * 64 + lane]); sgv[hh] = bf2f(sga[hh * 64 + lane]); snk[hh] = F.in[I_SINK][4 * g + hh]; }
        float res[4];
#pragma unroll
        for (int hh = 0; hh < 4; ++hh) {
            float sn = qh[hh] * knew;
#pragma unroll
            for (int ofs = 1; ofs < 64; ofs <<= 1) sn += __shfl_xor(sn, ofs);
            const float en = fexp2(sn + bt[(4 * g + hh) * 128] - M0);
            float osum = 0.f, lsum = 0.f;
#pragma unroll
            for (int k4 = 0; k4 < 4; ++k4) { osum += part[((w + k4) * 4 + hh) * 64 + lane]; lsum += part[8 * 256 + (w + k4) * 4 + hh]; }
            const float den = lsum + en + fexp2(snk[hh] * LOG2E - M0);
            res[hh] = (osum + en * vnew) / den * sgv[hh];
        }
        F.out[O_KWS + (((size_t)bs * 128 + 127) * 4 + g) * 64 + lane] = knew; F.out[O_VWS + (((size_t)bs * 128 + 127) * 4 + g) * 64 + lane] = vnew;
#pragma unroll
        for (int hh = 0; hh < 4; ++hh) yt[hh * 64 + lane] = (bf16)f2bf(res[hh]);
    }
    LDS_WAIT(); __syncthreads();
}

constexpr int KT_STRIDE = 144;
constexpr int VT_STRIDE = 520;
constexpr int AT_K = 0, AT_V = 256 * KT_STRIDE, AT_T = AT_V + 64 * VT_STRIDE, AT_END = AT_T + 4 * 384 * 4;
static_assert(AT_END <= RING_BYTES, "attention LDS");
struct KVRegs { v4u k[4], v[4]; };
__device__ __forceinline__ void attn_load_kv(Frame& F, int b, int n, int g, KVRegs& r) {
    const bf16* Kb = (const bf16*)(F.ws + WS_K); const bf16* Vb = (const bf16*)(F.ws + WS_V);
    const long krow0 = (long)b * SEQ + 128 * (n - 1);
#pragma unroll
    for (int i = 0; i < 4; ++i) {
        const int cidx = F.tid + 512 * i; int kl = cidx >> 3; const int c8 = cidx & 7;
        if (n == 0 && kl < 128) kl += 128;
        const size_t off = (size_t)(krow0 + kl) * 256 + g * 64 + 8 * c8;
        r.k[i] = *(const v4u*)(Kb + off); r.v[i] = *(const v4u*)(Vb + off);
    }
}
__device__ __forceinline__ void attn_store_kv(Frame& F, const KVRegs& r) {
    LAS unsigned char* L = F.lds;
#pragma unroll
    for (int i = 0; i < 4; ++i) {
        const int cidx = F.tid + 512 * i, kl = cidx >> 3, c8 = cidx & 7;
        *(LAS v4u*)(L + AT_K + kl * KT_STRIDE + 16 * c8) = r.k[i];
        LAS bf16* vt = (LAS bf16*)(L + AT_V) + kl;
        const unsigned ww[4] = {r.v[i].x, r.v[i].y, r.v[i].z, r.v[i].w};
#pragma unroll
        for (int e = 0; e < 4; ++e) { vt[(8 * c8 + 2 * e) * (VT_STRIDE / 2)] = (bf16)(ww[e] & 0xffffu); vt[(8 * c8 + 2 * e + 1) * (VT_STRIDE / 2)] = (bf16)(ww[e] >> 16); }
    }
}
__device__ __forceinline__ void attn_compute(Frame& F, int b, int n, int g, float M0) {
    const int lane = F.lane, r32 = lane & 31, hi = lane >> 5, w = F.wave;
    LAS unsigned char* L = F.lds;
    const int hq = w >> 1, head = 4 * g + hq;
    const bf16* Q = (const bf16*)(F.out + O_YP) + QM_OFF;
    const bf16* SGA = (const bf16*)(F.ws + WS_SGA);
    bf16* YM = (bf16*)(F.ws + WS_XN);
    const float sinkv = fexp2(F.in[I_SINK][head] * LOG2E - M0);
    const unsigned onew = (r32 == 0 || r32 == 4) ? 0x3f803f80u : 0u;
    const bf16x8 onesf = __builtin_bit_cast(bf16x8, (v4u){onew, onew, onew, onew});
    for (int sb = 0; sb < 2; ++sb) {
        const int s = 2 * (w & 1) + sb;
        const size_t qrow = (size_t)b * SEQ + 128 * n + 32 * s + r32;
        bf16x8 qf[4];
#pragma unroll
        for (int d0 = 0; d0 < 4; ++d0) qf[d0] = *(const bf16x8*)(Q + qrow * DM + head * 64 + 16 * d0 + 8 * hi);
        const bf16* sg = SGA + qrow * DM + head * 64 + 4 * hi;
        v2u sgw[8];
#pragma unroll
        for (int q4 = 0; q4 < 4; ++q4) { sgw[q4] = *(const v2u*)(sg + 8 * q4); sgw[4 + q4] = *(const v2u*)(sg + 32 + 8 * q4); }
        f32x16 o0 = {}, o1 = {}, o2 = {};
        for (int kk = 0; kk < 3; ++kk) {
            const int kt = (s >> 1) + kk;
            if (n == 0 && kt < 2) continue;
            f32x16 p0 = {}, p1 = {};
            const LAS unsigned char* kb = L + AT_K + (64 * kt + r32) * KT_STRIDE + 16 * hi;
#pragma unroll
            for (int d0 = 0; d0 < 4; ++d0) {
                const bf16x8 a0 = *(const LAS bf16x8*)(kb + 32 * d0);
                const bf16x8 a1 = *(const LAS bf16x8*)(kb + 32 * KT_STRIDE + 32 * d0);
                p0 = __builtin_amdgcn_mfma_f32_32x32x16_bf16(a0, qf[d0], p0, 0, 0, 0);
                p1 = __builtin_amdgcn_mfma_f32_32x32x16_bf16(a1, qf[d0], p1, 0, 0, 0);
            }
            const int dbase = 128 + 32 * s + r32 - 64 * kt - 4 * hi;
            const LAS float* tb = (const LAS float*)(L + AT_T) + hq * 384 + 128 + dbase - 59;
#pragma unroll
            for (int r = 0; r < 16; ++r) {
                const int c = (r & 3) + 8 * (r >> 2);
                p0[r] = fexp2(p0[r] + tb[59 - c]); p1[r] = fexp2(p1[r] + tb[27 - c]);
            }
            const LAS unsigned char* vb = L + AT_V + r32 * VT_STRIDE + (64 * kt + 4 * hi) * 2;
#pragma unroll
            for (int ks = 0; ks < 4; ++ks) {
                v4u pw;
                if (ks == 0)      { pw.x = pg8::cvt_pk_bf16(p0[0], p0[1]);   pw.y = pg8::cvt_pk_bf16(p0[2], p0[3]);   pw.z = pg8::cvt_pk_bf16(p0[4], p0[5]);   pw.w = pg8::cvt_pk_bf16(p0[6], p0[7]); }
                else if (ks == 1) { pw.x = pg8::cvt_pk_bf16(p0[8], p0[9]);   pw.y = pg8::cvt_pk_bf16(p0[10], p0[11]); pw.z = pg8::cvt_pk_bf16(p0[12], p0[13]); pw.w = pg8::cvt_pk_bf16(p0[14], p0[15]); }
                else if (ks == 2) { pw.x = pg8::cvt_pk_bf16(p1[0], p1[1]);   pw.y = pg8::cvt_pk_bf16(p1[2], p1[3]);   pw.z = pg8::cvt_pk_bf16(p1[4], p1[5]);   pw.w = pg8::cvt_pk_bf16(p1[6], p1[7]); }
                else              { pw.x = pg8::cvt_pk_bf16(p1[8], p1[9]);   pw.y = pg8::cvt_pk_bf16(p1[10], p1[11]); pw.z = pg8::cvt_pk_bf16(p1[12], p1[13]); pw.w = pg8::cvt_pk_bf16(p1[14], p1[15]); }
                const bf16x8 pb = __builtin_bit_cast(bf16x8, pw);
                const v2u va0 = *(const LAS v2u*)(vb + 32 * ks), va1 = *(const LAS v2u*)(vb + 32 * ks + 16);
                const v2u vc0 = *(const LAS v2u*)(vb + 32 * VT_STRIDE + 32 * ks), vc1 = *(const LAS v2u*)(vb + 32 * VT_STRIDE + 32 * ks + 16);
                const bf16x8 fa = __builtin_bit_cast(bf16x8, (v4u){va0.x, va0.y, va1.x, va1.y});
                const bf16x8 fc = __builtin_bit_cast(bf16x8, (v4u){vc0.x, vc0.y, vc1.x, vc1.y});
                o0 = __builtin_amdgcn_mfma_f32_32x32x16_bf16(fa, pb, o0, 0, 0, 0);
                o1 = __builtin_amdgcn_mfma_f32_32x32x16_bf16(fc, pb, o1, 0, 0, 0);
                o2 = __builtin_amdgcn_mfma_f32_32x32x16_bf16(onesf, pb, o2, 0, 0, 0);
            }
        }
        const float inv = 1.0f / (o2[0] + sinkv);
        bf16* yo = YM + qrow * DM + head * 64 + 4 * hi;
#pragma unroll
        for (int q4 = 0; q4 < 4; ++q4) {
            {
                const v2u sw = sgw[q4];
                v2u ow; ow.x = pg8::cvt_pk_bf16(o0[4 * q4] * inv * bflo(sw.x), o0[4 * q4 + 1] * inv * bfhi(sw.x)); ow.y = pg8::cvt_pk_bf16(o0[4 * q4 + 2] * inv * bflo(sw.y), o0[4 * q4 + 3] * inv * bfhi(sw.y));
                *(v2u*)(yo + 8 * q4) = ow;
            }
            {
                const v2u sw = sgw[4 + q4];
                v2u ow; ow.x = pg8::cvt_pk_bf16(o1[4 * q4] * inv * bflo(sw.x), o1[4 * q4 + 1] * inv * bfhi(sw.x)); ow.y = pg8::cvt_pk_bf16(o1[4 * q4 + 2] * inv * bflo(sw.y), o1[4 * q4 + 3] * inv * bfhi(sw.y));
                *(v2u*)(yo + 32 + 8 * q4) = ow;
            }
        }
    }
}
__device__ __forceinline__ void attn_phase(Frame& F, float M0) {
    const int NU = NB * 32 * 4;
    int u = blockIdx.x; if (u >= NU) return;
    KVRegs r; attn_load_kv(F, u >> 7, (u >> 2) & 31, u & 3, r);
    for (; u < NU; u += F.G) {
        attn_store_kv(F, r);
        {
            const int g_ = u & 3; LAS float* tb = (LAS float*)(F.lds + AT_T);
            float rv[3];
#pragma unroll
            for (int i = 0; i < 3; ++i) { const int e = F.tid + 512 * i, hh = e / 384, dist = e % 384 - 128; rv[i] = F.in[I_REL][rel_bucket(dist & 127) * 16 + 4 * g_ + hh]; }
#pragma unroll
            for (int i = 0; i < 3; ++i) { const int e = F.tid + 512 * i, dist = e % 384 - 128; tb[e] = ((unsigned)dist < 128u) ? rv[i] * LOG2E - M0 : -1e30f; }
        }
        const int un = u + F.G;
        if (un < NU) attn_load_kv(F, un >> 7, (un >> 2) & 31, un & 3, r);
        LDS_WAIT(); __syncthreads();
        attn_compute(F, u >> 7, (u >> 2) & 31, u & 3, M0);
        __syncthreads();
    }
}

constexpr int REP[7] = {1, 1, 1, 1, 1, 1, 1};
constexpr int REPS[4] = {1, 1, 1, 1};
__global__ void __launch_bounds__(NWAVES * 64, 2) hyb_fwd(Args args) {
    extern __shared__ __attribute__((aligned(16))) unsigned char lds[];
    Frame F;
    F.lds = (LAS unsigned char*)lds;
    F.tid = threadIdx.x; F.lane = F.tid & 63; F.wave = __builtin_amdgcn_readfirstlane(F.tid >> 6);
    F.G = gridDim.x; { const int bx = blockIdx.x; F.vcu = (F.G % 8 == 0) ? (bx % 8) * (F.G / 8) + bx / 8 : bx; }
    F.in = args.in; F.out = args.out; F.ws = args.ws;
    volatile LAS unsigned* MISC = (volatile LAS unsigned*)(F.lds + MISC_OFF);
    for (int u = F.tid; u < (LDS_BYTES - LDSCTL_OFF) / 4; u += NWAVES * 64) ((LAS unsigned*)(F.lds + LDSCTL_OFF))[u] = 0u;
    __syncthreads();
    const int lo = args.ph_lo, hi = args.ph_hi;
    const bool one = (hi - lo) > 1;
    XcdBarrier bar; bar.bar = (unsigned*)(F.ws + WS_CTL) + CW_BAR; bar.x = 0; bar.st = nullptr;
    if (one) bar = xcd_barrier_post((unsigned*)(F.ws + WS_CTL) + CW_BAR, MISC + 8);
#define IN(k) (lo <= (k) && (k) < hi)
#define SEAM(k) do { if (IN(k) && IN((k) + 1)) xcd_barrier(bar); } while (0)
    const int gw = F.vcu * NWAVES + F.wave, NGW = F.G * NWAVES;
    LAS unsigned char* wl = F.lds + F.wave * 16384;

    unsigned* ctlw = (unsigned*)(F.ws + WS_CTL);
    for (int rep = 0; rep < REP[0]; ++rep)
    if (IN(0)) {
        refresh(F);
        for (int t = blockIdx.x; t < 192; t += F.G) { p0_mod_tile(F, t); soft_arrive(ctlw + CW_MODC, 1u); }
        p0_weights(F);
        {
            const int gt_ = F.vcu * (NWAVES * 64) + F.tid, NGT = F.G * NWAVES * 64;
            unsigned long long* za = (unsigned long long*)(F.ws + WS_LBA); unsigned long long* zh = (unsigned long long*)(F.ws + WS_LBH);
            for (int e = gt_; e < 131072; e += NGT) __hip_atomic_store(za + e, 0ull, __ATOMIC_RELAXED, __HIP_MEMORY_SCOPE_AGENT);
            for (int e = gt_; e < 16384; e += NGT) __hip_atomic_store(zh + e, 0ull, __ATOMIC_RELAXED, __HIP_MEMORY_SCOPE_AGENT);
        }
        __syncthreads();
    }
    for (int rep = 0; rep < REP[1]; ++rep)
    if (IN(1)) { refresh(F); soft_wait(ctlw + CW_MODC, 192u); p1_xn(F); }
    SEAM(1);
    for (int rep = 0; rep < REP[2]; ++rep)
    if (IN(2)) {
        pg8::Gemm g{(const bf16*)(F.ws + WS_XN), (const bf16*)(F.ws + WS_WIN), MPAD, INW, DM, nullptr, DM};
        pg8::StaticOrder S; S.init(MPAD, INW, F.G, (int)blockIdx.x);
        EpiZ E{F.ws, F.out, F.in[I_QG], F.in[I_KG]};
        pg8::gemm_phase<EpiZ, pg8::StaticOrder, true, true>(F.lds, g, S, E);
        refresh(F);
        for (;;) {
            if (F.tid == 0) MISC[10] = __hip_atomic_fetch_add(ctlw + CW_TQ, 1u, __ATOMIC_RELAXED, __HIP_MEMORY_SCOPE_AGENT);
            __syncthreads();
            const int it = (int)MISC[10];
            __syncthreads();
            if (it >= TQ_ALL) break;
            tail_item(F, it);
        }
    }
    SEAM(2);
    for (int rep = 0; rep < REP[3]; ++rep)
    if (IN(3)) {
        refresh(F);
        const float M0 = logit_bound(F);
        build_bias_table(F);
        LDS_WAIT(); __syncthreads();
        for (int rs = 0; rs < REPS[0]; ++rs) {
        for (int u = F.vcu; u < NS * 2; u += F.G) sample_attn_block(F, u, M0);
        }
        if (F.G == 256) {
            scan_lb_block(F, F.vcu);
            build_bias_table(F); LDS_WAIT(); __syncthreads();
        } else {
            for (int u = F.vcu; u < 256; u += F.G) scan_block<1>(F, u);
            soft_arrive(ctlw + CW_S1C, 1u);
        }
        for (int rs = 0; rs < REPS[2]; ++rs)
        attn_phase(F, M0);
    }
    for (int rep = 0; rep < REP[4]; ++rep)
    if (IN(4) && F.G != 256) {
        refresh(F);
        soft_wait(ctlw + CW_S1C, (unsigned)F.G);
        for (int u = F.vcu; u < 256; u += F.G) scan_block<2>(F, u);
        __syncthreads();
    }
    SEAM(4);
    for (int rep = 0; rep < REP[5]; ++rep)
    if (IN(5)) {
        pg8::Gemm g{(const bf16*)(F.ws + WS_XN), (const bf16*)(F.ws + WS_WPP), MP, DM, 2048, (const bf16*)(F.out + O_YP), DM};
        pg8::StaticOrder S; S.init(MP, DM, F.G, (int)blockIdx.x);
        EpiMerge E{F.ws + WS_RAT, F.ws + WS_SMR, (bf16*)(F.ws + WS_SGA)};
        pg8::gemm_phase<EpiMerge, pg8::StaticOrder, false, true>(F.lds, g, S, E);
        refresh(F);
        for (int t = F.vcu; t < 256; t += F.G) mini_merge_block(F, t);
    }
    SEAM(5);
    for (int rep = 0; rep < REP[6]; ++rep)
    if (IN(6)) {
        pg8::Gemm g{(const bf16*)(F.ws + WS_SGA), (const bf16*)(F.ws + WS_WOUT), MP, DM, DM, nullptr, DM};
        pg8::StaticOrder S; S.init(MP, DM, F.G, (int)blockIdx.x);
        EpiOut E{F.in[I_XP], (const float*)(F.ws + WS_MOD), F.out + O_YP};
        pg8::gemm_phase<EpiOut, pg8::StaticOrder, false, true>(F.lds, g, S, E);
        refresh(F);
        for (int t = F.vcu; t < 256; t += F.G) mini_out_block(F, t);
    }
#undef IN
#undef SEAM
}

#ifndef MK_N_LAUNCHES
#define MK_N_LAUNCHES 1
#endif
constexpr int N_PHASES = 7;

extern "C" void kernel_launch(void* const* d_in, const int* in_sizes, int n_in, void* d_out, int out_size, void* d_ws, size_t ws_size, hipStream_t stream) {
    static int grid = 0;
    if (grid == 0) {
        if (n_in != 26 || out_size != (int)O_END || ws_size < WS_END) { fprintf(stderr, "kernel_launch: unexpected shapes (n_in %d out %d ws %zu)\n", n_in, out_size, ws_size); grid = -1; return; }
        int dev = 0, cus = 0, per_cu = 0;
        if (hipGetDevice(&dev) != hipSuccess || hipDeviceGetAttribute(&cus, hipDeviceAttributeMultiprocessorCount, dev) != hipSuccess) { grid = -1; return; }
        if (hipFuncSetAttribute((const void*)hyb_fwd, hipFuncAttributeMaxDynamicSharedMemorySize, LDS_BYTES) != hipSuccess) { fprintf(stderr, "kernel_launch: hipFuncSetAttribute failed\n"); grid = -1; return; }
        if (hipOccupancyMaxActiveBlocksPerMultiprocessor(&per_cu, (const void*)hyb_fwd, NWAVES * 64, LDS_BYTES) != hipSuccess || per_cu < 1) { fprintf(stderr, "kernel_launch: occupancy query says %d\n", per_cu); per_cu = 1; }
        (void)hipGetLastError();
        grid = cus * (per_cu < 1 ? 1 : 1);
    }
    if (grid < 0) return;
    (void)hipMemsetAsync((char*)d_ws + WS_CTL, 0, CTL_ZERO_BYTES, stream);
    Args a{};
    for (int i = 0; i < 26; ++i) a.in[i] = (const float*)d_in[i];
    a.out = (float*)d_out; a.ws = (unsigned char*)d_ws;
    if (MK_N_LAUNCHES == 1) {
        a.ph_lo = 0; a.ph_hi = N_PHASES;
        void* kargs[] = {&a};
        hipError_t e = hipLaunchCooperativeKernel((const void*)hyb_fwd, dim3(grid), dim3(NWAVES * 64), kargs, LDS_BYTES, stream);
        if (e != hipSuccess) fprintf(stderr, "kernel_launch: cooperative launch failed: %s (grid %d)\n", hipGetErrorString(e), grid);
    } else {
        for (int p = 0; p < N_PHASES; ++p) {
            a.ph_lo = p; a.ph_hi = p + 1;
            hipLaunchKernelGGL(hyb_fwd, dim3(grid), dim3(NWAVES * 64), LDS_BYTES, stream, a);
        }
    }
}
```

```cpp
#include <hip/hip_runtime.h>
#include <cstdio>
#include <cstdint>

namespace pg8 {
#define PG8_LAS __attribute__((address_space(3)))
typedef unsigned short bf16_t;
typedef short bf16x8 __attribute__((ext_vector_type(8)));
typedef float f32x4 __attribute__((ext_vector_type(4)));
typedef unsigned u32x4 __attribute__((ext_vector_type(4)));
constexpr int BM = 256, BK = 64, HALF = 128, HTB = HALF * BK * 2, STAGE_BYTES = 8 * HTB, NXCD = 8, WGM = 8;

__host__ __device__ __forceinline__ int lds_byte(int r, int c) { const int st = (r >> 4) * 2 + (c >> 5), rr = r & 15, cc = c & 31, ob = rr * 64 + cc * 2; return st * 1024 + (ob ^ (((ob >> 9) & 1) << 5)); }
__host__ __device__ __forceinline__ void stage_rc(int b, int& R, int& C) { const int st = b / 1024, sb = b % 1024, swz = sb ^ (((sb >> 9) & 1) << 5); R = (st >> 1) * 16 + swz / 64; C = (st & 1) * 32 + (swz % 64) / 2; }
__host__ __device__ __forceinline__ int perm32(int rho) { const int n = rho >> 4, i = rho & 15; return 8 * (i >> 2) + 4 * n + (i & 3); }

struct Unit { int pm, pn; };
struct Gemm { const bf16_t* A; const bf16_t* Bt; int M, N, K; const bf16_t* A2; int lda; };

struct StaticOrder {
    int nM, nN, nwg, G, c;
    __host__ __device__ void init(int M, int N, int G_, int c_) { nM = M / BM; nN = N / BM; nwg = nM * nN; G = G_; c = c_; }
    __host__ __device__ bool next(int i, Unit& u) const {
        const long L = (long)i * G + c; if (L >= nwg) return false;
        int wgid = (int)L; { const int q = nwg / NXCD, r = nwg % NXCD, xcd = wgid % NXCD, off = wgid / NXCD; wgid = (xcd < r ? xcd * (q + 1) : r * (q + 1) + (xcd - r) * q) + off; }
        const int nig = WGM * nN, gid = wgid / nig, fm = gid * WGM, gsz = (nM - fm) < WGM ? (nM - fm) : WGM;
        u.pm = fm + ((wgid % nig) % gsz); u.pn = (wgid % nig) / gsz; return true;
    }
    __device__ __forceinline__ void a_ready(const Unit&) const {}
    __device__ __forceinline__ void done(const Unit&) const {}
};

typedef float f32x2_t __attribute__((ext_vector_type(2))); typedef __bf16 bf16x2_t __attribute__((ext_vector_type(2)));
__device__ __forceinline__ unsigned cvt_pk_bf16(float lo, float hi) { f32x2_t v = {lo, hi}; bf16x2_t b = __builtin_convertvector(v, bf16x2_t); return __builtin_bit_cast(unsigned, b); }

template <class Epi, class Sched, bool ALIGN_EPI = false, bool SP2 = false>
__device__ __forceinline__ void gemm_phase(PG8_LAS unsigned char* lds, const Gemm g, const Sched& S, const Epi& E) {
    int tid_ = threadIdx.x; asm volatile("" : "+v"(tid_));
    const int tid = tid_, wid = __builtin_amdgcn_readfirstlane(tid >> 6), lane = tid & 63, wr = wid >> 2, wc = wid & 3, fr = lane & 15, fq = lane >> 4;
    const int K = g.K, nt = K / BK;
    unsigned voffA[2], voffB[2];
#pragma unroll
    for (int i = 0; i < 2; ++i) { int R, C; stage_rc(tid * 16 + i * 8192, R, C); const int Rb = Epi::PERM ? ((R & ~31) + perm32(R & 31)) : R;
        voffA[i] = (unsigned)(R * g.lda + C) * 2u; voffB[i] = (unsigned)(Rb * K + C) * 2u; }
    const size_t kstep = (size_t)(BK * 2);
    const size_t hstep = (size_t)HALF * K * 2;
    const size_t tstep = 2 * hstep;
    const size_t hstepA = (size_t)HALF * g.lda * 2, tstepA = 2 * hstepA;
    const int nh = g.A2 ? nt / 2 : nt + 4;
    const long a2delta = g.A2 ? ((const char*)g.A2 - (const char*)g.A) - (long)nh * (long)kstep : 0;
    const unsigned ldsw = (unsigned)wid * 1024u;
    const int aoff = lds_byte(wr * 64 + fr, fq * 8), boff = lds_byte(wc * 32 + fr, fq * 8);
#define PG8_SA(b, h) (((b) * 2 + (h)) * HTB)
#define PG8_SB(b, h) ((4 + (b) * 2 + (h)) * HTB)
#define PG8_STAGE(bufoff, gbase, voff) do { _Pragma("unroll") for (int _i = 0; _i < 2; ++_i) \
        __builtin_amdgcn_global_load_lds((const unsigned*)((const char*)(gbase) + (voff)[_i]), (PG8_LAS unsigned*)(lds + (bufoff) + ldsw + _i * 8192), 16, 0, 0); } while (0)
#define PG8_LDA(dst, b, h) do { _Pragma("unroll") for (int m = 0; m < 4; ++m) _Pragma("unroll") for (int k = 0; k < 2; ++k) dst[m][k] = *(const PG8_LAS bf16x8*)(lds + PG8_SA(b, h) + aoff + m * 2048 + k * 1024); } while (0)
#define PG8_LDB(dst, b, h) do { _Pragma("unroll") for (int n = 0; n < 2; ++n) _Pragma("unroll") for (int k = 0; k < 2; ++k) dst[n][k] = *(const PG8_LAS bf16x8*)(lds + PG8_SB(b, h) + boff + n * 2048 + k * 1024); } while (0)
#define PG8_MMA(ai, bj, At, Bt) do { __builtin_amdgcn_s_setprio(1); _Pragma("unroll") for (int m = 0; m < 4; ++m) _Pragma("unroll") for (int n = 0; n < 2; ++n) _Pragma("unroll") for (int k = 0; k < 2; ++k) \
        acc[ai][bj][m][n] = __builtin_amdgcn_mfma_f32_16x16x32_bf16(Bt[n][k], At[m][k], acc[ai][bj][m][n], 0, 0, 0); __builtin_amdgcn_s_setprio(0); } while (0)
#define PG8_WAIT_V(n) asm volatile("s_waitcnt vmcnt(" #n ")" ::: "memory")
#define PG8_WAIT_L(n) asm volatile("s_waitcnt lgkmcnt(" #n ")" ::: "memory")
#define PG8_BAR __builtin_amdgcn_s_barrier()
#define PG8_SCHED __builtin_amdgcn_sched_barrier(0)
    Unit cur, nxt; int ui = 0;
    if (!S.next(0, cur)) return;
    f32x4 acc[2][2][4][2];
#pragma unroll
    for (int a = 0; a < 2; ++a)
#pragma unroll
        for (int b = 0; b < 2; ++b)
#pragma unroll
            for (int m = 0; m < 4; ++m)
#pragma unroll
                for (int n = 0; n < 2; ++n) acc[a][b][m][n] = (f32x4){0.f, 0.f, 0.f, 0.f};
    bf16x8 At[4][2], B0[2][2], B1[2][2];
    const char* cA = (const char*)g.A + (size_t)cur.pm * tstepA; const char* cB = (const char*)g.Bt + (size_t)cur.pn * tstep;
    S.a_ready(cur);
    if constexpr (SP2) {
        PG8_STAGE(PG8_SB(0, 0), cB, voffB); PG8_STAGE(PG8_SB(0, 1), cB + hstep, voffB); PG8_STAGE(PG8_SA(0, 0), cA, voffA); PG8_STAGE(PG8_SA(0, 1), cA + hstepA, voffA);
        if (wr == 1) PG8_BAR;
        PG8_WAIT_V(2); PG8_BAR;
        PG8_STAGE(PG8_SB(1, 0), cB + kstep, voffB); PG8_STAGE(PG8_SA(1, 0), cA + kstep, voffA); PG8_STAGE(PG8_SB(1, 1), cB + hstep + kstep, voffB);
        PG8_WAIT_V(6); PG8_BAR;
    } else {
        PG8_STAGE(PG8_SB(0, 0), cB, voffB); PG8_STAGE(PG8_SA(0, 0), cA, voffA); PG8_STAGE(PG8_SB(0, 1), cB + hstep, voffB); PG8_STAGE(PG8_SA(0, 1), cA + hstepA, voffA);
        if (wr == 1) PG8_BAR;
        PG8_WAIT_V(4); PG8_BAR;
        PG8_STAGE(PG8_SB(1, 0), cB + kstep, voffB); PG8_STAGE(PG8_SA(1, 0), cA + kstep, voffA); PG8_STAGE(PG8_SB(1, 1), cB + hstep + kstep, voffB);
        PG8_WAIT_V(6); PG8_BAR;
    }
    for (;;) {
        const bool has_next = S.next(ui + 1, nxt);
        const char* nA = has_next ? (const char*)g.A + (size_t)nxt.pm * tstepA : cA; const char* nB = has_next ? (const char*)g.Bt + (size_t)nxt.pn * tstep : cB;
        for (int t = 0; t < nt; t += 2) {
            if constexpr (Epi::HAS_MID) { if (t == nt / 2) E.mid(acc, cur, wr, wc, fr, fq); }
            const bool last = (t == nt - 2);
            const char* a1 = cA + (t >= nh ? a2delta : 0) + (size_t)(t + 1) * kstep;
            const char* a2 = last ? nA : cA + (t + 2 >= nh ? a2delta : 0) + (size_t)(t + 2) * kstep; const char* b2 = last ? nB : cB + (size_t)(t + 2) * kstep;
            const char* a3 = a2 + kstep; const char* b3 = b2 + kstep;
            if (last && has_next) S.a_ready(nxt);
            if constexpr (SP2) {
            PG8_LDB(B0, 0, 0); PG8_LDB(B1, 0, 1); PG8_SCHED; PG8_LDA(At, 0, 0); PG8_STAGE(PG8_SA(1, 1), a1 + hstepA, voffA);
            PG8_WAIT_V(8); PG8_WAIT_L(0); PG8_BAR; PG8_MMA(0, 0, At, B0); PG8_MMA(0, 1, At, B1); PG8_BAR; PG8_SCHED;
            PG8_LDA(At, 0, 1); PG8_STAGE(PG8_SB(0, 0), b2, voffB); PG8_STAGE(PG8_SB(0, 1), b2 + hstep, voffB); PG8_STAGE(PG8_SA(0, 0), a2, voffA);
            PG8_WAIT_V(8); PG8_WAIT_L(0); PG8_BAR; PG8_MMA(1, 0, At, B0); PG8_MMA(1, 1, At, B1); PG8_BAR; PG8_SCHED;
            PG8_LDB(B0, 1, 0); PG8_LDB(B1, 1, 1); PG8_SCHED; PG8_LDA(At, 1, 0); PG8_STAGE(PG8_SA(0, 1), a2 + hstepA, voffA);
            PG8_WAIT_V(8); PG8_WAIT_L(0); PG8_BAR; PG8_MMA(0, 0, At, B0); PG8_MMA(0, 1, At, B1); PG8_BAR; PG8_SCHED;
            PG8_LDA(At, 1, 1); PG8_STAGE(PG8_SB(1, 0), b3, voffB); PG8_STAGE(PG8_SB(1, 1), b3 + hstep, voffB); PG8_STAGE(PG8_SA(1, 0), a3, voffA);
            PG8_WAIT_V(8); PG8_WAIT_L(0); PG8_BAR; PG8_MMA(1, 0, At, B0); PG8_MMA(1, 1, At, B1); PG8_BAR; PG8_SCHED;
            } else {
            PG8_LDB(B0, 0, 0); PG8_SCHED; PG8_LDA(At, 0, 0); PG8_STAGE(PG8_SA(1, 1), a1 + hstepA, voffA);
            PG8_WAIT_L(8); PG8_BAR; PG8_WAIT_L(0); PG8_MMA(0, 0, At, B0); PG8_BAR; PG8_SCHED;
            PG8_LDB(B1, 0, 1); PG8_STAGE(PG8_SB(0, 0), b2, voffB);
            PG8_BAR; PG8_WAIT_L(0); PG8_MMA(0, 1, At, B1); PG8_BAR;
            PG8_LDA(At, 0, 1); PG8_STAGE(PG8_SA(0, 0), a2, voffA);
            PG8_BAR; PG8_WAIT_L(0); PG8_MMA(1, 0, At, B0); PG8_BAR; PG8_SCHED;
            PG8_STAGE(PG8_SB(0, 1), b2 + hstep, voffB);
            PG8_WAIT_V(6); PG8_BAR; PG8_MMA(1, 1, At, B1); PG8_BAR;
            PG8_LDB(B0, 1, 0); PG8_SCHED; PG8_LDA(At, 1, 0); PG8_STAGE(PG8_SA(0, 1), a2 + hstepA, voffA);
            PG8_WAIT_L(8); PG8_BAR; PG8_WAIT_L(0); PG8_MMA(0, 0, At, B0); PG8_BAR; PG8_SCHED;
            PG8_LDB(B1, 1, 1); PG8_STAGE(PG8_SB(1, 0), b3, voffB);
            PG8_BAR; PG8_WAIT_L(0); PG8_MMA(0, 1, At, B1); PG8_BAR;
            PG8_LDA(At, 1, 1); PG8_STAGE(PG8_SA(1, 0), a3, voffA);
            PG8_BAR; PG8_WAIT_L(0); PG8_MMA(1, 0, At, B0); PG8_BAR; PG8_SCHED;
            PG8_STAGE(PG8_SB(1, 1), b3 + hstep, voffB);
            PG8_WAIT_V(6); PG8_BAR; PG8_MMA(1, 1, At, B1); PG8_BAR;
            }
        }
        if constexpr (ALIGN_EPI) { if (wr == 0) PG8_BAR; }
        E(acc, cur, wr, wc, fr, fq); S.done(cur);
        if (!has_next) break;
#pragma unroll
        for (int a = 0; a < 2; ++a)
#pragma unroll
            for (int b = 0; b < 2; ++b)
#pragma unroll
                for (int m = 0; m < 4; ++m)
#pragma unroll
                    for (int n = 0; n < 2; ++n) acc[a][b][m][n] = (f32x4){0.f, 0.f, 0.f, 0.f};
        cur = nxt; cA = nA; cB = nB; ++ui;
        if constexpr (ALIGN_EPI) { if (wr == 1) PG8_BAR; }
    }
    PG8_WAIT_V(0);
    if constexpr (!ALIGN_EPI) { if (wr == 0) PG8_BAR; }
    PG8_BAR;
#undef PG8_SA
#undef PG8_SB
#undef PG8_STAGE
#undef PG8_LDA
#undef PG8_LDB
#undef PG8_MMA
#undef PG8_WAIT_V
#undef PG8_WAIT_L
#undef PG8_BAR
#undef PG8_SCHED
}
}

constexpr int NWAVES = 8;
constexpr int DM = 1024, NB = 4, SEQ = 4096, NS = 128, WIN = 128;
constexpr int MP = NB * SEQ;
constexpr int MALL = MP + NS;
constexpr int MPAD = 16640;
constexpr int INW = 6656;
constexpr int NCH = 32;
constexpr float EPSN = 1e-6f;
constexpr float LOG2E = 1.4426950408889634f;
constexpr float QSCALE = 0.125f * LOG2E;

constexpr size_t MiB = 1u << 20;
constexpr size_t WS_CTL = 0, CTL_ZERO_BYTES = 64 * 1024;
constexpr size_t WS_MOD = 1 * MiB;
constexpr size_t WS_WRA = 3 * MiB;
constexpr size_t WS_WRX = 3 * MiB + 128 * 1024;
constexpr size_t WS_KVNEW = 3 * MiB + 256 * 1024;
constexpr size_t WS_AGG = 4 * MiB;
constexpr size_t WS_LBA = 4 * MiB;
constexpr size_t WS_LBH = 3 * MiB + 512 * 1024;
constexpr size_t WS_WIN = 5 * MiB;
constexpr size_t WS_WPP = 18 * MiB;
constexpr size_t WS_WOUT = 22 * MiB;
constexpr size_t WS_XN = 24 * MiB;
constexpr size_t ACT = (size_t)MPAD * DM * 2;
constexpr size_t WS_K = WS_XN + ACT;
constexpr size_t WS_V = WS_K + ACT / 4;
constexpr size_t WS_SGA = WS_V + ACT / 4;
constexpr size_t WS_XR = WS_SGA + ACT;
constexpr size_t WS_SGR = WS_XR + ACT;
constexpr size_t WS_RAT = WS_SGR + ACT;
constexpr size_t WS_SMR = WS_RAT + ACT;
constexpr size_t WS_QT = WS_SMR + ACT;
constexpr size_t WS_YT = WS_QT + 512 * 1024;
constexpr size_t WS_MGT = WS_YT + 512 * 1024;
constexpr size_t WS_END = WS_MGT + 256 * 1024;
static_assert(WS_END <= 256 * MiB, "d_ws map");
constexpr size_t O_YP = 0, O_YS = 16777216, O_KWP = 16908288, O_VWP = 17039360, O_CVP = 17170432, O_HP = 17182720,
                 O_KWS = 17186816, O_VWS = 21381120, O_CVS = 25575424, O_HS = 25968640, O_END = 26099712;
constexpr size_t QM_OFF = (size_t)MP * DM;

constexpr int CW_BAR = 1024, CW_MODC = 64, CW_S1C = 128, CW_TQ = 192;

constexpr int RING_BYTES = 131072;
constexpr int GW_OFF = RING_BYTES, GW_STRIDE = 144, GW_BYTES = 2 * 64 * GW_STRIDE;
constexpr int BT_OFF = GW_OFF + GW_BYTES, BT_BYTES = 16 * 128 * 4;
constexpr int LDSCTL_OFF = BT_OFF + BT_BYTES, MISC_OFF = LDSCTL_OFF + 320;
constexpr int LDS_BYTES = LDSCTL_OFF + 512;

#define GAS __attribute__((address_space(1)))
#define LAS __attribute__((address_space(3)))
typedef unsigned short bf16;
typedef unsigned v4u __attribute__((ext_vector_type(4)));
typedef unsigned v2u __attribute__((ext_vector_type(2)));
typedef float f32x4 __attribute__((ext_vector_type(4)));
typedef float f32x16 __attribute__((ext_vector_type(16)));
typedef short bf16x8 __attribute__((ext_vector_type(8)));
typedef short s16x4 __attribute__((ext_vector_type(4)));
typedef GAS unsigned gu32;
#define RLX_AGENT __ATOMIC_RELAXED, __HIP_MEMORY_SCOPE_AGENT
#define LDS_WAIT() asm volatile("s_waitcnt lgkmcnt(0)" ::: "memory")
#define VM_WAIT() asm volatile("s_waitcnt vmcnt(0)" ::: "memory")
__device__ __forceinline__ unsigned f2bf(float f) { unsigned u = __builtin_bit_cast(unsigned, f); return (u + 0x7fffu + ((u >> 16) & 1u)) >> 16; }
__device__ __forceinline__ unsigned pk2(float lo, float hi) { return f2bf(lo) | (f2bf(hi) << 16); }
__device__ __forceinline__ float bf2f(unsigned b) { return __uint_as_float(b << 16); }
__device__ __forceinline__ float bflo(unsigned w) { return __uint_as_float(w << 16); }
__device__ __forceinline__ float bfhi(unsigned w) { return __uint_as_float(w & 0xffff0000u); }
__device__ __forceinline__ unsigned pk_u8x4(float a, float b, float c, float d) {
    unsigned r = __builtin_amdgcn_cvt_pk_u8_f32(fmaxf(a * 255.0f, 1.0f), 0, 0u); r = __builtin_amdgcn_cvt_pk_u8_f32(fmaxf(b * 255.0f, 1.0f), 1, r);
    r = __builtin_amdgcn_cvt_pk_u8_f32(fmaxf(c * 255.0f, 1.0f), 2, r); return __builtin_amdgcn_cvt_pk_u8_f32(fmaxf(d * 255.0f, 1.0f), 3, r); }
__device__ __forceinline__ float u8f(unsigned w, int i) { return (float)((w >> (8 * i)) & 0xffu); }
__device__ __forceinline__ float fexp2(float x) { return __builtin_amdgcn_exp2f(x); }
__device__ __forceinline__ float frcp(float x) { return __builtin_amdgcn_rcpf(x); }
__device__ __forceinline__ float sigm(float x) { return frcp(1.0f + fexp2(-LOG2E * x)); }

#define XB_TMO      128
#define XB_XCNT(j)  (256  + 64 * (j))
#define XB_XSUB(j)  (1280 + 64 * (j))
#define XB_XGEN(j)  (2304 + 64 * (j))
#define XB_TOP      3328
#define XB_TOPGEN   3392
#define XCD_BAR_WORDS 3456
#define XB_SPIN_CAP (1u << 22)
__device__ __forceinline__ unsigned xb_ld(unsigned* p)              { return __hip_atomic_load(p, __ATOMIC_RELAXED, __HIP_MEMORY_SCOPE_AGENT); }
__device__ __forceinline__ unsigned xb_add(unsigned* p, unsigned v) { return __hip_atomic_fetch_add(p, v, __ATOMIC_RELAXED, __HIP_MEMORY_SCOPE_AGENT); }
__device__ __forceinline__ unsigned xb_xcc_id() { return (unsigned)__builtin_amdgcn_s_getreg((3 << 11) | 20) & 0xFu; }
#define XB_SPIN(cond, bar) do { unsigned _sp = 0; while (cond) { __builtin_amdgcn_s_sleep(1); \
    if ((++_sp & 255u) == 0u) { if (xb_ld(&(bar)[XB_TMO])) break; if (_sp > XB_SPIN_CAP) { atomicAdd(&(bar)[XB_TMO], 1u); break; } } } } while (0)
struct XcdBarrier { unsigned* bar; unsigned x; volatile LAS unsigned* st; };
__device__ __forceinline__ XcdBarrier xcd_barrier_post(unsigned* bar, volatile LAS unsigned* st) {
    XcdBarrier b; b.bar = bar; b.x = xb_xcc_id(); b.st = st;
    if (threadIdx.x == 0) (void)xb_add(&bar[XB_XCNT(b.x)], 1u);
    return b;
}
__device__ __forceinline__ void xcd_barrier_complete(unsigned* bar, unsigned x, unsigned& nloc, unsigned& nx) {
    const unsigned G = gridDim.x * gridDim.y * gridDim.z;
    unsigned sum, cnt, mine, sp = 0u;
    for (;;) {
        sum = 0u; cnt = 0u; mine = 0u;
#pragma unroll
        for (unsigned j = 0; j < 16; ++j) { const unsigned c = xb_ld(&bar[XB_XCNT(j)]); sum += c; cnt += (c > 0u) ? 1u : 0u; mine = (j == x) ? c : mine; }
        if (sum == G) break;
        __builtin_amdgcn_s_sleep(1);
        if ((++sp & 255u) == 0u) { if (xb_ld(&bar[XB_TMO])) break; if (sp > XB_SPIN_CAP) { atomicAdd(&bar[XB_TMO], 1u); break; } }
    }
    nloc = mine > 0u ? mine : 1u; nx = cnt > 0u ? cnt : 1u;
}
__device__ __forceinline__ void xcd_barrier(const XcdBarrier& b) {
    asm volatile("s_waitcnt vmcnt(0)" ::: "memory");
    __syncthreads();
    if (threadIdx.x == 0) {
        unsigned* bar = b.bar;
        __builtin_amdgcn_s_waitcnt(0);
        unsigned nloc = b.st[0], nx = b.st[1];
        if (nloc == 0u) { xcd_barrier_complete(bar, b.x, nloc, nx); b.st[0] = nloc; b.st[1] = nx; }
        const unsigned old = xb_add(&bar[XB_XSUB(b.x)], 1u);
        const unsigned gen = old / nloc;
        if (old + 1u == (gen + 1u) * nloc) {
            __builtin_amdgcn_fence(__ATOMIC_RELEASE, "agent");
            asm volatile("s_waitcnt vmcnt(0)" ::: "memory");
            const unsigned og = xb_add(&bar[XB_TOP], 1u);
            const unsigned tg = og / nx;
            if (og + 1u == (tg + 1u) * nx) xb_add(&bar[XB_TOPGEN], 1u);
            else XB_SPIN(xb_ld(&bar[XB_TOPGEN]) == tg, bar);
            __builtin_amdgcn_fence(__ATOMIC_ACQUIRE, "agent");
            xb_add(&bar[XB_XGEN(b.x)], 1u);
            asm volatile("s_waitcnt vmcnt(0)" ::: "memory");
        } else {
            XB_SPIN(xb_ld(&bar[XB_XGEN(b.x)]) == gen, bar);
            __builtin_amdgcn_fence(__ATOMIC_ACQUIRE, "agent");
            asm volatile("s_waitcnt vmcnt(0)" ::: "memory");
        }
    }
    __syncthreads();
}

__device__ __forceinline__ void soft_arrive(unsigned* cnt, unsigned v) {
    asm volatile("s_waitcnt vmcnt(0)" ::: "memory"); __syncthreads();
    if (threadIdx.x == 0) (void)__hip_atomic_fetch_add(cnt, v, __ATOMIC_RELAXED, __HIP_MEMORY_SCOPE_AGENT);
}
__device__ __forceinline__ void soft_wait(unsigned* cnt, unsigned need) {
    if (threadIdx.x == 0) {
        unsigned sp = 0;
        while (__hip_atomic_load(cnt, __ATOMIC_RELAXED, __HIP_MEMORY_SCOPE_AGENT) < need) { __builtin_amdgcn_s_sleep(2); if (++sp > (1u << 22)) break; }
        __builtin_amdgcn_fence(__ATOMIC_ACQUIRE, "agent");
        asm volatile("s_waitcnt vmcnt(0)" ::: "memory");
    }
    __syncthreads();
}
__device__ __forceinline__ void st_sc1(float* p, float v) { __hip_atomic_store((unsigned*)p, __float_as_uint(v), __ATOMIC_RELAXED, __HIP_MEMORY_SCOPE_AGENT); }
struct Args {
    const float* in[26];
    float* out; unsigned char* ws;
    int ph_lo, ph_hi;
};
enum { I_XP = 0, I_XS, I_CK, I_CV, I_SC, I_SH, I_CP, I_CS, I_REL, I_NG, I_WADA, I_BADA, I_WIN, I_QG, I_KG, I_SINK, I_WCONV, I_BCONV,
       I_WRA, I_BRA, I_WRX, I_BRX, I_LAM, I_WPA, I_WPR, I_WOUT };

struct Frame {
    LAS unsigned char* lds;
    int tid, lane, wave, G, vcu;
    const float* const* in;
    float* out; unsigned char* ws;
};

__device__ __forceinline__ void refresh(Frame& F) {
    int t = threadIdx.x; asm volatile("" : "+v"(t));
    F.tid = t; F.lane = t & 63; F.wave = __builtin_amdgcn_readfirstlane(t >> 6);
}
__device__ __forceinline__ int rel_bucket(int n) { const int big = 16 + (int)(__builtin_amdgcn_logf((float)n * 0.0625f) * (16.0f / 3.0f)); return n < 16 ? n : (big < 31 ? big : 31); }
__device__ const unsigned char BUCKET[128] = {0, 1, 2, 3, 4, 5, 6, 7, 8, 9, 10, 11, 12, 13, 14, 15, 16, 16, 16, 17, 17, 18, 18, 18, 19, 19, 19, 20, 20, 20, 20, 21, 21, 21, 21, 22, 22, 22, 22, 22, 23, 23, 23, 23, 23, 23, 24, 24, 24, 24, 24, 24, 25, 25, 25, 25, 25, 25, 25, 26, 26, 26, 26, 26, 26, 26, 26, 27, 27, 27, 27, 27, 27, 27, 27, 27, 27, 28, 28, 28, 28, 28, 28, 28, 28, 28, 28, 29, 29, 29, 29, 29, 29, 29, 29, 29, 29, 29, 29, 30, 30, 30, 30, 30, 30, 30, 30, 30, 30, 30, 30, 30, 30, 31, 31, 31, 31, 31, 31, 31, 31, 31, 31, 31, 31, 31, 31, 31};

__device__ __forceinline__ void transpose_block(const float* W, int N, int k0, int n0, bf16* WT, int ldk, int drow0, int kofs, LAS float* scr, int lane) {
    f32x4 wv[8];
#pragma unroll
    for (int i = 0; i < 8; ++i) wv[i] = *(const f32x4*)(W + (size_t)(k0 + 8 * i + (lane >> 3)) * N + n0 + 4 * (lane & 7));
#pragma unroll
    for (int i = 0; i < 8; ++i) { LAS float* d = scr + (8 * i + (lane >> 3)) * 33 + 4 * (lane & 7); d[0] = wv[i][0]; d[1] = wv[i][1]; d[2] = wv[i][2]; d[3] = wv[i][3]; }
    LDS_WAIT(); asm volatile("" ::: "memory");
    const int c = lane & 7;
#pragma unroll
    for (int j = 0; j < 4; ++j) { const int n = (lane >> 3) + 8 * j; const LAS float* s = scr + (8 * c) * 33 + n;
        v4u o; o.x = pk2(s[0 * 33], s[1 * 33]); o.y = pk2(s[2 * 33], s[3 * 33]); o.z = pk2(s[4 * 33], s[5 * 33]); o.w = pk2(s[6 * 33], s[7 * 33]);
        *(GAS v4u*)(WT + (size_t)(drow0 + n) * ldk + kofs + k0 + 8 * c) = o; }
    LDS_WAIT(); asm volatile("" ::: "memory");
}
__device__ __forceinline__ int win_row(int n0) {
    if (n0 < 1280) { const int t = n0 >> 8, w = n0 & 255; return (t << 8) + (((w >> 5) & 1) << 7) + ((w >> 6) << 5); }
    if (n0 < 4608) return n0;
    if (n0 < 5632) { const int i = n0 - 4608; return 4608 + ((i >> 7) << 8) + (i & 127); }
    { const int i = n0 - 5632; return 4608 + ((i >> 7) << 8) + 128 + (i & 127); }
}
__device__ __forceinline__ void p0_weights(Frame& F) {
    LAS float* scr = (LAS float*)(F.lds + F.wave * 16384);
    const int gw = F.vcu * NWAVES + F.wave, NGW = F.G * NWAVES;
    bf16* WIN_T = (bf16*)(F.ws + WS_WIN);
    for (int it = gw; it < 16 * 208; it += NGW) { const int kb = it / 208, nb = it % 208; transpose_block(F.in[I_WIN], INW, 64 * kb, 32 * nb, WIN_T, DM, win_row(32 * nb), 0, scr, F.lane); }
}
constexpr int TQ_TR = 200, TQ_ALL = 708;
__device__ __forceinline__ void tail_item(Frame& F, int it) {
    if (it < TQ_TR) {
        LAS float* scr = (LAS float*)(F.lds + F.wave * 16384);
        int r = 8 * it + F.wave;
        bf16* WPP = (bf16*)(F.ws + WS_WPP); bf16* WOUT_T = (bf16*)(F.ws + WS_WOUT);
        if (r < 512) { const int kb = r / 32, nb = r % 32; transpose_block(F.in[I_WPA], DM, 64 * kb, 32 * nb, WPP, 2048, 32 * nb, 0, scr, F.lane); return; } r -= 512;
        if (r < 512) { const int kb = r / 32, nb = r % 32; transpose_block(F.in[I_WPR], DM, 64 * kb, 32 * nb, WPP, 2048, 32 * nb, 1024, scr, F.lane); return; } r -= 512;
        if (r < 512) { const int kb = r / 32, nb = r % 32; transpose_block(F.in[I_WOUT], DM, 64 * kb, 32 * nb, WOUT_T, DM, 32 * nb, 0, scr, F.lane); return; } r -= 512;
        if (r < 32) { const int blk = r >> 1, nb = r & 1; transpose_block(F.in[I_WRA] + blk * 4096, 64, 0, 32 * nb, (bf16*)(F.ws + WS_WRA) + blk * 4096, 64, 32 * nb, 0, scr, F.lane); return; } r -= 32;
        { const int blk = r >> 1, nb = r & 1; transpose_block(F.in[I_WRX] + blk * 4096, 64, 0, 32 * nb, (bf16*)(F.ws + WS_WRX) + blk * 4096, 64, 32 * nb, 0, scr, F.lane); }
        return;
    }
    const int rbase = (it - TQ_TR) * 64 + 8 * F.wave;
    f32x4 v[8]; size_t dsto[8];
#pragma unroll
    for (int i = 0; i < 8; ++i) {
        const int rr = rbase + i, which = rr / 16256, r2 = rr % 16256, bs = r2 / 127, jj = r2 % 127;
        v[i] = ((const f32x4*)F.in[which ? I_CV : I_CK])[((size_t)bs * 128 + jj + 1) * 64 + F.lane];
        dsto[i] = (which ? O_VWS : O_KWS) / 4 + ((size_t)bs * 128 + jj) * 64 + F.lane;
    }
#pragma unroll
    for (int i = 0; i < 8; ++i) ((f32x4*)F.out)[dsto[i]] = v[i];
}

__device__ __forceinline__ void p0_mod_tile(Frame& F, int nt) {
    const float* wada = F.in[I_WADA]; const int lane = F.lane, w = F.wave;
    const int n0 = 16 * nt, kbase = 128 * w;
    f32x4 acc[9];
#pragma unroll
    for (int m = 0; m < 9; ++m) acc[m] = (f32x4){0.f, 0.f, 0.f, 0.f};
    float bvv[4][8];
#pragma unroll
    for (int ks = 0; ks < 4; ++ks)
#pragma unroll
        for (int j = 0; j < 8; ++j) bvv[ks][j] = wada[(size_t)(kbase + 32 * ks + 8 * (lane >> 4) + j) * 3072 + n0 + (lane & 15)];
#pragma unroll
    for (int ks = 0; ks < 4; ++ks) {
        const int k0 = kbase + 32 * ks + 8 * (lane >> 4);
        f32x4 a0[9], a1[9];
#pragma unroll
        for (int m = 0; m < 9; ++m) {
            const int row = 16 * m + (lane & 15);
            const int rr = row < 132 ? row : 131;
            const float* cr = (rr < 4 ? F.in[I_CP] + rr * 1024 : F.in[I_CS] + (rr - 4) * 1024) + k0;
            a0[m] = *(const f32x4*)cr; a1[m] = *(const f32x4*)(cr + 4);
        }
        v4u bw; bw.x = pk2(bvv[ks][0], bvv[ks][1]); bw.y = pk2(bvv[ks][2], bvv[ks][3]); bw.z = pk2(bvv[ks][4], bvv[ks][5]); bw.w = pk2(bvv[ks][6], bvv[ks][7]);
        const bf16x8 bfr = __builtin_bit_cast(bf16x8, bw);
#pragma unroll
        for (int m = 0; m < 9; ++m) {
            const int row = 16 * m + (lane & 15);
            v4u aw; aw.x = pk2(a0[m].x, a0[m].y); aw.y = pk2(a0[m].z, a0[m].w); aw.z = pk2(a1[m].x, a1[m].y); aw.w = pk2(a1[m].z, a1[m].w);
            if (row >= 132) aw = (v4u){0u, 0u, 0u, 0u};
            acc[m] = __builtin_amdgcn_mfma_f32_16x16x32_bf16(__builtin_bit_cast(bf16x8, aw), bfr, acc[m], 0, 0, 0);
        }
    }
    LAS float* part = (LAS float*)F.lds;
#pragma unroll
    for (int m = 0; m < 9; ++m)
#pragma unroll
        for (int r = 0; r < 4; ++r) part[(w * 144 + 16 * m + 4 * (lane >> 4) + r) * 16 + (lane & 15)] = acc[m][r];
    __syncthreads();
    float* mod = (float*)(F.ws + WS_MOD);
    for (int e = F.tid; e < 132 * 4; e += NWAVES * 64) {
        const int row = e >> 2, c4 = (e & 3) * 4; f32x4 s = *(const f32x4*)(F.in[I_BADA] + n0 + c4);
#pragma unroll
        for (int ww = 0; ww < 8; ++ww) s += *(const LAS f32x4*)(part + (ww * 144 + row) * 16 + c4);
        const v4u sv = __builtin_bit_cast(v4u, s);
        unsigned long long* dst = (unsigned long long*)(mod + (size_t)row * 3072 + n0 + c4);
        __hip_atomic_store(dst, (unsigned long long)sv.x | ((unsigned long long)sv.y << 32), __ATOMIC_RELAXED, __HIP_MEMORY_SCOPE_AGENT);
        __hip_atomic_store(dst + 1, (unsigned long long)sv.z | ((unsigned long long)sv.w << 32), __ATOMIC_RELAXED, __HIP_MEMORY_SCOPE_AGENT);
    }
    __syncthreads();
}
__device__ __forceinline__ float wave_sum(float v) {
#pragma unroll
    for (int o = 1; o < 64; o <<= 1) v += __shfl_xor(v, o);
    return v;
}
__device__ __forceinline__ const float* xn_src_row(Frame& F, int m) { return m < MP ? F.in[I_XP] + (size_t)m * DM : F.in[I_XS] + (size_t)(m - MP) * DM; }
__device__ __forceinline__ void p1_xn(Frame& F) {
    const int RPB = (MPAD + F.G - 1) / F.G, rbeg = F.vcu * RPB, rend = (rbeg + RPB < MPAD) ? rbeg + RPB : MPAD;
    const float* mod = (const float*)(F.ws + WS_MOD); bf16* XN = (bf16*)(F.ws + WS_XN);
    const f32x4* gp = (const f32x4*)F.in[I_NG] + F.lane;
    f32x4 gvec[4];
#pragma unroll
    for (int j = 0; j < 4; ++j) gvec[j] = gp[64 * j];
    f32x4 nx[4];
    if (rbeg + F.wave < MALL && rbeg + F.wave < rend) { const f32x4* xr = (const f32x4*)xn_src_row(F, rbeg + F.wave) + F.lane;
#pragma unroll
        for (int j = 0; j < 4; ++j) nx[j] = xr[64 * j]; }
    int mr_c = -1; f32x4 scv[4], shv[4];
#pragma unroll
    for (int j = 0; j < 4; ++j) { scv[j] = (f32x4){0.f, 0.f, 0.f, 0.f}; shv[j] = scv[j]; }
    for (int m = rbeg + F.wave; m < rend; m += NWAVES) {
        GAS unsigned long long* o8 = (GAS unsigned long long*)(XN + (size_t)m * DM) + F.lane;
        if (m >= MALL) {
#pragma unroll
            for (int j = 0; j < 4; ++j) o8[64 * j] = 0ull;
            continue;
        }
        f32x4 v[4];
#pragma unroll
        for (int j = 0; j < 4; ++j) v[j] = nx[j];
        const int mn = m + NWAVES;
        if (mn < MALL && mn < rend) { const f32x4* xr = (const f32x4*)xn_src_row(F, mn) + F.lane;
#pragma unroll
            for (int j = 0; j < 4; ++j) nx[j] = xr[64 * j]; }
        const int mr = m < MP ? (m >> 12) : 4 + (m - MP);
        if (mr != mr_c) {
            const f32x4* sh = (const f32x4*)(mod + (size_t)mr * 3072) + F.lane; const f32x4* sc = sh + 256;
#pragma unroll
            for (int j = 0; j < 4; ++j) { scv[j] = sc[64 * j] + 1.0f; shv[j] = sh[64 * j]; }
            mr_c = mr;
        }
        float s = 0.f;
#pragma unroll
        for (int j = 0; j < 4; ++j) s += (v[j].x * v[j].x + v[j].y * v[j].y) + (v[j].z * v[j].z + v[j].w * v[j].w);
        const float rstd = 1.0f / sqrtf(wave_sum(s) * (1.f / DM) + EPSN);
        unsigned long long ov[4];
#pragma unroll
        for (int j = 0; j < 4; ++j) {
            const f32x4 y = v[j] * rstd * gvec[j] * scv[j] + shv[j];
            ov[j] = (unsigned long long)pk2(y.x, y.y) | ((unsigned long long)pk2(y.z, y.w) << 32);
        }
#pragma unroll
        for (int j = 0; j < 4; ++j) o8[64 * j] = ov[j];
    }
}

struct EpiZ {
    static constexpr bool PERM = true, HAS_MID = false;
    unsigned char* ws; float* out; const float* qg; const float* kg;
    __device__ __forceinline__ void mid(pg8::f32x4 (&)[2][2][4][2], const pg8::Unit&, int, int, int, int) const {}
    __device__ __forceinline__ void operator()(const pg8::f32x4 (&acc)[2][2][4][2], const pg8::Unit& u, int wr, int wc, int fr, int fq) const {
        asm volatile("" : "+v"(fr), "+v"(fq));
        const int pn = u.pn, pm = u.pm;
        const int rloc = wr * 64 + fr;
        const size_t row0 = (size_t)pm * 256 + rloc;
        if (pn < 5) {
            const bool isq = pn < 4;
            const float* gsrc = (isq ? qg : kg) + 8 * fq;
            f32x4 gv[2][2];
#pragma unroll
            for (int bj = 0; bj < 2; ++bj)
#pragma unroll
                for (int n = 0; n < 2; ++n) gv[bj][n] = *(const f32x4*)(gsrc + 32 * bj + 4 * n);
            const float sc = isq ? QSCALE : 1.0f;
            bf16* dst; int ld, colb;
            if (isq) { dst = (pm < 64) ? (bf16*)(out + O_YP) + QM_OFF + row0 * DM : (bf16*)(ws + WS_QT) + (size_t)rloc * DM; ld = DM; colb = (4 * pn + wc) * 64 + 8 * fq; }
            else { dst = (bf16*)(ws + WS_K) + row0 * 256; ld = 256; colb = wc * 64 + 8 * fq; }
#pragma unroll
            for (int ai = 0; ai < 2; ++ai)
#pragma unroll
                for (int m = 0; m < 4; ++m) {
                    float ss = 0.f;
#pragma unroll
                    for (int bj = 0; bj < 2; ++bj)
#pragma unroll
                        for (int n = 0; n < 2; ++n) { const f32x4 x = acc[ai][bj][m][n]; ss += (x[0] * x[0] + x[1] * x[1]) + (x[2] * x[2] + x[3] * x[3]); }
                    ss += __shfl_xor(ss, 16); ss += __shfl_xor(ss, 32);
                    const float rs = sc / sqrtf(ss * (1.0f / 64.0f) + EPSN);
                    bf16* rp = dst + (size_t)(ai * 128 + m * 16) * ld + colb;
#pragma unroll
                    for (int bj = 0; bj < 2; ++bj) {
                        const f32x4 v0 = acc[ai][bj][m][0] * rs * gv[bj][0], v1 = acc[ai][bj][m][1] * rs * gv[bj][1];
                        v4u w; w.x = pg8::cvt_pk_bf16(v0[0], v0[1]); w.y = pg8::cvt_pk_bf16(v0[2], v0[3]); w.z = pg8::cvt_pk_bf16(v1[0], v1[1]); w.w = pg8::cvt_pk_bf16(v1[2], v1[3]);
                        *(v4u*)(rp + 32 * bj) = w;
                        if (!isq) {
                            float* so = nullptr;
                            if (pm < 64 && (pm & 15) == 15 && ai == 1) so = out + O_KWP + ((size_t)(pm >> 4) * 128 + (wr * 64 + m * 16 + fr)) * 256;
                            else if (pm == 64 && ai == 0) so = (float*)(ws + WS_KVNEW) + (size_t)(wr * 64 + m * 16 + fr) * 256;
                            if (so) { so += wc * 64 + 32 * bj + 8 * fq; *(f32x4*)so = v0; *(f32x4*)(so + 4) = v1; }
                        }
                    }
                }
            return;
        }
        if (pn == 5) {
            bf16* dst = (bf16*)(ws + WS_V) + row0 * 256 + 32 * wc + 8 * fq;
#pragma unroll
            for (int ai = 0; ai < 2; ++ai)
#pragma unroll
                for (int m = 0; m < 4; ++m)
#pragma unroll
                    for (int bj = 0; bj < 2; ++bj) {
                        const f32x4 v0 = acc[ai][bj][m][0], v1 = acc[ai][bj][m][1];
                        v4u w; w.x = pg8::cvt_pk_bf16(v0[0], v0[1]); w.y = pg8::cvt_pk_bf16(v0[2], v0[3]); w.z = pg8::cvt_pk_bf16(v1[0], v1[1]); w.w = pg8::cvt_pk_bf16(v1[2], v1[3]);
                        *(v4u*)(dst + (size_t)(ai * 128 + m * 16) * 256 + 128 * bj) = w;
                        float* so = nullptr;
                        if (pm < 64 && (pm & 15) == 15 && ai == 1) so = out + O_VWP + ((size_t)(pm >> 4) * 128 + (wr * 64 + m * 16 + fr)) * 256;
                        else if (pm == 64 && ai == 0) so = (float*)(ws + WS_KVNEW) + 128 * 256 + (size_t)(wr * 64 + m * 16 + fr) * 256;
                        if (so) { so += 128 * bj + 32 * wc + 8 * fq; *(f32x4*)so = v0; *(f32x4*)(so + 4) = v1; }
                    }
            return;
        }
        if (pn < 18) {
            const int seg = (pn - 6) >> 2;
            const int colt = ((pn - 6) & 3) * 256 + 32 * wc + 8 * fq;
            bf16* dst = (bf16*)(ws + (seg == 0 ? WS_SGA : seg == 1 ? WS_XR : WS_SGR)) + row0 * DM + colt;
#pragma unroll
            for (int ai = 0; ai < 2; ++ai)
#pragma unroll
                for (int m = 0; m < 4; ++m)
#pragma unroll
                    for (int bj = 0; bj < 2; ++bj) {
                        f32x4 v0 = acc[ai][bj][m][0], v1 = acc[ai][bj][m][1];
                        if (seg != 1) {
#pragma unroll
                            for (int e = 0; e < 4; ++e) { v0[e] = v0[e] * sigm(v0[e]); v1[e] = v1[e] * sigm(v1[e]); }
                        }
                        v4u w; w.x = pg8::cvt_pk_bf16(v0[0], v0[1]); w.y = pg8::cvt_pk_bf16(v0[2], v0[3]); w.z = pg8::cvt_pk_bf16(v1[0], v1[1]); w.w = pg8::cvt_pk_bf16(v1[2], v1[3]);
                        *(v4u*)(dst + (size_t)(ai * 128 + m * 16) * DM + 128 * bj) = w;
                        if (seg == 1 && pm < 64 && (pm & 15) == 15 && ai == 1 && wr == 1 && m == 3 && fr >= 13) {
                            float* so = out + O_CVP + ((size_t)(pm >> 4) * 3 + (fr - 13)) * DM + colt + 128 * bj;
                            *(f32x4*)so = v0; *(f32x4*)(so + 4) = v1;
                        }
                    }
            return;
        }
        {
            const int colt = (pn - 18) * 128 + 32 * wc + 8 * fq;
            unsigned char* da = ws + WS_RAT + row0 * DM + colt; unsigned char* ds = ws + WS_SMR + row0 * DM + colt;
#pragma unroll
            for (int ai = 0; ai < 2; ++ai)
#pragma unroll
                for (int m = 0; m < 4; ++m) {
                    float sa[8], sm[8];
#pragma unroll
                    for (int n = 0; n < 2; ++n)
#pragma unroll
                        for (int e = 0; e < 4; ++e) { sa[4 * n + e] = sigm(acc[ai][0][m][n][e]); sm[4 * n + e] = sigm(acc[ai][1][m][n][e]); }
                    v2u w; w.x = pk_u8x4(sa[0], sa[1], sa[2], sa[3]); w.y = pk_u8x4(sa[4], sa[5], sa[6], sa[7]);
                    *(v2u*)(da + (size_t)(ai * 128 + m * 16) * DM) = w;
                    w.x = pk_u8x4(sm[0], sm[1], sm[2], sm[3]); w.y = pk_u8x4(sm[4], sm[5], sm[6], sm[7]);
                    *(v2u*)(ds + (size_t)(ai * 128 + m * 16) * DM) = w;
                }
        }
    }
};

struct EpiMerge {
    static constexpr bool PERM = true, HAS_MID = true;
    const unsigned char* sma; const unsigned char* smr; bf16* mg;
    __device__ __forceinline__ void mid(pg8::f32x4 (&acc)[2][2][4][2], const pg8::Unit& u, int wr, int wc, int fr, int fq) const {
        asm volatile("" : "+v"(fr), "+v"(fq));
        const size_t off = ((size_t)u.pm * 256 + wr * 64 + fr) * DM + u.pn * 256 + 32 * wc + 8 * fq;
        v2u ga[16], gr[16];
#pragma unroll
        for (int ai = 0; ai < 2; ++ai)
#pragma unroll
            for (int m = 0; m < 4; ++m)
#pragma unroll
                for (int bj = 0; bj < 2; ++bj) {
                    const size_t o = off + (size_t)(ai * 128 + m * 16) * DM + 128 * bj;
                    ga[(ai * 4 + m) * 2 + bj] = *(const v2u*)(sma + o); gr[(ai * 4 + m) * 2 + bj] = *(const v2u*)(smr + o);
                }
        __builtin_amdgcn_sched_barrier(0);
#pragma unroll
        for (int ai = 0; ai < 2; ++ai)
#pragma unroll
            for (int m = 0; m < 4; ++m)
#pragma unroll
                for (int bj = 0; bj < 2; ++bj) {
                    const v2u a = ga[(ai * 4 + m) * 2 + bj], r = gr[(ai * 4 + m) * 2 + bj];
                    acc[ai][bj][m][0] *= (pg8::f32x4){u8f(a.x, 0) * frcp(u8f(r.x, 0)), u8f(a.x, 1) * frcp(u8f(r.x, 1)), u8f(a.x, 2) * frcp(u8f(r.x, 2)), u8f(a.x, 3) * frcp(u8f(r.x, 3))};
                    acc[ai][bj][m][1] *= (pg8::f32x4){u8f(a.y, 0) * frcp(u8f(r.y, 0)), u8f(a.y, 1) * frcp(u8f(r.y, 1)), u8f(a.y, 2) * frcp(u8f(r.y, 2)), u8f(a.y, 3) * frcp(u8f(r.y, 3))};
                }
    }
    __device__ __forceinline__ void operator()(const pg8::f32x4 (&acc)[2][2][4][2], const pg8::Unit& u, int wr, int wc, int fr, int fq) const {
        asm volatile("" : "+v"(fr), "+v"(fq));
        const size_t off = ((size_t)u.pm * 256 + wr * 64 + fr) * DM + u.pn * 256 + 32 * wc + 8 * fq;
        const float i255 = 1.0f / 255.0f;
        v2u gr[16];
#pragma unroll
        for (int ai = 0; ai < 2; ++ai)
#pragma unroll
            for (int m = 0; m < 4; ++m)
#pragma unroll
                for (int bj = 0; bj < 2; ++bj) gr[(ai * 4 + m) * 2 + bj] = *(const v2u*)(smr + off + (size_t)(ai * 128 + m * 16) * DM + 128 * bj);
        __builtin_amdgcn_sched_barrier(0);
#pragma unroll
        for (int ai = 0; ai < 2; ++ai)
#pragma unroll
            for (int m = 0; m < 4; ++m)
#pragma unroll
                for (int bj = 0; bj < 2; ++bj) {
                    const size_t o = off + (size_t)(ai * 128 + m * 16) * DM + 128 * bj;
                    const v2u r = gr[(ai * 4 + m) * 2 + bj];
                    const pg8::f32x4 v0 = acc[ai][bj][m][0] * ((pg8::f32x4){u8f(r.x, 0), u8f(r.x, 1), u8f(r.x, 2), u8f(r.x, 3)} * i255);
                    const pg8::f32x4 v1 = acc[ai][bj][m][1] * ((pg8::f32x4){u8f(r.y, 0), u8f(r.y, 1), u8f(r.y, 2), u8f(r.y, 3)} * i255);
                    v4u w; w.x = pg8::cvt_pk_bf16(v0[0], v0[1]); w.y = pg8::cvt_pk_bf16(v0[2], v0[3]); w.z = pg8::cvt_pk_bf16(v1[0], v1[1]); w.w = pg8::cvt_pk_bf16(v1[2], v1[3]);
                    *(v4u*)(mg + o) = w;
                }
    }
};
struct EpiOut {
    static constexpr bool PERM = false, HAS_MID = false;
    const float* x; const float* mod; float* y;
    __device__ __forceinline__ void mid(pg8::f32x4 (&)[2][2][4][2], const pg8::Unit&, int, int, int, int) const {}
    __device__ __forceinline__ void operator()(const pg8::f32x4 (&acc)[2][2][4][2], const pg8::Unit& u, int wr, int wc, int fr, int fq) const {
        asm volatile("" : "+v"(fr), "+v"(fq));
        const int col0 = u.pn * 256 + wc * 32 + 4 * fq;
        const float* gp = mod + (size_t)(u.pm >> 4) * 3072 + 2048 + col0;
        f32x4 gv[2][2];
#pragma unroll
        for (int bj = 0; bj < 2; ++bj)
#pragma unroll
            for (int n = 0; n < 2; ++n) gv[bj][n] = *(const f32x4*)(gp + 128 * bj + 16 * n);
#pragma unroll
        for (int ai = 0; ai < 2; ++ai) {
            f32x4 xv[4][2][2];
#pragma unroll
            for (int m = 0; m < 4; ++m) {
                const size_t off = ((size_t)u.pm * 256 + ai * 128 + wr * 64 + m * 16 + fr) * DM + col0;
#pragma unroll
                for (int bj = 0; bj < 2; ++bj)
#pragma unroll
                    for (int n = 0; n < 2; ++n) xv[m][bj][n] = *(const f32x4*)(x + off + 128 * bj + 16 * n);
            }
            __builtin_amdgcn_sched_barrier(0);
#pragma unroll
            for (int m = 0; m < 4; ++m) {
                const size_t off = ((size_t)u.pm * 256 + ai * 128 + wr * 64 + m * 16 + fr) * DM + col0;
#pragma unroll
                for (int bj = 0; bj < 2; ++bj)
#pragma unroll
                    for (int n = 0; n < 2; ++n) *(f32x4*)(y + off + 128 * bj + 16 * n) = xv[m][bj][n] + gv[bj][n] * acc[ai][bj][m][n];
            }
            __builtin_amdgcn_sched_barrier(0);
        }
    }
};

template <int KQ  >
__device__ __forceinline__ f32x4 mini_partial(const bf16* A, const bf16* B) {
    bf16x8 a[KQ], b[KQ];
#pragma unroll
    for (int ks = 0; ks < KQ; ++ks) { a[ks] = *(const bf16x8*)(A + 32 * ks); b[ks] = *(const bf16x8*)(B + 32 * ks); }
    f32x4 acc = (f32x4){0.f, 0.f, 0.f, 0.f};
#pragma unroll
    for (int ks = 0; ks < KQ; ++ks) acc = __builtin_amdgcn_mfma_f32_16x16x32_bf16(a[ks], b[ks], acc, 0, 0, 0);
    return acc;
}
__device__ __forceinline__ void mini_merge_block(Frame& F, int pair) {
    const int lane = F.lane, w = F.wave, tile = 2 * pair + (w >> 2), kq = w & 3, rt = tile >> 6, ct = tile & 63;
    const bf16* A = (const bf16*)(F.ws + WS_YT) + (size_t)(16 * rt + (lane & 15)) * 2048 + 8 * (lane >> 4) + 512 * kq;
    const bf16* B = (const bf16*)(F.ws + WS_WPP) + (size_t)(16 * ct + (lane & 15)) * 2048 + 8 * (lane >> 4) + 512 * kq;
    const f32x4 acc = mini_partial<16>(A, B);
    LAS float* part = (LAS float*)F.lds;
#pragma unroll
    for (int r = 0; r < 4; ++r) part[w * 256 + (4 * (lane >> 4) + r) * 16 + (lane & 15)] = acc[r];
    __syncthreads();
    {
        const int t2 = F.tid >> 8, e = F.tid & 255, row = e >> 4, col = e & 15, tl = 2 * pair + t2, rl = 16 * (tl >> 6) + row, cg = 16 * (tl & 63) + col;
        const LAS float* p = part + t2 * 1024 + e;
        const float sa_ = (float)(F.ws + WS_RAT)[(size_t)(MP + rl) * DM + cg], sr_ = (float)(F.ws + WS_SMR)[(size_t)(MP + rl) * DM + cg];
        const float rat = sa_ / sr_, sm = sr_ * (1.0f / 255.0f);
        const float v = ((p[0] + p[256]) * rat + (p[512] + p[768])) * sm;
        ((bf16*)(F.ws + WS_MGT))[(size_t)rl * DM + cg] = (bf16)f2bf(v);
    }
    __syncthreads();
}
__device__ __forceinline__ void mini_out_block(Frame& F, int pair) {
    const int lane = F.lane, w = F.wave, tile = 2 * pair + (w >> 2), kq = w & 3, rt = tile >> 6, ct = tile & 63;
    const bf16* A = (const bf16*)(F.ws + WS_MGT) + (size_t)(16 * rt + (lane & 15)) * DM + 8 * (lane >> 4) + 256 * kq;
    const bf16* B = (const bf16*)(F.ws + WS_WOUT) + (size_t)(16 * ct + (lane & 15)) * DM + 8 * (lane >> 4) + 256 * kq;
    const f32x4 acc = mini_partial<8>(A, B);
    LAS float* part = (LAS float*)F.lds;
#pragma unroll
    for (int r = 0; r < 4; ++r) part[w * 256 + (4 * (lane >> 4) + r) * 16 + (lane & 15)] = acc[r];
    __syncthreads();
    {
        const int t2 = F.tid >> 8, e = F.tid & 255, row = e >> 4, col = e & 15, tl = 2 * pair + t2, rl = 16 * (tl >> 6) + row, cg = 16 * (tl & 63) + col;
        const LAS float* p = part + t2 * 1024 + e;
        const float* mod = (const float*)(F.ws + WS_MOD);
        F.out[O_YS + (size_t)rl * DM + cg] = F.in[I_XS][(size_t)rl * DM + cg] + mod[(size_t)(4 + rl) * 3072 + 2048 + cg] * ((p[0] + p[256]) + (p[512] + p[768]));
    }
    __syncthreads();
}

struct ChanConst { float w0, w1, w2, w3, bc, bra, brx, c1, nbra, nbrx; };
__device__ __forceinline__ ChanConst chan_const(Frame& F, int ch) {
    ChanConst c; const float* wc = F.in[I_WCONV];
    c.w0 = wc[ch]; c.w1 = wc[DM + ch]; c.w2 = wc[2 * DM + ch]; c.w3 = wc[3 * DM + ch]; c.bc = F.in[I_BCONV][ch];
    c.bra = F.in[I_BRA][ch]; c.brx = F.in[I_BRX][ch];
    c.c1 = -8.0f * log1pf(expf(-F.in[I_LAM][ch])) * LOG2E;
    c.nbra = -LOG2E * c.bra; c.nbrx = -LOG2E * c.brx;
    return c;
}
__device__ __forceinline__ void sample_rnn_unit(Frame& F, int bs, int j);
__device__ __forceinline__ void stage_gate_weights(Frame& F, int j) {
    for (int cidx = F.tid; cidx < 1024; cidx += NWAVES * 64) {
        const int gsel = cidx >> 9, row = (cidx >> 3) & 63, c8 = cidx & 7;
        const v4u v = *(const v4u*)((const bf16*)(F.ws + (gsel ? WS_WRX : WS_WRA)) + j * 4096 + row * 64 + 8 * c8);
        *(LAS v4u*)(F.lds + GW_OFF + (gsel * 64 + row) * GW_STRIDE + 16 * c8) = v;
    }
}
template <int PASS>
__device__ __forceinline__ void scan_unit(Frame& F, int b, int c, int j, LAS unsigned char* wl) {
    const int lane = F.lane, r32 = lane & 31, hi = lane >> 5, ch = 64 * j + lane;
    const ChanConst cc = chan_const(F, ch);
    const bf16* XR = (const bf16*)(F.ws + WS_XR); const bf16* SGR = (const bf16*)(F.ws + WS_SGR);
    float* agg = (float*)(F.ws + WS_AGG);
    bf16* YM = (bf16*)(F.out + O_YP);
    LAS bf16* xt = (LAS bf16*)wl; LAS bf16* st = (LAS bf16*)(wl + 4096); LAS float* gt = (LAS float*)(wl + 8192);
    const size_t rowb = (size_t)b * SEQ + 128 * c;
    const int lrow = lane >> 3, lc8 = lane & 7;
    const bf16* xsrc = XR + (rowb + lrow) * DM + 64 * j + 8 * lc8;
    const bf16* ssrc = SGR + (rowb + lrow) * DM + 64 * j + 8 * lc8;
    v4u xn[4], sn[4];
#pragma unroll
    for (int i = 0; i < 4; ++i) { xn[i] = *(const v4u*)(xsrc + (size_t)(8 * i) * DM); if (PASS == 2) sn[i] = *(const v4u*)(ssrc + (size_t)(8 * i) * DM); }
    float xm3 = 0.f, xm2 = 0.f, xm1 = 0.f;
    if (c > 0) { xm3 = bf2f(XR[(rowb - 3) * DM + ch]); xm2 = bf2f(XR[(rowb - 2) * DM + ch]); xm1 = bf2f(XR[(rowb - 1) * DM + ch]); }
    float h = 0.f, ap = 1.f;
    if (PASS == 2) {
        for (int q = 0; q < c; ++q) { const float a = agg[((size_t)(b * NCH + q) * 2 + 0) * DM + ch], hl = agg[((size_t)(b * NCH + q) * 2 + 1) * DM + ch]; h = a * h + hl; }
    }
    const LAS unsigned char* gwr = F.lds + GW_OFF + r32 * GW_STRIDE + 16 * hi;
    for (int sc = 0; sc < 4; ++sc) {
        const size_t r0 = rowb + 32 * sc;
#pragma unroll
        for (int i = 0; i < 4; ++i) { *(LAS v4u*)(xt + (lrow + 8 * i) * 64 + 8 * lc8) = xn[i]; if (PASS == 2) *(LAS v4u*)(st + (lrow + 8 * i) * 64 + 8 * lc8) = sn[i]; }
        if (sc < 3) {
#pragma unroll
            for (int i = 0; i < 4; ++i) { xn[i] = *(const v4u*)(xsrc + (size_t)(32 * (sc + 1) + 8 * i) * DM); if (PASS == 2) sn[i] = *(const v4u*)(ssrc + (size_t)(32 * (sc + 1) + 8 * i) * DM); }
        }
        LDS_WAIT(); asm volatile("" ::: "memory");
        float xc[32];
#pragma unroll
        for (int t = 0; t < 32; ++t) {
            const float x = bf2f(xt[t * 64 + lane]);
            xc[t] = cc.bc + cc.w0 * xm3 + cc.w1 * xm2 + cc.w2 * xm1 + cc.w3 * x;
            xm3 = xm2; xm2 = xm1; xm1 = x;
            xt[t * 64 + lane] = (bf16)pg8::cvt_pk_bf16(xc[t], 0.f);
        }
        LDS_WAIT(); asm volatile("" ::: "memory");
        bf16x8 af[4];
#pragma unroll
        for (int d0 = 0; d0 < 4; ++d0) af[d0] = *(const LAS bf16x8*)(xt + r32 * 64 + 16 * d0 + 8 * hi);
        float zr[32];
#pragma unroll
        for (int oh = 0; oh < 2; ++oh) {
            f32x16 d = {};
#pragma unroll
            for (int d0 = 0; d0 < 4; ++d0) d = __builtin_amdgcn_mfma_f32_32x32x16_bf16(af[d0], *(const LAS bf16x8*)(gwr + (32 * oh) * GW_STRIDE + 32 * d0), d, 0, 0, 0);
#pragma unroll
            for (int r = 0; r < 16; ++r) gt[((r & 3) + 8 * (r >> 2) + 4 * hi) * 64 + 32 * oh + r32] = d[r];
        }
        LDS_WAIT(); asm volatile("" ::: "memory");
#pragma unroll
        for (int t = 0; t < 32; ++t) zr[t] = gt[t * 64 + lane];
        LDS_WAIT(); asm volatile("" ::: "memory");
#pragma unroll
        for (int oh = 0; oh < 2; ++oh) {
            f32x16 d = {};
#pragma unroll
            for (int d0 = 0; d0 < 4; ++d0) d = __builtin_amdgcn_mfma_f32_32x32x16_bf16(af[d0], *(const LAS bf16x8*)(gwr + (64 + 32 * oh) * GW_STRIDE + 32 * d0), d, 0, 0, 0);
#pragma unroll
            for (int r = 0; r < 16; ++r) gt[((r & 3) + 8 * (r >> 2) + 4 * hi) * 64 + 32 * oh + r32] = d[r];
        }
        LDS_WAIT(); asm volatile("" ::: "memory");
#pragma unroll
        for (int t = 0; t < 32; ++t) {
            const float zi = gt[t * 64 + lane];
            const float rg = frcp(1.0f + fexp2(__builtin_fmaf(zr[t], -LOG2E, cc.nbra))), ig = frcp(1.0f + fexp2(__builtin_fmaf(zi, -LOG2E, cc.nbrx)));
            const float a = fexp2(cc.c1 * rg);
            const float s = __builtin_amdgcn_sqrtf(__builtin_fmaf(-a, a, 1.0f));
            const float uu = s * ig * xc[t];
            h = a * h + uu;
            if (PASS == 1) ap *= a;
            if (PASS == 2) st[t * 64 + lane] = (bf16)pg8::cvt_pk_bf16(h * bf2f(st[t * 64 + lane]), 0.f);
        }
        LDS_WAIT(); asm volatile("" ::: "memory");
        if (PASS == 2) {
#pragma unroll
            for (int i = 0; i < 4; ++i) *(v4u*)(YM + (r0 + lrow + 8 * i) * DM + 64 * j + 8 * lc8) = *(const LAS v4u*)(st + (lrow + 8 * i) * 64 + 8 * lc8);
            LDS_WAIT(); asm volatile("" ::: "memory");
        }
    }
    if (PASS == 1) { st_sc1(&agg[((size_t)(b * NCH + c) * 2 + 0) * DM + ch], ap); st_sc1(&agg[((size_t)(b * NCH + c) * 2 + 1) * DM + ch], h); }
    if (PASS == 2 && c == NCH - 1) F.out[O_HP + (size_t)b * DM + ch] = h;
}
typedef GAS unsigned long long gu64;
__device__ __forceinline__ void gr_store(unsigned long long* g, float v) { __hip_atomic_store(g, (1ull << 32) | (unsigned long long)__float_as_uint(v), __ATOMIC_RELAXED, __HIP_MEMORY_SCOPE_AGENT); }
__device__ __forceinline__ unsigned long long gr_load(unsigned long long* g) { return __hip_atomic_load(g, __ATOMIC_RELAXED, __HIP_MEMORY_SCOPE_AGENT); }
__device__ __forceinline__ void scan_lb_block(Frame& F, int bu) {
    const int j = bu & 15, ib = (bu >> 4) & 3, b = bu >> 6, w = F.wave, q = 8 * ib + w;
    stage_gate_weights(F, j);
    LDS_WAIT(); __syncthreads();
    sample_rnn_unit(F, (bu >> 4) * 8 + w, j);
    const int lane = F.lane, r32 = lane & 31, hi = lane >> 5, ch = 64 * j + lane;
    LAS unsigned char* wl = F.lds + w * 16384;
    const ChanConst cc = chan_const(F, ch);
    const bf16* XR = (const bf16*)(F.ws + WS_XR); const bf16* SGR = (const bf16*)(F.ws + WS_SGR);
    bf16* YM = (bf16*)(F.out + O_YP);
    LAS bf16* xt = (LAS bf16*)wl; LAS bf16* st = (LAS bf16*)(wl + 4096); LAS float* gt = (LAS float*)(wl + 8192);
    LAS float* xch = (LAS float*)(F.lds + BT_OFF);
    unsigned long long* lba = (unsigned long long*)(F.ws + WS_LBA) + ((size_t)(b * 16 + j) * 16) * 128 + lane;
    unsigned long long* lbh = (unsigned long long*)(F.ws + WS_LBH) + ((size_t)(b * 16 + j) * 4) * 64 + lane;
    const int lrow = lane >> 3, lc8 = lane & 7;
    const size_t row0 = (size_t)b * SEQ + 32 * q;
    const bf16* xsrc = XR + (row0 + lrow) * DM + 64 * j + 8 * lc8;
    const bf16* ssrc = SGR + (row0 + lrow) * DM + 64 * j + 8 * lc8;
    v4u xn[4], sn[4];
#pragma unroll
    for (int i = 0; i < 4; ++i) { xn[i] = *(const v4u*)(xsrc + (size_t)(8 * i) * DM); sn[i] = *(const v4u*)(ssrc + (size_t)(8 * i) * DM); }
    float hx3 = 0.f, hx2 = 0.f, hx1 = 0.f;
    if (q > 0) { hx3 = bf2f(XR[(row0 - 3) * DM + ch]); hx2 = bf2f(XR[(row0 - 2) * DM + ch]); hx1 = bf2f(XR[(row0 - 1) * DM + ch]); }
    const LAS unsigned char* gwr = F.lds + GW_OFF + r32 * GW_STRIDE + 16 * hi;
    for (int r = 0; r < 4; ++r) {
        const size_t r0 = row0 + 1024 * r;
#pragma unroll
        for (int i = 0; i < 4; ++i) { *(LAS v4u*)(xt + (lrow + 8 * i) * 64 + 8 * lc8) = xn[i]; *(LAS v4u*)(st + (lrow + 8 * i) * 64 + 8 * lc8) = sn[i]; }
        float xm3 = hx3, xm2 = hx2, xm1 = hx1;
        if (r < 3) {
#pragma unroll
            for (int i = 0; i < 4; ++i) { xn[i] = *(const v4u*)(xsrc + (size_t)(1024 * (r + 1) + 8 * i) * DM); sn[i] = *(const v4u*)(ssrc + (size_t)(1024 * (r + 1) + 8 * i) * DM); }
            hx3 = bf2f(XR[(r0 + 1024 - 3) * DM + ch]); hx2 = bf2f(XR[(r0 + 1024 - 2) * DM + ch]); hx1 = bf2f(XR[(r0 + 1024 - 1) * DM + ch]);
        }
        LDS_WAIT(); asm volatile("" ::: "memory");
        float xc[32];
#pragma unroll
        for (int t = 0; t < 32; ++t) {
            const float x = bf2f(xt[t * 64 + lane]);
            xc[t] = cc.bc + cc.w0 * xm3 + cc.w1 * xm2 + cc.w2 * xm1 + cc.w3 * x;
            xm3 = xm2; xm2 = xm1; xm1 = x;
            xt[t * 64 + lane] = (bf16)pg8::cvt_pk_bf16(xc[t], 0.f);
        }
        LDS_WAIT(); asm volatile("" ::: "memory");
        bf16x8 af[4];
#pragma unroll
        for (int d0 = 0; d0 < 4; ++d0) af[d0] = *(const LAS bf16x8*)(xt + r32 * 64 + 16 * d0 + 8 * hi);
        float av[32], uv[32];
#pragma unroll
        for (int oh = 0; oh < 2; ++oh) {
            f32x16 d = {};
#pragma unroll
            for (int d0 = 0; d0 < 4; ++d0) d = __builtin_amdgcn_mfma_f32_32x32x16_bf16(af[d0], *(const LAS bf16x8*)(gwr + (32 * oh) * GW_STRIDE + 32 * d0), d, 0, 0, 0);
#pragma unroll
            for (int g4 = 0; g4 < 4; ++g4) *(LAS f32x4*)(gt + (32 * oh + r32) * 32 + (((2 * g4 + hi) ^ (((32 * oh + r32) >> 1) & 7)) << 2)) = (f32x4){d[4 * g4], d[4 * g4 + 1], d[4 * g4 + 2], d[4 * g4 + 3]};
        }
        LDS_WAIT(); asm volatile("" ::: "memory");
#pragma unroll
        for (int c = 0; c < 8; ++c) { const f32x4 v4 = *(const LAS f32x4*)(gt + lane * 32 + ((c ^ ((lane >> 1) & 7)) << 2)); av[4 * c] = v4[0]; av[4 * c + 1] = v4[1]; av[4 * c + 2] = v4[2]; av[4 * c + 3] = v4[3]; }
        LDS_WAIT(); asm volatile("" ::: "memory");
#pragma unroll
        for (int oh = 0; oh < 2; ++oh) {
            f32x16 d = {};
#pragma unroll
            for (int d0 = 0; d0 < 4; ++d0) d = __builtin_amdgcn_mfma_f32_32x32x16_bf16(af[d0], *(const LAS bf16x8*)(gwr + (64 + 32 * oh) * GW_STRIDE + 32 * d0), d, 0, 0, 0);
#pragma unroll
            for (int g4 = 0; g4 < 4; ++g4) *(LAS f32x4*)(gt + (32 * oh + r32) * 32 + (((2 * g4 + hi) ^ (((32 * oh + r32) >> 1) & 7)) << 2)) = (f32x4){d[4 * g4], d[4 * g4 + 1], d[4 * g4 + 2], d[4 * g4 + 3]};
        }
        LDS_WAIT(); asm volatile("" ::: "memory");
        float hl = 0.f, ap = 1.f;
        typedef float f2 __attribute__((ext_vector_type(2)));
#pragma unroll
        for (int c = 0; c < 8; ++c) {
            const f32x4 z4 = *(const LAS f32x4*)(gt + lane * 32 + ((c ^ ((lane >> 1) & 7)) << 2));
#pragma unroll
            for (int p = 0; p < 2; ++p) {
                const int t = 4 * c + 2 * p;
                const f2 zr2 = {av[t], av[t + 1]}, zi2 = {z4[2 * p], z4[2 * p + 1]}, xc2 = {xc[t], xc[t + 1]};
                f2 er = zr2 * (-LOG2E) + cc.nbra, ei = zi2 * (-LOG2E) + cc.nbrx;
                er = (f2){fexp2(er.x), fexp2(er.y)} + 1.0f; ei = (f2){fexp2(ei.x), fexp2(ei.y)} + 1.0f;
                const f2 rg = {frcp(er.x), frcp(er.y)}, ig = {frcp(ei.x), frcp(ei.y)};
                const f2 la = rg * cc.c1;
                const f2 a2 = {fexp2(la.x), fexp2(la.y)};
                const f2 om = 1.0f - a2 * a2;
                const f2 sq = {__builtin_amdgcn_sqrtf(om.x), __builtin_amdgcn_sqrtf(om.y)};
                const f2 u2 = sq * ig * xc2;
                av[t] = a2.x; av[t + 1] = a2.y; uv[t] = u2.x; uv[t + 1] = u2.y;
                hl = a2.x * hl + u2.x; hl = a2.y * hl + u2.y; ap *= a2.x * a2.y;
            }
        }
        LAS float* xw = xch + (r & 1) * 1024;
        xw[(w * 2 + 0) * 64 + lane] = ap; xw[(w * 2 + 1) * 64 + lane] = hl;
        LDS_WAIT(); __syncthreads();
        float pa = 1.f, ph = 0.f;
        for (int k = 0; k < w; ++k) { const float ak = xw[(k * 2 + 0) * 64 + lane], hk = xw[(k * 2 + 1) * 64 + lane]; ph = ak * ph + hk; pa = ak * pa; }
        if (w == 7 && ib < 3) { gr_store(lba + (size_t)(r * 4 + ib) * 128, ap * pa); gr_store(lba + (size_t)(r * 4 + ib) * 128 + 64, ap * ph + hl); }
        float hin = 0.f;
        {
            unsigned long long gh = (1ull << 32), ga[3] = {1ull << 32, 1ull << 32, 1ull << 32}, gb[3] = {1ull << 32, 1ull << 32, 1ull << 32};
            unsigned sp = 0;
            for (;;) {
                if (r > 0) gh = gr_load(lbh + (size_t)(r - 1) * 64);
#pragma unroll
                for (int k = 0; k < 3; ++k) if (k < ib) { ga[k] = gr_load(lba + (size_t)(r * 4 + k) * 128); gb[k] = gr_load(lba + (size_t)(r * 4 + k) * 128 + 64); }
                bool ok = (gh >> 32) == 1ull;
#pragma unroll
                for (int k = 0; k < 3; ++k) ok = ok && (ga[k] >> 32) == 1ull && (gb[k] >> 32) == 1ull;
                if (__all(ok)) break;
                __builtin_amdgcn_s_sleep(2);
                if (++sp > (1u << 20)) break;
            }
            if (r > 0) hin = __uint_as_float((unsigned)gh);
#pragma unroll
            for (int k = 0; k < 3; ++k) if (k < ib) hin = __uint_as_float((unsigned)ga[k]) * hin + __uint_as_float((unsigned)gb[k]);
            hin = pa * hin + ph;
        }
        float h = hin;
#pragma unroll
        for (int t = 0; t < 32; ++t) {
            h = av[t] * h + uv[t];
            st[t * 64 + lane] = (bf16)pg8::cvt_pk_bf16(h * bf2f(st[t * 64 + lane]), 0.f);
        }
        LDS_WAIT(); asm volatile("" ::: "memory");
#pragma unroll
        for (int i = 0; i < 4; ++i) *(v4u*)(YM + (r0 + lrow + 8 * i) * DM + 64 * j + 8 * lc8) = *(const LAS v4u*)(st + (lrow + 8 * i) * 64 + 8 * lc8);
        if (q == 31) { if (r < 3) gr_store(lbh + (size_t)r * 64, h); else F.out[O_HP + (size_t)b * DM + ch] = h; }
        LDS_WAIT(); asm volatile("" ::: "memory");
    }
    __syncthreads();
}
template <int PASS>
__device__ __forceinline__ void scan_block(Frame& F, int bu) {
    const int j = bu & 15, ub = (bu >> 4) * 8 + F.wave;
    stage_gate_weights(F, j);
    LDS_WAIT(); __syncthreads();
    if (PASS == 1) sample_rnn_unit(F, ub, j);
    scan_unit<PASS>(F, ub >> 5, ub & 31, j, F.lds + F.wave * 16384);
    __syncthreads();
}
__device__ __forceinline__ void sample_rnn_unit(Frame& F, int bs, int j) {
    const int lane = F.lane, ch = 64 * j + lane;
    const ChanConst cc = chan_const(F, ch);
    const float* scv = F.in[I_SC] + (size_t)bs * 3 * DM;
    const float x0 = scv[ch], x1 = scv[DM + ch], x2 = scv[2 * DM + ch];
    const float x3 = bf2f(((const bf16*)(F.ws + WS_XR))[(size_t)(MP + bs) * DM + ch]);
    const float h0 = F.in[I_SH][(size_t)bs * DM + ch];
    const float sg = bf2f(((const bf16*)(F.ws + WS_SGR))[(size_t)(MP + bs) * DM + ch]);
    const float xc = cc.bc + cc.w0 * x0 + cc.w1 * x1 + cc.w2 * x2 + cc.w3 * x3;
    const int xci = __float_as_int(xc);
    const LAS unsigned char* gw = F.lds + GW_OFF + lane * GW_STRIDE;
    float zr = 0.f, zi = 0.f;
#pragma unroll
    for (int k8 = 0; k8 < 8; ++k8) {
        const v4u wr4 = *(const LAS v4u*)(gw + 16 * k8), wi4 = *(const LAS v4u*)(gw + 64 * GW_STRIDE + 16 * k8);
        const unsigned wrw[4] = {wr4.x, wr4.y, wr4.z, wr4.w}, wiw[4] = {wi4.x, wi4.y, wi4.z, wi4.w};
#pragma unroll
        for (int e = 0; e < 4; ++e) {
            const float xa = __int_as_float(__builtin_amdgcn_readlane(xci, 8 * k8 + 2 * e)), xb = __int_as_float(__builtin_amdgcn_readlane(xci, 8 * k8 + 2 * e + 1));
            zr += xa * bflo(wrw[e]); zr += xb * bfhi(wrw[e]); zi += xa * bflo(wiw[e]); zi += xb * bfhi(wiw[e]);
        }
    }
    const float rg = sigm(zr + cc.bra), ig = sigm(zi + cc.brx);
    const float a = fexp2(cc.c1 * rg);
    const float sq = sqrtf(fmaxf(1.0f - a * a, 0.f));
    const float h = a * h0 + sq * ig * xc;
    F.out[O_HS + (size_t)bs * DM + ch] = h;
    float* cv = F.out + O_CVS + (size_t)bs * 3 * DM;
    cv[ch] = x1; cv[DM + ch] = x2; cv[2 * DM + ch] = x3;
    ((bf16*)(F.ws + WS_YT))[(size_t)bs * 2048 + 1024 + ch] = (bf16)f2bf(h * sg);
}

__device__ __forceinline__ float logit_bound(Frame& F) {
    float mq = fabsf(F.in[I_QG][F.lane]), mk = fabsf(F.in[I_KG][F.lane]), mb = 0.f;
#pragma unroll
    for (int i = 0; i < 8; ++i) mb = fmaxf(mb, fabsf(F.in[I_REL][F.lane + 64 * i]));
#pragma unroll
    for (int o = 1; o < 64; o <<= 1) { mq = fmaxf(mq, __shfl_xor(mq, o)); mk = fmaxf(mk, __shfl_xor(mk, o)); mb = fmaxf(mb, __shfl_xor(mb, o)); }
    return (8.0f * mq * mk + mb) * LOG2E;
}

__device__ __forceinline__ void build_bias_table(Frame& F) {
    LAS float* bt = (LAS float*)(F.lds + BT_OFF);
    float rv[4];
#pragma unroll
    for (int i = 0; i < 4; ++i) { const int e = F.tid + 512 * i; rv[i] = F.in[I_REL][rel_bucket(e & 127) * 16 + (e >> 7)]; }
#pragma unroll
    for (int i = 0; i < 4; ++i) bt[F.tid + 512 * i] = rv[i] * LOG2E;
}
__device__ __forceinline__ void sample_attn_block(Frame& F, int pair, float M0) {
    const int lane = F.lane, w = F.wave, u = 2 * pair + (w >> 2), bs = u >> 2, g = u & 3, kq = w & 3;
    const int dch = lane & 15, ksub = lane >> 4;
    const LAS float* bt = (const LAS float*)(F.lds + BT_OFF);
    LAS float* part = (LAS float*)F.lds;
    const bf16* QT = (const bf16*)(F.ws + WS_QT) + (size_t)bs * DM + g * 256;
    float q[4][4];
#pragma unroll
    for (int hh = 0; hh < 4; ++hh) { const v2u qq = *(const v2u*)(QT + hh * 64 + 4 * dch); q[hh][0] = bflo(qq.x); q[hh][1] = bfhi(qq.x); q[hh][2] = bflo(qq.y); q[hh][3] = bfhi(qq.y); }
    const float* ck = F.in[I_CK] + (((size_t)bs * 128 + 32 * kq + ksub) * 4 + g) * 64 + 4 * dch;
    const float* cv = F.in[I_CV] + (((size_t)bs * 128 + 32 * kq + ksub) * 4 + g) * 64 + 4 * dch;
    f32x4 kv[8], vv[8];
#pragma unroll
    for (int i = 0; i < 8; ++i) kv[i] = *(const f32x4*)(ck + (size_t)i * 1024);
#pragma unroll
    for (int i = 0; i < 8; ++i) vv[i] = *(const f32x4*)(cv + (size_t)i * 1024);
    float l[4] = {0.f, 0.f, 0.f, 0.f}; float o[4][4];
#pragma unroll
    for (int hh = 0; hh < 4; ++hh)
#pragma unroll
        for (int e = 0; e < 4; ++e) o[hh][e] = 0.f;
#pragma unroll
    for (int i = 0; i < 8; ++i) {
        const int key = 32 * kq + 4 * i + ksub;
#pragma unroll
        for (int hh = 0; hh < 4; ++hh) {
            float sdot = (kv[i][0] * q[hh][0] + kv[i][1] * q[hh][1]) + (kv[i][2] * q[hh][2] + kv[i][3] * q[hh][3]);
            sdot += __shfl_xor(sdot, 1); sdot += __shfl_xor(sdot, 2); sdot += __shfl_xor(sdot, 4); sdot += __shfl_xor(sdot, 8);
            const float ev = (key >= 1) ? fexp2(sdot + bt[(4 * g + hh) * 128 + ((128 - key) & 127)] - M0) : 0.f;
            l[hh] += ev;
#pragma unroll
            for (int e = 0; e < 4; ++e) o[hh][e] += ev * vv[i][e];
        }
    }
#pragma unroll
    for (int hh = 0; hh < 4; ++hh) {
        l[hh] += __shfl_xor(l[hh], 16); l[hh] += __shfl_xor(l[hh], 32);
#pragma unroll
        for (int e = 0; e < 4; ++e) { o[hh][e] += __shfl_xor(o[hh][e], 16); o[hh][e] += __shfl_xor(o[hh][e], 32); }
    }
    if (ksub == 0) {
#pragma unroll
        for (int hh = 0; hh < 4; ++hh) *(LAS f32x4*)(part + (w * 4 + hh) * 64 + 4 * dch) = (f32x4){o[hh][0], o[hh][1], o[hh][2], o[hh][3]};
    }
    if (lane < 4) part[8 * 256 + w * 4 + lane] = (lane == 0) ? l[0] : (lane == 1) ? l[1] : (lane == 2) ? l[2] : l[3];
    LDS_WAIT(); __syncthreads();
    if (kq == 0) {
        const float* kn = (const float*)(F.ws + WS_KVNEW) + (size_t)bs * 256 + g * 64; const float* vn = kn + 128 * 256;
        const float knew = kn[lane], vnew = vn[lane];
        const bf16* sga = (const bf16*)(F.ws + WS_SGA) + (size_t)(MP + bs) * DM + g * 256;
        bf16* yt = (bf16*)(F.ws + WS_YT) + (size_t)bs * 2048 + g * 256;
        float qh[4], sgv[4], snk[4];
#pragma unroll
        for (int hh = 0; hh < 4; ++hh) { qh[hh] = bf2f(QT[hh * 64 + lane]); sgv[hh] = bf2f(sga[hh * 64 + lane]); snk[hh] = F.in[I_SINK][4 * g + hh]; }
        float res[4];
#pragma unroll
        for (int hh = 0; hh < 4; ++hh) {
            float sn = qh[hh] * knew;
#pragma unroll
            for (int ofs = 1; ofs < 64; ofs <<= 1) sn += __shfl_xor(sn, ofs);
            const float en = fexp2(sn + bt[(4 * g + hh) * 128] - M0);
            float osum = 0.f, lsum = 0.f;
#pragma unroll
            for (int k4 = 0; k4 < 4; ++k4) { osum += part[((w + k4) * 4 + hh) * 64 + lane]; lsum += part[8 * 256 + (w + k4) * 4 + hh]; }
            const float den = lsum + en + fexp2(snk[hh] * LOG2E - M0);
            res[hh] = (osum + en * vnew) / den * sgv[hh];
        }
        F.out[O_KWS + (((size_t)bs * 128 + 127) * 4 + g) * 64 + lane] = knew; F.out[O_VWS + (((size_t)bs * 128 + 127) * 4 + g) * 64 + lane] = vnew;
#pragma unroll
        for (int hh = 0; hh < 4; ++hh) yt[hh * 64 + lane] = (bf16)f2bf(res[hh]);
    }
    LDS_WAIT(); __syncthreads();
}

constexpr int KT_STRIDE = 144;
constexpr int VT_STRIDE = 520;
constexpr int AT_K = 0, AT_V = 256 * KT_STRIDE, AT_T = AT_V + 64 * VT_STRIDE, AT_END = AT_T + 4 * 384 * 4;
static_assert(AT_END <= RING_BYTES, "attention LDS");
struct KVRegs { v4u k[4], v[4]; };
__device__ __forceinline__ void attn_load_kv(Frame& F, int b, int n, int g, KVRegs& r) {
    const bf16* Kb = (const bf16*)(F.ws + WS_K); const bf16* Vb = (const bf16*)(F.ws + WS_V);
    const long krow0 = (long)b * SEQ + 128 * (n - 1);
#pragma unroll
    for (int i = 0; i < 4; ++i) {
        const int cidx = F.tid + 512 * i; int kl = cidx >> 3; const int c8 = cidx & 7;
        if (n == 0 && kl < 128) kl += 128;
        const size_t off = (size_t)(krow0 + kl) * 256 + g * 64 + 8 * c8;
        r.k[i] = *(const v4u*)(Kb + off); r.v[i] = *(const v4u*)(Vb + off);
    }
}
__device__ __forceinline__ void attn_store_kv(Frame& F, const KVRegs& r) {
    LAS unsigned char* L = F.lds;
#pragma unroll
    for (int i = 0; i < 4; ++i) {
        const int cidx = F.tid + 512 * i, kl = cidx >> 3, c8 = cidx & 7;
        *(LAS v4u*)(L + AT_K + kl * KT_STRIDE + 16 * c8) = r.k[i];
        LAS bf16* vt = (LAS bf16*)(L + AT_V) + kl;
        const unsigned ww[4] = {r.v[i].x, r.v[i].y, r.v[i].z, r.v[i].w};
#pragma unroll
        for (int e = 0; e < 4; ++e) { vt[(8 * c8 + 2 * e) * (VT_STRIDE / 2)] = (bf16)(ww[e] & 0xffffu); vt[(8 * c8 + 2 * e + 1) * (VT_STRIDE / 2)] = (bf16)(ww[e] >> 16); }
    }
}
__device__ __forceinline__ void attn_compute(Frame& F, int b, int n, int g, float M0) {
    const int lane = F.lane, r32 = lane & 31, hi = lane >> 5, w = F.wave;
    LAS unsigned char* L = F.lds;
    const int hq = w >> 1, head = 4 * g + hq;
    const bf16* Q = (const bf16*)(F.out + O_YP) + QM_OFF;
    const bf16* SGA = (const bf16*)(F.ws + WS_SGA);
    bf16* YM = (bf16*)(F.ws + WS_XN);
    const float sinkv = fexp2(F.in[I_SINK][head] * LOG2E - M0);
    const unsigned onew = (r32 == 0 || r32 == 4) ? 0x3f803f80u : 0u;
    const bf16x8 onesf = __builtin_bit_cast(bf16x8, (v4u){onew, onew, onew, onew});
    for (int sb = 0; sb < 2; ++sb) {
        const int s = 2 * (w & 1) + sb;
        const size_t qrow = (size_t)b * SEQ + 128 * n + 32 * s + r32;
        bf16x8 qf[4];
#pragma unroll
        for (int d0 = 0; d0 < 4; ++d0) qf[d0] = *(const bf16x8*)(Q + qrow * DM + head * 64 + 16 * d0 + 8 * hi);
        const bf16* sg = SGA + qrow * DM + head * 64 + 4 * hi;
        v2u sgw[8];
#pragma unroll
        for (int q4 = 0; q4 < 4; ++q4) { sgw[q4] = *(const v2u*)(sg + 8 * q4); sgw[4 + q4] = *(const v2u*)(sg + 32 + 8 * q4); }
        f32x16 o0 = {}, o1 = {}, o2 = {};
        for (int kk = 0; kk < 3; ++kk) {
            const int kt = (s >> 1) + kk;
            if (n == 0 && kt < 2) continue;
            f32x16 p0 = {}, p1 = {};
            const LAS unsigned char* kb = L + AT_K + (64 * kt + r32) * KT_STRIDE + 16 * hi;
#pragma unroll
            for (int d0 = 0; d0 < 4; ++d0) {
                const bf16x8 a0 = *(const LAS bf16x8*)(kb + 32 * d0);
                const bf16x8 a1 = *(const LAS bf16x8*)(kb + 32 * KT_STRIDE + 32 * d0);
                p0 = __builtin_amdgcn_mfma_f32_32x32x16_bf16(a0, qf[d0], p0, 0, 0, 0);
                p1 = __builtin_amdgcn_mfma_f32_32x32x16_bf16(a1, qf[d0], p1, 0, 0, 0);
            }
            const int dbase = 128 + 32 * s + r32 - 64 * kt - 4 * hi;
            const LAS float* tb = (const LAS float*)(L + AT_T) + hq * 384 + 128 + dbase - 59;
#pragma unroll
            for (int r = 0; r < 16; ++r) {
                const int c = (r & 3) + 8 * (r >> 2);
                p0[r] = fexp2(p0[r] + tb[59 - c]); p1[r] = fexp2(p1[r] + tb[27 - c]);
            }
            const LAS unsigned char* vb = L + AT_V + r32 * VT_STRIDE + (64 * kt + 4 * hi) * 2;
#pragma unroll
            for (int ks = 0; ks < 4; ++ks) {
                v4u pw;
                if (ks == 0)      { pw.x = pg8::cvt_pk_bf16(p0[0], p0[1]);   pw.y = pg8::cvt_pk_bf16(p0[2], p0[3]);   pw.z = pg8::cvt_pk_bf16(p0[4], p0[5]);   pw.w = pg8::cvt_pk_bf16(p0[6], p0[7]); }
                else if (ks == 1) { pw.x = pg8::cvt_pk_bf16(p0[8], p0[9]);   pw.y = pg8::cvt_pk_bf16(p0[10], p0[11]); pw.z = pg8::cvt_pk_bf16(p0[12], p0[13]); pw.w = pg8::cvt_pk_bf16(p0[14], p0[15]); }
                else if (ks == 2) { pw.x = pg8::cvt_pk_bf16(p1[0], p1[1]);   pw.y = pg8::cvt_pk_bf16(p1[2], p1[3]);   pw.z = pg8::cvt_pk_bf16(p1[4], p1[5]);   pw.w = pg8::cvt_pk_bf16(p1[6], p1[7]); }
                else              { pw.x = pg8::cvt_pk_bf16(p1[8], p1[9]);   pw.y = pg8::cvt_pk_bf16(p1[10], p1[11]); pw.z = pg8::cvt_pk_bf16(p1[12], p1[13]); pw.w = pg8::cvt_pk_bf16(p1[14], p1[15]); }
                const bf16x8 pb = __builtin_bit_cast(bf16x8, pw);
                const v2u va0 = *(const LAS v2u*)(vb + 32 * ks), va1 = *(const LAS v2u*)(vb + 32 * ks + 16);
                const v2u vc0 = *(const LAS v2u*)(vb + 32 * VT_STRIDE + 32 * ks), vc1 = *(const LAS v2u*)(vb + 32 * VT_STRIDE + 32 * ks + 16);
                const bf16x8 fa = __builtin_bit_cast(bf16x8, (v4u){va0.x, va0.y, va1.x, va1.y});
                const bf16x8 fc = __builtin_bit_cast(bf16x8, (v4u){vc0.x, vc0.y, vc1.x, vc1.y});
                o0 = __builtin_amdgcn_mfma_f32_32x32x16_bf16(fa, pb, o0, 0, 0, 0);
                o1 = __builtin_amdgcn_mfma_f32_32x32x16_bf16(fc, pb, o1, 0, 0, 0);
                o2 = __builtin_amdgcn_mfma_f32_32x32x16_bf16(onesf, pb, o2, 0, 0, 0);
            }
        }
        const float inv = 1.0f / (o2[0] + sinkv);
        bf16* yo = YM + qrow * DM + head * 64 + 4 * hi;
#pragma unroll
        for (int q4 = 0; q4 < 4; ++q4) {
            {
                const v2u sw = sgw[q4];
                v2u ow; ow.x = pg8::cvt_pk_bf16(o0[4 * q4] * inv * bflo(sw.x), o0[4 * q4 + 1] * inv * bfhi(sw.x)); ow.y = pg8::cvt_pk_bf16(o0[4 * q4 + 2] * inv * bflo(sw.y), o0[4 * q4 + 3] * inv * bfhi(sw.y));
                *(v2u*)(yo + 8 * q4) = ow;
            }
            {
                const v2u sw = sgw[4 + q4];
                v2u ow; ow.x = pg8::cvt_pk_bf16(o1[4 * q4] * inv * bflo(sw.x), o1[4 * q4 + 1] * inv * bfhi(sw.x)); ow.y = pg8::cvt_pk_bf16(o1[4 * q4 + 2] * inv * bflo(sw.y), o1[4 * q4 + 3] * inv * bfhi(sw.y));
                *(v2u*)(yo + 32 + 8 * q4) = ow;
            }
        }
    }
}
__device__ __forceinline__ void attn_phase(Frame& F, float M0) {
    const int NU = NB * 32 * 4;
    int u = blockIdx.x; if (u >= NU) return;
    KVRegs r; attn_load_kv(F, u >> 7, (u >> 2) & 31, u & 3, r);
    for (; u < NU; u += F.G) {
        attn_store_kv(F, r);
        {
            const int g_ = u & 3; LAS float* tb = (LAS float*)(F.lds + AT_T);
            float rv[3];
#pragma unroll
            for (int i = 0; i < 3; ++i) { const int e = F.tid + 512 * i, hh = e / 384, dist = e % 384 - 128; rv[i] = F.in[I_REL][rel_bucket(dist & 127) * 16 + 4 * g_ + hh]; }
#pragma unroll
            for (int i = 0; i < 3; ++i) { const int e = F.tid + 512 * i, dist = e % 384 - 128; tb[e] = ((unsigned)dist < 128u) ? rv[i] * LOG2E - M0 : -1e30f; }
        }
        const int un = u + F.G;
        if (un < NU) attn_load_kv(F, un >> 7, (un >> 2) & 31, un & 3, r);
        LDS_WAIT(); __syncthreads();
        attn_compute(F, u >> 7, (u >> 2) & 31, u & 3, M0);
        __syncthreads();
    }
}

constexpr int REP[7] = {1, 1, 1, 1, 1, 1, 1};
constexpr int REPS[4] = {1, 1, 1, 1};
__global__ void __launch_bounds__(NWAVES * 64, 2) hyb_fwd(Args args) {
    extern __shared__ __attribute__((aligned(16))) unsigned char lds[];
    Frame F;
    F.lds = (LAS unsigned char*)lds;
    F.tid = threadIdx.x; F.lane = F.tid & 63; F.wave = __builtin_amdgcn_readfirstlane(F.tid >> 6);
    F.G = gridDim.x; { const int bx = blockIdx.x; F.vcu = (F.G % 8 == 0) ? (bx % 8) * (F.G / 8) + bx / 8 : bx; }
    F.in = args.in; F.out = args.out; F.ws = args.ws;
    volatile LAS unsigned* MISC = (volatile LAS unsigned*)(F.lds + MISC_OFF);
    for (int u = F.tid; u < (LDS_BYTES - LDSCTL_OFF) / 4; u += NWAVES * 64) ((LAS unsigned*)(F.lds + LDSCTL_OFF))[u] = 0u;
    __syncthreads();
    const int lo = args.ph_lo, hi = args.ph_hi;
    const bool one = (hi - lo) > 1;
    XcdBarrier bar; bar.bar = (unsigned*)(F.ws + WS_CTL) + CW_BAR; bar.x = 0; bar.st = nullptr;
    if (one) bar = xcd_barrier_post((unsigned*)(F.ws + WS_CTL) + CW_BAR, MISC + 8);
#define IN(k) (lo <= (k) && (k) < hi)
#define SEAM(k) do { if (IN(k) && IN((k) + 1)) xcd_barrier(bar); } while (0)
    const int gw = F.vcu * NWAVES + F.wave, NGW = F.G * NWAVES;
    LAS unsigned char* wl = F.lds + F.wave * 16384;

    unsigned* ctlw = (unsigned*)(F.ws + WS_CTL);
    for (int rep = 0; rep < REP[0]; ++rep)
    if (IN(0)) {
        refresh(F);
        for (int t = blockIdx.x; t < 192; t += F.G) { p0_mod_tile(F, t); soft_arrive(ctlw + CW_MODC, 1u); }
        p0_weights(F);
        {
            const int gt_ = F.vcu * (NWAVES * 64) + F.tid, NGT = F.G * NWAVES * 64;
            unsigned long long* za = (unsigned long long*)(F.ws + WS_LBA); unsigned long long* zh = (unsigned long long*)(F.ws + WS_LBH);
            for (int e = gt_; e < 131072; e += NGT) __hip_atomic_store(za + e, 0ull, __ATOMIC_RELAXED, __HIP_MEMORY_SCOPE_AGENT);
            for (int e = gt_; e < 16384; e += NGT) __hip_atomic_store(zh + e, 0ull, __ATOMIC_RELAXED, __HIP_MEMORY_SCOPE_AGENT);
        }
        __syncthreads();
    }
    for (int rep = 0; rep < REP[1]; ++rep)
    if (IN(1)) { refresh(F); soft_wait(ctlw + CW_MODC, 192u); p1_xn(F); }
    SEAM(1);
    for (int rep = 0; rep < REP[2]; ++rep)
    if (IN(2)) {
        pg8::Gemm g{(const bf16*)(F.ws + WS_XN), (const bf16*)(F.ws + WS_WIN), MPAD, INW, DM, nullptr, DM};
        pg8::StaticOrder S; S.init(MPAD, INW, F.G, (int)blockIdx.x);
        EpiZ E{F.ws, F.out, F.in[I_QG], F.in[I_KG]};
        pg8::gemm_phase<EpiZ, pg8::StaticOrder, true, true>(F.lds, g, S, E);
        refresh(F);
        for (;;) {
            if (F.tid == 0) MISC[10] = __hip_atomic_fetch_add(ctlw + CW_TQ, 1u, __ATOMIC_RELAXED, __HIP_MEMORY_SCOPE_AGENT);
            __syncthreads();
            const int it = (int)MISC[10];
            __syncthreads();
            if (it >= TQ_ALL) break;
            tail_item(F, it);
        }
    }
    SEAM(2);
    for (int rep = 0; rep < REP[3]; ++rep)
    if (IN(3)) {
        refresh(F);
        const float M0 = logit_bound(F);
        build_bias_table(F);
        LDS_WAIT(); __syncthreads();
        for (int rs = 0; rs < REPS[0]; ++rs) {
        for (int u = F.vcu; u < NS * 2; u += F.G) sample_attn_block(F, u, M0);
        }
        if (F.G == 256) {
            scan_lb_block(F, F.vcu);
            build_bias_table(F); LDS_WAIT(); __syncthreads();
        } else {
            for (int u = F.vcu; u < 256; u += F.G) scan_block<1>(F, u);
            soft_arrive(ctlw + CW_S1C, 1u);
        }
        for (int rs = 0; rs < REPS[2]; ++rs)
        attn_phase(F, M0);
    }
    for (int rep = 0; rep < REP[4]; ++rep)
    if (IN(4) && F.G != 256) {
        refresh(F);
        soft_wait(ctlw + CW_S1C, (unsigned)F.G);
        for (int u = F.vcu; u < 256; u += F.G) scan_block<2>(F, u);
        __syncthreads();
    }
    SEAM(4);
    for (int rep = 0; rep < REP[5]; ++rep)
    if (IN(5)) {
        pg8::Gemm g{(const bf16*)(F.ws + WS_XN), (const bf16*)(F.ws + WS_WPP), MP, DM, 2048, (const bf16*)(F.out + O_YP), DM};
        pg8::StaticOrder S; S.init(MP, DM, F.G, (int)blockIdx.x);
        EpiMerge E{F.ws + WS_RAT, F.ws + WS_SMR, (bf16*)(F.ws + WS_SGA)};
        pg8::gemm_phase<EpiMerge, pg8::StaticOrder, false, true>(F.lds, g, S, E);
        refresh(F);
        for (int t = F.vcu; t < 256; t += F.G) mini_merge_block(F, t);
    }
    SEAM(5);
    for (int rep = 0; rep < REP[6]; ++rep)
    if (IN(6)) {
        pg8::Gemm g{(const bf16*)(F.ws + WS_SGA), (const bf16*)(F.ws + WS_WOUT), MP, DM, DM, nullptr, DM};
        pg8::StaticOrder S; S.init(MP, DM, F.G, (int)blockIdx.x);
        EpiOut E{F.in[I_XP], (const float*)(F.ws + WS_MOD), F.out + O_YP};
        pg8::gemm_phase<EpiOut, pg8::StaticOrder, false, true>(F.lds, g, S, E);
        refresh(F);
        for (int t = F.vcu; t < 256; t += F.G) mini_out_block(F, t);
    }
#undef IN
#undef SEAM
}

#ifndef MK_N_LAUNCHES
#define MK_N_LAUNCHES 1
#endif
constexpr int N_PHASES = 7;

extern "C" void kernel_launch(void* const* d_in, const int* in_sizes, int n_in, void* d_out, int out_size, void* d_ws, size_t ws_size, hipStream_t stream) {
    static int grid = 0;
    if (grid == 0) {
        if (n_in != 26 || out_size != (int)O_END || ws_size < WS_END) { fprintf(stderr, "kernel_launch: unexpected shapes (n_in %d out %d ws %zu)\n", n_in, out_size, ws_size); grid = -1; return; }
        int dev = 0, cus = 0, per_cu = 0;
        if (hipGetDevice(&dev) != hipSuccess || hipDeviceGetAttribute(&cus, hipDeviceAttributeMultiprocessorCount, dev) != hipSuccess) { grid = -1; return; }
        if (hipFuncSetAttribute((const void*)hyb_fwd, hipFuncAttributeMaxDynamicSharedMemorySize, LDS_BYTES) != hipSuccess) { fprintf(stderr, "kernel_launch: hipFuncSetAttribute failed\n"); grid = -1; return; }
        if (hipOccupancyMaxActiveBlocksPerMultiprocessor(&per_cu, (const void*)hyb_fwd, NWAVES * 64, LDS_BYTES) != hipSuccess || per_cu < 1) { fprintf(stderr, "kernel_launch: occupancy query says %d\n", per_cu); per_cu = 1; }
        (void)hipGetLastError();
        grid = cus * (per_cu < 1 ? 1 : 1);
    }
    if (grid < 0) return;
    (void)hipMemsetAsync((char*)d_ws + WS_CTL, 0, CTL_ZERO_BYTES, stream);
    Args a{};
    for (int i = 0; i < 26; ++i) a.in[i] = (const float*)d_in[i];
    a.out = (float*)d_out; a.ws = (unsigned char*)d_ws;
    if (MK_N_LAUNCHES == 1) {
        a.ph_lo = 0; a.ph_hi = N_PHASES;
        void* kargs[] = {&a};
        hipError_t e = hipLaunchCooperativeKernel((const void*)hyb_fwd, dim3(grid), dim3(NWAVES * 64), kargs, LDS_BYTES, stream);
        if (e != hipSuccess) fprintf(stderr, "kernel_launch: cooperative launch failed: %s (grid %d)\n", hipGetErrorString(e), grid);
    } else {
        for (int p = 0; p < N_PHASES; ++p) {
            a.ph_lo = p; a.ph_hi = p + 1;
            hipLaunchKernelGGL(hyb_fwd, dim3(grid), dim3(NWAVES * 64), LDS_BYTES, stream, a);
        }
    }
}
```

```cpp
#include <hip/hip_runtime.h>
#include <cstdio>
#include <cstdint>

namespace pg8 {
#define PG8_LAS __attribute__((address_space(3)))
typedef unsigned short bf16_t;
typedef short bf16x8 __attribute__((ext_vector_type(8)));
typedef float f32x4 __attribute__((ext_vector_type(4)));
typedef unsigned u32x4 __attribute__((ext_vector_type(4)));
constexpr int BM = 256, BK = 64, HALF = 128, HTB = HALF * BK * 2, STAGE_BYTES = 8 * HTB, NXCD = 8, WGM = 8;

__host__ __device__ __forceinline__ int lds_byte(int r, int c) { const int st = (r >> 4) * 2 + (c >> 5), rr = r & 15, cc = c & 31, ob = rr * 64 + cc * 2; return st * 1024 + (ob ^ (((ob >> 9) & 1) << 5)); }
__host__ __device__ __forceinline__ void stage_rc(int b, int& R, int& C) { const int st = b / 1024, sb = b % 1024, swz = sb ^ (((sb >> 9) & 1) << 5); R = (st >> 1) * 16 + swz / 64; C = (st & 1) * 32 + (swz % 64) / 2; }
__host__ __device__ __forceinline__ int perm32(int rho) { const int n = rho >> 4, i = rho & 15; return 8 * (i >> 2) + 4 * n + (i & 3); }

struct Unit { int pm, pn; };
struct Gemm { const bf16_t* A; const bf16_t* Bt; int M, N, K; const bf16_t* A2; int lda; };

struct StaticOrder {
    int nM, nN, nwg, G, c;
    __host__ __device__ void init(int M, int N, int G_, int c_) { nM = M / BM; nN = N / BM; nwg = nM * nN; G = G_; c = c_; }
    __host__ __device__ bool next(int i, Unit& u) const {
        const long L = (long)i * G + c; if (L >= nwg) return false;
        int wgid = (int)L; { const int q = nwg / NXCD, r = nwg % NXCD, xcd = wgid % NXCD, off = wgid / NXCD; wgid = (xcd < r ? xcd * (q + 1) : r * (q + 1) + (xcd - r) * q) + off; }
        const int nig = WGM * nN, gid = wgid / nig, fm = gid * WGM, gsz = (nM - fm) < WGM ? (nM - fm) : WGM;
        u.pm = fm + ((wgid % nig) % gsz); u.pn = (wgid % nig) / gsz; return true;
    }
    __device__ __forceinline__ void a_ready(const Unit&) const {}
    __device__ __forceinline__ void done(const Unit&) const {}
};

typedef float f32x2_t __attribute__((ext_vector_type(2))); typedef __bf16 bf16x2_t __attribute__((ext_vector_type(2)));
__device__ __forceinline__ unsigned cvt_pk_bf16(float lo, float hi) { f32x2_t v = {lo, hi}; bf16x2_t b = __builtin_convertvector(v, bf16x2_t); return __builtin_bit_cast(unsigned, b); }

template <class Epi, class Sched, bool ALIGN_EPI = false, bool SP2 = false>
__device__ __forceinline__ void gemm_phase(PG8_LAS unsigned char* lds, const Gemm g, const Sched& S, const Epi& E) {
    int tid_ = threadIdx.x; asm volatile("" : "+v"(tid_));
    const int tid = tid_, wid = __builtin_amdgcn_readfirstlane(tid >> 6), lane = tid & 63, wr = wid >> 2, wc = wid & 3, fr = lane & 15, fq = lane >> 4;
    const int K = g.K, nt = K / BK;
    unsigned voffA[2], voffB[2];
#pragma unroll
    for (int i = 0; i < 2; ++i) { int R, C; stage_rc(tid * 16 + i * 8192, R, C); const int Rb = Epi::PERM ? ((R & ~31) + perm32(R & 31)) : R;
        voffA[i] = (unsigned)(R * g.lda + C) * 2u; voffB[i] = (unsigned)(Rb * K + C) * 2u; }
    const size_t kstep = (size_t)(BK * 2);
    const size_t hstep = (size_t)HALF * K * 2;
    const size_t tstep = 2 * hstep;
    const size_t hstepA = (size_t)HALF * g.lda * 2, tstepA = 2 * hstepA;
    const int nh = g.A2 ? nt / 2 : nt + 4;
    const long a2delta = g.A2 ? ((const char*)g.A2 - (const char*)g.A) - (long)nh * (long)kstep : 0;
    const unsigned ldsw = (unsigned)wid * 1024u;
    const int aoff = lds_byte(wr * 64 + fr, fq * 8), boff = lds_byte(wc * 32 + fr, fq * 8);
#define PG8_SA(b, h) (((b) * 2 + (h)) * HTB)
#define PG8_SB(b, h) ((4 + (b) * 2 + (h)) * HTB)
#define PG8_STAGE(bufoff, gbase, voff) do { _Pragma("unroll") for (int _i = 0; _i < 2; ++_i) \
        __builtin_amdgcn_global_load_lds((const unsigned*)((const char*)(gbase) + (voff)[_i]), (PG8_LAS unsigned*)(lds + (bufoff) + ldsw + _i * 8192), 16, 0, 0); } while (0)
#define PG8_LDA(dst, b, h) do { _Pragma("unroll") for (int m = 0; m < 4; ++m) _Pragma("unroll") for (int k = 0; k < 2; ++k) dst[m][k] = *(const PG8_LAS bf16x8*)(lds + PG8_SA(b, h) + aoff + m * 2048 + k * 1024); } while (0)
#define PG8_LDB(dst, b, h) do { _Pragma("unroll") for (int n = 0; n < 2; ++n) _Pragma("unroll") for (int k = 0; k < 2; ++k) dst[n][k] = *(const PG8_LAS bf16x8*)(lds + PG8_SB(b, h) + boff + n * 2048 + k * 1024); } while (0)
#define PG8_MMA(ai, bj, At, Bt) do { __builtin_amdgcn_s_setprio(1); _Pragma("unroll") for (int m = 0; m < 4; ++m) _Pragma("unroll") for (int n = 0; n < 2; ++n) _Pragma("unroll") for (int k = 0; k < 2; ++k) \
        acc[ai][bj][m][n] = __builtin_amdgcn_mfma_f32_16x16x32_bf16(Bt[n][k], At[m][k], acc[ai][bj][m][n], 0, 0, 0); __builtin_amdgcn_s_setprio(0); } while (0)
#define PG8_WAIT_V(n) asm volatile("s_waitcnt vmcnt(" #n ")" ::: "memory")
#define PG8_WAIT_L(n) asm volatile("s_waitcnt lgkmcnt(" #n ")" ::: "memory")
#define PG8_BAR __builtin_amdgcn_s_barrier()
#define PG8_SCHED __builtin_amdgcn_sched_barrier(0)
    Unit cur, nxt; int ui = 0;
    if (!S.next(0, cur)) return;
    f32x4 acc[2][2][4][2];
#pragma unroll
    for (int a = 0; a < 2; ++a)
#pragma unroll
        for (int b = 0; b < 2; ++b)
#pragma unroll
            for (int m = 0; m < 4; ++m)
#pragma unroll
                for (int n = 0; n < 2; ++n) acc[a][b][m][n] = (f32x4){0.f, 0.f, 0.f, 0.f};
    bf16x8 At[4][2], B0[2][2], B1[2][2];
    const char* cA = (const char*)g.A + (size_t)cur.pm * tstepA; const char* cB = (const char*)g.Bt + (size_t)cur.pn * tstep;
    S.a_ready(cur);
    if constexpr (SP2) {
        PG8_STAGE(PG8_SB(0, 0), cB, voffB); PG8_STAGE(PG8_SB(0, 1), cB + hstep, voffB); PG8_STAGE(PG8_SA(0, 0), cA, voffA); PG8_STAGE(PG8_SA(0, 1), cA + hstepA, voffA);
        if (wr == 1) PG8_BAR;
        PG8_WAIT_V(2); PG8_BAR;
        PG8_STAGE(PG8_SB(1, 0), cB + kstep, voffB); PG8_STAGE(PG8_SA(1, 0), cA + kstep, voffA); PG8_STAGE(PG8_SB(1, 1), cB + hstep + kstep, voffB);
        PG8_WAIT_V(6); PG8_BAR;
    } else {
        PG8_STAGE(PG8_SB(0, 0), cB, voffB); PG8_STAGE(PG8_SA(0, 0), cA, voffA); PG8_STAGE(PG8_SB(0, 1), cB + hstep, voffB); PG8_STAGE(PG8_SA(0, 1), cA + hstepA, voffA);
        if (wr == 1) PG8_BAR;
        PG8_WAIT_V(4); PG8_BAR;
        PG8_STAGE(PG8_SB(1, 0), cB + kstep, voffB); PG8_STAGE(PG8_SA(1, 0), cA + kstep, voffA); PG8_STAGE(PG8_SB(1, 1), cB + hstep + kstep, voffB);
        PG8_WAIT_V(6); PG8_BAR;
    }
    for (;;) {
        const bool has_next = S.next(ui + 1, nxt);
        const char* nA = has_next ? (const char*)g.A + (size_t)nxt.pm * tstepA : cA; const char* nB = has_next ? (const char*)g.Bt + (size_t)nxt.pn * tstep : cB;
        for (int t = 0; t < nt; t += 2) {
            if constexpr (Epi::HAS_MID) { if (t == nt / 2) E.mid(acc, cur, wr, wc, fr, fq); }
            const bool last = (t == nt - 2);
            const char* a1 = cA + (t >= nh ? a2delta : 0) + (size_t)(t + 1) * kstep;
            const char* a2 = last ? nA : cA + (t + 2 >= nh ? a2delta : 0) + (size_t)(t + 2) * kstep; const char* b2 = last ? nB : cB + (size_t)(t + 2) * kstep;
            const char* a3 = a2 + kstep; const char* b3 = b2 + kstep;
            if (last && has_next) S.a_ready(nxt);
            if constexpr (SP2) {
            PG8_LDB(B0, 0, 0); PG8_LDB(B1, 0, 1); PG8_SCHED; PG8_LDA(At, 0, 0); PG8_STAGE(PG8_SA(1, 1), a1 + hstepA, voffA);
            PG8_WAIT_V(8); PG8_WAIT_L(0); PG8_BAR; PG8_MMA(0, 0, At, B0); PG8_MMA(0, 1, At, B1); PG8_BAR; PG8_SCHED;
            PG8_LDA(At, 0, 1); PG8_STAGE(PG8_SB(0, 0), b2, voffB); PG8_STAGE(PG8_SB(0, 1), b2 + hstep, voffB); PG8_STAGE(PG8_SA(0, 0), a2, voffA);
            PG8_WAIT_V(8); PG8_WAIT_L(0); PG8_BAR; PG8_MMA(1, 0, At, B0); PG8_MMA(1, 1, At, B1); PG8_BAR; PG8_SCHED;
            PG8_LDB(B0, 1, 0); PG8_LDB(B1, 1, 1); PG8_SCHED; PG8_LDA(At, 1, 0); PG8_STAGE(PG8_SA(0, 1), a2 + hstepA, voffA);
            PG8_WAIT_V(8); PG8_WAIT_L(0); PG8_BAR; PG8_MMA(0, 0, At, B0); PG8_MMA(0, 1, At, B1); PG8_BAR; PG8_SCHED;
            PG8_LDA(At, 1, 1); PG8_STAGE(PG8_SB(1, 0), b3, voffB); PG8_STAGE(PG8_SB(1, 1), b3 + hstep, voffB); PG8_STAGE(PG8_SA(1, 0), a3, voffA);
            PG8_WAIT_V(8); PG8_WAIT_L(0); PG8_BAR; PG8_MMA(1, 0, At, B0); PG8_MMA(1, 1, At, B1); PG8_BAR; PG8_SCHED;
            } else {
            PG8_LDB(B0, 0, 0); PG8_SCHED; PG8_LDA(At, 0, 0); PG8_STAGE(PG8_SA(1, 1), a1 + hstepA, voffA);
            PG8_WAIT_L(8); PG8_BAR; PG8_WAIT_L(0); PG8_MMA(0, 0, At, B0); PG8_BAR; PG8_SCHED;
            PG8_LDB(B1, 0, 1); PG8_STAGE(PG8_SB(0, 0), b2, voffB);
            PG8_BAR; PG8_WAIT_L(0); PG8_MMA(0, 1, At, B1); PG8_BAR;
            PG8_LDA(At, 0, 1); PG8_STAGE(PG8_SA(0, 0), a2, voffA);
            PG8_BAR; PG8_WAIT_L(0); PG8_MMA(1, 0, At, B0); PG8_BAR; PG8_SCHED;
            PG8_STAGE(PG8_SB(0, 1), b2 + hstep, voffB);
            PG8_WAIT_V(6); PG8_BAR; PG8_MMA(1, 1, At, B1); PG8_BAR;
            PG8_LDB(B0, 1, 0); PG8_SCHED; PG8_LDA(At, 1, 0); PG8_STAGE(PG8_SA(0, 1), a2 + hstepA, voffA);
            PG8_WAIT_L(8); PG8_BAR; PG8_WAIT_L(0); PG8_MMA(0, 0, At, B0); PG8_BAR; PG8_SCHED;
            PG8_LDB(B1, 1, 1); PG8_STAGE(PG8_SB(1, 0), b3, voffB);
            PG8_BAR; PG8_WAIT_L(0); PG8_MMA(0, 1, At, B1); PG8_BAR;
            PG8_LDA(At, 1, 1); PG8_STAGE(PG8_SA(1, 0), a3, voffA);
            PG8_BAR; PG8_WAIT_L(0); PG8_MMA(1, 0, At, B0); PG8_BAR; PG8_SCHED;
            PG8_STAGE(PG8_SB(1, 1), b3 + hstep, voffB);
            PG8_WAIT_V(6); PG8_BAR; PG8_MMA(1, 1, At, B1); PG8_BAR;
            }
        }
        if constexpr (ALIGN_EPI) { if (wr == 0) PG8_BAR; }
        E(acc, cur, wr, wc, fr, fq); S.done(cur);
        if (!has_next) break;
#pragma unroll
        for (int a = 0; a < 2; ++a)
#pragma unroll
            for (int b = 0; b < 2; ++b)
#pragma unroll
                for (int m = 0; m < 4; ++m)
#pragma unroll
                    for (int n = 0; n < 2; ++n) acc[a][b][m][n] = (f32x4){0.f, 0.f, 0.f, 0.f};
        cur = nxt; cA = nA; cB = nB; ++ui;
        if constexpr (ALIGN_EPI) { if (wr == 1) PG8_BAR; }
    }
    PG8_WAIT_V(0);
    if constexpr (!ALIGN_EPI) { if (wr == 0) PG8_BAR; }
    PG8_BAR;
#undef PG8_SA
#undef PG8_SB
#undef PG8_STAGE
#undef PG8_LDA
#undef PG8_LDB
#undef PG8_MMA
#undef PG8_WAIT_V
#undef PG8_WAIT_L
#undef PG8_BAR
#undef PG8_SCHED
}
}

constexpr int NWAVES = 8;
constexpr int DM = 1024, NB = 4, SEQ = 4096, NS = 128, WIN = 128;
constexpr int MP = NB * SEQ;
constexpr int MALL = MP + NS;
constexpr int MPAD = 16640;
constexpr int INW = 6656;
constexpr int NCH = 32;
constexpr float EPSN = 1e-6f;
constexpr float LOG2E = 1.4426950408889634f;
constexpr float QSCALE = 0.125f * LOG2E;

constexpr size_t MiB = 1u << 20;
constexpr size_t WS_CTL = 0, CTL_ZERO_BYTES = 64 * 1024;
constexpr size_t WS_MOD = 1 * MiB;
constexpr size_t WS_WRA = 3 * MiB;
constexpr size_t WS_WRX = 3 * MiB + 128 * 1024;
constexpr size_t WS_KVNEW = 3 * MiB + 256 * 1024;
constexpr size_t WS_AGG = 4 * MiB;
constexpr size_t WS_LBA = 4 * MiB;
constexpr size_t WS_LBH = 3 * MiB + 512 * 1024;
constexpr size_t WS_WIN = 5 * MiB;
constexpr size_t WS_WPP = 18 * MiB;
constexpr size_t WS_WOUT = 22 * MiB;
constexpr size_t WS_XN = 24 * MiB;
constexpr size_t ACT = (size_t)MPAD * DM * 2;
constexpr size_t WS_K = WS_XN + ACT;
constexpr size_t WS_V = WS_K + ACT / 4;
constexpr size_t WS_SGA = WS_V + ACT / 4;
constexpr size_t WS_XR = WS_SGA + ACT;
constexpr size_t WS_SGR = WS_XR + ACT;
constexpr size_t WS_RAT = WS_SGR + ACT;
constexpr size_t WS_SMR = WS_RAT + ACT;
constexpr size_t WS_QT = WS_SMR + ACT;
constexpr size_t WS_YT = WS_QT + 512 * 1024;
constexpr size_t WS_MGT = WS_YT + 512 * 1024;
constexpr size_t WS_END = WS_MGT + 256 * 1024;
static_assert(WS_END <= 256 * MiB, "d_ws map");
constexpr size_t O_YP = 0, O_YS = 16777216, O_KWP = 16908288, O_VWP = 17039360, O_CVP = 17170432, O_HP = 17182720,
                 O_KWS = 17186816, O_VWS = 21381120, O_CVS = 25575424, O_HS = 25968640, O_END = 26099712;
constexpr size_t QM_OFF = (size_t)MP * DM;

constexpr int CW_BAR = 1024, CW_MODC = 64, CW_S1C = 128, CW_TQ = 192;

constexpr int RING_BYTES = 131072;
constexpr int GW_OFF = RING_BYTES, GW_STRIDE = 144, GW_BYTES = 2 * 64 * GW_STRIDE;
constexpr int BT_OFF = GW_OFF + GW_BYTES, BT_BYTES = 16 * 128 * 4;
constexpr int LDSCTL_OFF = BT_OFF + BT_BYTES, MISC_OFF = LDSCTL_OFF + 320;
constexpr int LDS_BYTES = LDSCTL_OFF + 512;

#define GAS __attribute__((address_space(1)))
#define LAS __attribute__((address_space(3)))
typedef unsigned short bf16;
typedef unsigned v4u __attribute__((ext_vector_type(4)));
typedef unsigned v2u __attribute__((ext_vector_type(2)));
typedef float f32x4 __attribute__((ext_vector_type(4)));
typedef float f32x16 __attribute__((ext_vector_type(16)));
typedef short bf16x8 __attribute__((ext_vector_type(8)));
typedef short s16x4 __attribute__((ext_vector_type(4)));
typedef GAS unsigned gu32;
#define RLX_AGENT __ATOMIC_RELAXED, __HIP_MEMORY_SCOPE_AGENT
#define LDS_WAIT() asm volatile("s_waitcnt lgkmcnt(0)" ::: "memory")
#define VM_WAIT() asm volatile("s_waitcnt vmcnt(0)" ::: "memory")
__device__ __forceinline__ unsigned f2bf(float f) { unsigned u = __builtin_bit_cast(unsigned, f); return (u + 0x7fffu + ((u >> 16) & 1u)) >> 16; }
__device__ __forceinline__ unsigned pk2(float lo, float hi) { return f2bf(lo) | (f2bf(hi) << 16); }
__device__ __forceinline__ float bf2f(unsigned b) { return __uint_as_float(b << 16); }
__device__ __forceinline__ float bflo(unsigned w) { return __uint_as_float(w << 16); }
__device__ __forceinline__ float bfhi(unsigned w) { return __uint_as_float(w & 0xffff0000u); }
__device__ __forceinline__ unsigned pk_u8x4(float a, float b, float c, float d) {
    unsigned r = __builtin_amdgcn_cvt_pk_u8_f32(fmaxf(a * 255.0f, 1.0f), 0, 0u); r = __builtin_amdgcn_cvt_pk_u8_f32(fmaxf(b * 255.0f, 1.0f), 1, r);
    r = __builtin_amdgcn_cvt_pk_u8_f32(fmaxf(c * 255.0f, 1.0f), 2, r); return __builtin_amdgcn_cvt_pk_u8_f32(fmaxf(d * 255.0f, 1.0f), 3, r); }
__device__ __forceinline__ float u8f(unsigned w, int i) { return (float)((w >> (8 * i)) & 0xffu); }
__device__ __forceinline__ float fexp2(float x) { return __builtin_amdgcn_exp2f(x); }
__device__ __forceinline__ float frcp(float x) { return __builtin_amdgcn_rcpf(x); }
__device__ __forceinline__ float sigm(float x) { return frcp(1.0f + fexp2(-LOG2E * x)); }

#define XB_TMO      128
#define XB_XCNT(j)  (256  + 64 * (j))
#define XB_XSUB(j)  (1280 + 64 * (j))
#define XB_XGEN(j)  (2304 + 64 * (j))
#define XB_TOP      3328
#define XB_TOPGEN   3392
#define XCD_BAR_WORDS 3456
#define XB_SPIN_CAP (1u << 22)
__device__ __forceinline__ unsigned xb_ld(unsigned* p)              { return __hip_atomic_load(p, __ATOMIC_RELAXED, __HIP_MEMORY_SCOPE_AGENT); }
__device__ __forceinline__ unsigned xb_add(unsigned* p, unsigned v) { return __hip_atomic_fetch_add(p, v, __ATOMIC_RELAXED, __HIP_MEMORY_SCOPE_AGENT); }
__device__ __forceinline__ unsigned xb_xcc_id() { return (unsigned)__builtin_amdgcn_s_getreg((3 << 11) | 20) & 0xFu; }
#define XB_SPIN(cond, bar) do { unsigned _sp = 0; while (cond) { __builtin_amdgcn_s_sleep(1); \
    if ((++_sp & 255u) == 0u) { if (xb_ld(&(bar)[XB_TMO])) break; if (_sp > XB_SPIN_CAP) { atomicAdd(&(bar)[XB_TMO], 1u); break; } } } } while (0)
struct XcdBarrier { unsigned* bar; unsigned x; volatile LAS unsigned* st; };
__device__ __forceinline__ XcdBarrier xcd_barrier_post(unsigned* bar, volatile LAS unsigned* st) {
    XcdBarrier b; b.bar = bar; b.x = xb_xcc_id(); b.st = st;
    if (threadIdx.x == 0) (void)xb_add(&bar[XB_XCNT(b.x)], 1u);
    return b;
}
__device__ __forceinline__ void xcd_barrier_complete(unsigned* bar, unsigned x, unsigned& nloc, unsigned& nx) {
    const unsigned G = gridDim.x * gridDim.y * gridDim.z;
    unsigned sum, cnt, mine, sp = 0u;
    for (;;) {
        sum = 0u; cnt = 0u; mine = 0u;
#pragma unroll
        for (unsigned j = 0; j < 16; ++j) { const unsigned c = xb_ld(&bar[XB_XCNT(j)]); sum += c; cnt += (c > 0u) ? 1u : 0u; mine = (j == x) ? c : mine; }
        if (sum == G) break;
        __builtin_amdgcn_s_sleep(1);
        if ((++sp & 255u) == 0u) { if (xb_ld(&bar[XB_TMO])) break; if (sp > XB_SPIN_CAP) { atomicAdd(&bar[XB_TMO], 1u); break; } }
    }
    nloc = mine > 0u ? mine : 1u; nx = cnt > 0u ? cnt : 1u;
}
__device__ __forceinline__ void xcd_barrier(const XcdBarrier& b) {
    asm volatile("s_waitcnt vmcnt(0)" ::: "memory");
    __syncthreads();
    if (threadIdx.x == 0) {
        unsigned* bar = b.bar;
        __builtin_amdgcn_s_waitcnt(0);
        unsigned nloc = b.st[0], nx = b.st[1];
        if (nloc == 0u) { xcd_barrier_complete(bar, b.x, nloc, nx); b.st[0] = nloc; b.st[1] = nx; }
        const unsigned old = xb_add(&bar[XB_XSUB(b.x)], 1u);
        const unsigned gen = old / nloc;
        if (old + 1u == (gen + 1u) * nloc) {
            __builtin_amdgcn_fence(__ATOMIC_RELEASE, "agent");
            asm volatile("s_waitcnt vmcnt(0)" ::: "memory");
            const unsigned og = xb_add(&bar[XB_TOP], 1u);
            const unsigned tg = og / nx;
            if (og + 1u == (tg + 1u) * nx) xb_add(&bar[XB_TOPGEN], 1u);
            else XB_SPIN(xb_ld(&bar[XB_TOPGEN]) == tg, bar);
            __builtin_amdgcn_fence(__ATOMIC_ACQUIRE, "agent");
            xb_add(&bar[XB_XGEN(b.x)], 1u);
            asm volatile("s_waitcnt vmcnt(0)" ::: "memory");
        } else {
            XB_SPIN(xb_ld(&bar[XB_XGEN(b.x)]) == gen, bar);
            __builtin_amdgcn_fence(__ATOMIC_ACQUIRE, "agent");
            asm volatile("s_waitcnt vmcnt(0)" ::: "memory");
        }
    }
    __syncthreads();
}

__device__ __forceinline__ void soft_arrive(unsigned* cnt, unsigned v) {
    asm volatile("s_waitcnt vmcnt(0)" ::: "memory"); __syncthreads();
    if (threadIdx.x == 0) (void)__hip_atomic_fetch_add(cnt, v, __ATOMIC_RELAXED, __HIP_MEMORY_SCOPE_AGENT);
}
__device__ __forceinline__ void soft_wait(unsigned* cnt, unsigned need) {
    if (threadIdx.x == 0) {
        unsigned sp = 0;
        while (__hip_atomic_load(cnt, __ATOMIC_RELAXED, __HIP_MEMORY_SCOPE_AGENT) < need) { __builtin_amdgcn_s_sleep(2); if (++sp > (1u << 22)) break; }
        __builtin_amdgcn_fence(__ATOMIC_ACQUIRE, "agent");
        asm volatile("s_waitcnt vmcnt(0)" ::: "memory");
    }
    __syncthreads();
}
__device__ __forceinline__ void st_sc1(float* p, float v) { __hip_atomic_store((unsigned*)p, __float_as_uint(v), __ATOMIC_RELAXED, __HIP_MEMORY_SCOPE_AGENT); }
struct Args {
    const float* in[26];
    float* out; unsigned char* ws;
    int ph_lo, ph_hi;
};
enum { I_XP = 0, I_XS, I_CK, I_CV, I_SC, I_SH, I_CP, I_CS, I_REL, I_NG, I_WADA, I_BADA, I_WIN, I_QG, I_KG, I_SINK, I_WCONV, I_BCONV,
       I_WRA, I_BRA, I_WRX, I_BRX, I_LAM, I_WPA, I_WPR, I_WOUT };

struct Frame {
    LAS unsigned char* lds;
    int tid, lane, wave, G, vcu;
    const float* const* in;
    float* out; unsigned char* ws;
};

__device__ __forceinline__ void refresh(Frame& F) {
    int t = threadIdx.x; asm volatile("" : "+v"(t));
    F.tid = t; F.lane = t & 63; F.wave = __builtin_amdgcn_readfirstlane(t >> 6);
}
__device__ __forceinline__ int rel_bucket(int n) { const int big = 16 + (int)(__builtin_amdgcn_logf((float)n * 0.0625f) * (16.0f / 3.0f)); return n < 16 ? n : (big < 31 ? big : 31); }
__device__ const unsigned char BUCKET[128] = {0, 1, 2, 3, 4, 5, 6, 7, 8, 9, 10, 11, 12, 13, 14, 15, 16, 16, 16, 17, 17, 18, 18, 18, 19, 19, 19, 20, 20, 20, 20, 21, 21, 21, 21, 22, 22, 22, 22, 22, 23, 23, 23, 23, 23, 23, 24, 24, 24, 24, 24, 24, 25, 25, 25, 25, 25, 25, 25, 26, 26, 26, 26, 26, 26, 26, 26, 27, 27, 27, 27, 27, 27, 27, 27, 27, 27, 28, 28, 28, 28, 28, 28, 28, 28, 28, 28, 29, 29, 29, 29, 29, 29, 29, 29, 29, 29, 29, 29, 30, 30, 30, 30, 30, 30, 30, 30, 30, 30, 30, 30, 30, 30, 31, 31, 31, 31, 31, 31, 31, 31, 31, 31, 31, 31, 31, 31, 31};

__device__ __forceinline__ void transpose_block(const float* W, int N, int k0, int n0, bf16* WT, int ldk, int drow0, int kofs, LAS float* scr, int lane) {
    f32x4 wv[8];
#pragma unroll
    for (int i = 0; i < 8; ++i) wv[i] = __builtin_nontemporal_load((const f32x4*)(W + (size_t)(k0 + 8 * i + (lane >> 3)) * N + n0 + 4 * (lane & 7)));
#pragma unroll
    for (int i = 0; i < 8; ++i) { LAS float* d = scr + (8 * i + (lane >> 3)) * 33 + 4 * (lane & 7); d[0] = wv[i][0]; d[1] = wv[i][1]; d[2] = wv[i][2]; d[3] = wv[i][3]; }
    LDS_WAIT(); asm volatile("" ::: "memory");
    const int c = lane & 7;
#pragma unroll
    for (int j = 0; j < 4; ++j) { const int n = (lane >> 3) + 8 * j; const LAS float* s = scr + (8 * c) * 33 + n;
        v4u o; o.x = pk2(s[0 * 33], s[1 * 33]); o.y = pk2(s[2 * 33], s[3 * 33]); o.z = pk2(s[4 * 33], s[5 * 33]); o.w = pk2(s[6 * 33], s[7 * 33]);
        *(GAS v4u*)(WT + (size_t)(drow0 + n) * ldk + kofs + k0 + 8 * c) = o; }
    LDS_WAIT(); asm volatile("" ::: "memory");
}
__device__ __forceinline__ int win_row(int n0) {
    if (n0 < 1280) { const int t = n0 >> 8, w = n0 & 255; return (t << 8) + (((w >> 5) & 1) << 7) + ((w >> 6) << 5); }
    if (n0 < 4608) return n0;
    if (n0 < 5632) { const int i = n0 - 4608; return 4608 + ((i >> 7) << 8) + (i & 127); }
    { const int i = n0 - 5632; return 4608 + ((i >> 7) << 8) + 128 + (i & 127); }
}
__device__ __forceinline__ void p0_weights(Frame& F) {
    LAS float* scr = (LAS float*)(F.lds + F.wave * 16384);
    const int gw = F.vcu * NWAVES + F.wave, NGW = F.G * NWAVES;
    bf16* WIN_T = (bf16*)(F.ws + WS_WIN);
    for (int it = gw; it < 16 * 208; it += NGW) { const int kb = it / 208, nb = it % 208; transpose_block(F.in[I_WIN], INW, 64 * kb, 32 * nb, WIN_T, DM, win_row(32 * nb), 0, scr, F.lane); }
}
constexpr int TQ_TR = 200, TQ_ALL = 708;
__device__ __forceinline__ void tail_item(Frame& F, int it) {
    if (it < TQ_TR) {
        LAS float* scr = (LAS float*)(F.lds + F.wave * 16384);
        int r = 8 * it + F.wave;
        bf16* WPP = (bf16*)(F.ws + WS_WPP); bf16* WOUT_T = (bf16*)(F.ws + WS_WOUT);
        if (r < 512) { const int kb = r / 32, nb = r % 32; transpose_block(F.in[I_WPA], DM, 64 * kb, 32 * nb, WPP, 2048, 32 * nb, 0, scr, F.lane); return; } r -= 512;
        if (r < 512) { const int kb = r / 32, nb = r % 32; transpose_block(F.in[I_WPR], DM, 64 * kb, 32 * nb, WPP, 2048, 32 * nb, 1024, scr, F.lane); return; } r -= 512;
        if (r < 512) { const int kb = r / 32, nb = r % 32; transpose_block(F.in[I_WOUT], DM, 64 * kb, 32 * nb, WOUT_T, DM, 32 * nb, 0, scr, F.lane); return; } r -= 512;
        if (r < 32) { const int blk = r >> 1, nb = r & 1; transpose_block(F.in[I_WRA] + blk * 4096, 64, 0, 32 * nb, (bf16*)(F.ws + WS_WRA) + blk * 4096, 64, 32 * nb, 0, scr, F.lane); return; } r -= 32;
        { const int blk = r >> 1, nb = r & 1; transpose_block(F.in[I_WRX] + blk * 4096, 64, 0, 32 * nb, (bf16*)(F.ws + WS_WRX) + blk * 4096, 64, 32 * nb, 0, scr, F.lane); }
        return;
    }
    const int rbase = (it - TQ_TR) * 64 + 8 * F.wave;
    f32x4 v[8]; size_t dsto[8];
#pragma unroll
    for (int i = 0; i < 8; ++i) {
        const int rr = rbase + i, which = rr / 16256, r2 = rr % 16256, bs = r2 / 127, jj = r2 % 127;
        v[i] = __builtin_nontemporal_load((const f32x4*)F.in[which ? I_CV : I_CK] + ((size_t)bs * 128 + jj + 1) * 64 + F.lane);
        dsto[i] = (which ? O_VWS : O_KWS) / 4 + ((size_t)bs * 128 + jj) * 64 + F.lane;
    }
#pragma unroll
    for (int i = 0; i < 8; ++i) __builtin_nontemporal_store(v[i], (f32x4*)F.out + dsto[i]);
}

__device__ __forceinline__ void p0_mod_tile(Frame& F, int nt) {
    const float* wada = F.in[I_WADA]; const int lane = F.lane, w = F.wave;
    const int n0 = 16 * nt, kbase = 128 * w;
    f32x4 acc[9];
#pragma unroll
    for (int m = 0; m < 9; ++m) acc[m] = (f32x4){0.f, 0.f, 0.f, 0.f};
    float bvv[4][8];
#pragma unroll
    for (int ks = 0; ks < 4; ++ks)
#pragma unroll
        for (int j = 0; j < 8; ++j) bvv[ks][j] = __builtin_nontemporal_load(wada + (size_t)(kbase + 32 * ks + 8 * (lane >> 4) + j) * 3072 + n0 + (lane & 15));
#pragma unroll
    for (int ks = 0; ks < 4; ++ks) {
        const int k0 = kbase + 32 * ks + 8 * (lane >> 4);
        f32x4 a0[9], a1[9];
#pragma unroll
        for (int m = 0; m < 9; ++m) {
            const int row = 16 * m + (lane & 15);
            const int rr = row < 132 ? row : 131;
            const float* cr = (rr < 4 ? F.in[I_CP] + rr * 1024 : F.in[I_CS] + (rr - 4) * 1024) + k0;
            a0[m] = *(const f32x4*)cr; a1[m] = *(const f32x4*)(cr + 4);
        }
        v4u bw; bw.x = pk2(bvv[ks][0], bvv[ks][1]); bw.y = pk2(bvv[ks][2], bvv[ks][3]); bw.z = pk2(bvv[ks][4], bvv[ks][5]); bw.w = pk2(bvv[ks][6], bvv[ks][7]);
        const bf16x8 bfr = __builtin_bit_cast(bf16x8, bw);
#pragma unroll
        for (int m = 0; m < 9; ++m) {
            const int row = 16 * m + (lane & 15);
            v4u aw; aw.x = pk2(a0[m].x, a0[m].y); aw.y = pk2(a0[m].z, a0[m].w); aw.z = pk2(a1[m].x, a1[m].y); aw.w = pk2(a1[m].z, a1[m].w);
            if (row >= 132) aw = (v4u){0u, 0u, 0u, 0u};
            acc[m] = __builtin_amdgcn_mfma_f32_16x16x32_bf16(__builtin_bit_cast(bf16x8, aw), bfr, acc[m], 0, 0, 0);
        }
    }
    LAS float* part = (LAS float*)F.lds;
#pragma unroll
    for (int m = 0; m < 9; ++m)
#pragma unroll
        for (int r = 0; r < 4; ++r) part[(w * 144 + 16 * m + 4 * (lane >> 4) + r) * 16 + (lane & 15)] = acc[m][r];
    __syncthreads();
    float* mod = (float*)(F.ws + WS_MOD);
    for (int e = F.tid; e < 132 * 4; e += NWAVES * 64) {
        const int row = e >> 2, c4 = (e & 3) * 4; f32x4 s = *(const f32x4*)(F.in[I_BADA] + n0 + c4);
#pragma unroll
        for (int ww = 0; ww < 8; ++ww) s += *(const LAS f32x4*)(part + (ww * 144 + row) * 16 + c4);
        const v4u sv = __builtin_bit_cast(v4u, s);
        unsigned long long* dst = (unsigned long long*)(mod + (size_t)row * 3072 + n0 + c4);
        __hip_atomic_store(dst, (unsigned long long)sv.x | ((unsigned long long)sv.y << 32), __ATOMIC_RELAXED, __HIP_MEMORY_SCOPE_AGENT);
        __hip_atomic_store(dst + 1, (unsigned long long)sv.z | ((unsigned long long)sv.w << 32), __ATOMIC_RELAXED, __HIP_MEMORY_SCOPE_AGENT);
    }
    __syncthreads();
}
__device__ __forceinline__ float wave_sum(float v) {
#pragma unroll
    for (int o = 1; o < 64; o <<= 1) v += __shfl_xor(v, o);
    return v;
}
__device__ __forceinline__ const float* xn_src_row(Frame& F, int m) { return m < MP ? F.in[I_XP] + (size_t)m * DM : F.in[I_XS] + (size_t)(m - MP) * DM; }
__device__ __forceinline__ void p1_xn(Frame& F) {
    const int RPB = (MPAD + F.G - 1) / F.G, rbeg = F.vcu * RPB, rend = (rbeg + RPB < MPAD) ? rbeg + RPB : MPAD;
    const float* mod = (const float*)(F.ws + WS_MOD); bf16* XN = (bf16*)(F.ws + WS_XN);
    const f32x4* gp = (const f32x4*)F.in[I_NG] + F.lane;
    f32x4 gvec[4];
#pragma unroll
    for (int j = 0; j < 4; ++j) gvec[j] = gp[64 * j];
    f32x4 nx[4];
    if (rbeg + F.wave < MALL && rbeg + F.wave < rend) { const f32x4* xr = (const f32x4*)xn_src_row(F, rbeg + F.wave) + F.lane;
#pragma unroll
        for (int j = 0; j < 4; ++j) nx[j] = __builtin_nontemporal_load(xr + 64 * j); }
    int mr_c = -1; f32x4 scv[4], shv[4];
#pragma unroll
    for (int j = 0; j < 4; ++j) { scv[j] = (f32x4){0.f, 0.f, 0.f, 0.f}; shv[j] = scv[j]; }
    for (int m = rbeg + F.wave; m < rend; m += NWAVES) {
        GAS unsigned long long* o8 = (GAS unsigned long long*)(XN + (size_t)m * DM) + F.lane;
        if (m >= MALL) {
#pragma unroll
            for (int j = 0; j < 4; ++j) o8[64 * j] = 0ull;
            continue;
        }
        f32x4 v[4];
#pragma unroll
        for (int j = 0; j < 4; ++j) v[j] = nx[j];
        const int mn = m + NWAVES;
        if (mn < MALL && mn < rend) { const f32x4* xr = (const f32x4*)xn_src_row(F, mn) + F.lane;
#pragma unroll
            for (int j = 0; j < 4; ++j) nx[j] = __builtin_nontemporal_load(xr + 64 * j); }
        const int mr = m < MP ? (m >> 12) : 4 + (m - MP);
        if (mr != mr_c) {
            const f32x4* sh = (const f32x4*)(mod + (size_t)mr * 3072) + F.lane; const f32x4* sc = sh + 256;
#pragma unroll
            for (int j = 0; j < 4; ++j) { scv[j] = sc[64 * j] + 1.0f; shv[j] = sh[64 * j]; }
            mr_c = mr;
        }
        float s = 0.f;
#pragma unroll
        for (int j = 0; j < 4; ++j) s += (v[j].x * v[j].x + v[j].y * v[j].y) + (v[j].z * v[j].z + v[j].w * v[j].w);
        const float rstd = 1.0f / sqrtf(wave_sum(s) * (1.f / DM) + EPSN);
        unsigned long long ov[4];
#pragma unroll
        for (int j = 0; j < 4; ++j) {
            const f32x4 y = v[j] * rstd * gvec[j] * scv[j] + shv[j];
            ov[j] = (unsigned long long)pk2(y.x, y.y) | ((unsigned long long)pk2(y.z, y.w) << 32);
        }
#pragma unroll
        for (int j = 0; j < 4; ++j) o8[64 * j] = ov[j];
    }
}

struct EpiZ {
    static constexpr bool PERM = true, HAS_MID = false;
    unsigned char* ws; float* out; const float* qg; const float* kg;
    __device__ __forceinline__ void mid(pg8::f32x4 (&)[2][2][4][2], const pg8::Unit&, int, int, int, int) const {}
    __device__ __forceinline__ void operator()(const pg8::f32x4 (&acc)[2][2][4][2], const pg8::Unit& u, int wr, int wc, int fr, int fq) const {
        asm volatile("" : "+v"(fr), "+v"(fq));
        const int pn = u.pn, pm = u.pm;
        const int rloc = wr * 64 + fr;
        const size_t row0 = (size_t)pm * 256 + rloc;
        if (pn < 5) {
            const bool isq = pn < 4;
            const float* gsrc = (isq ? qg : kg) + 8 * fq;
            f32x4 gv[2][2];
#pragma unroll
            for (int bj = 0; bj < 2; ++bj)
#pragma unroll
                for (int n = 0; n < 2; ++n) gv[bj][n] = *(const f32x4*)(gsrc + 32 * bj + 4 * n);
            const float sc = isq ? QSCALE : 1.0f;
            bf16* dst; int ld, colb;
            if (isq) { dst = (pm < 64) ? (bf16*)(out + O_YP) + QM_OFF + row0 * DM : (bf16*)(ws + WS_QT) + (size_t)rloc * DM; ld = DM; colb = (4 * pn + wc) * 64 + 8 * fq; }
            else { dst = (bf16*)(ws + WS_K) + row0 * 256; ld = 256; colb = wc * 64 + 8 * fq; }
#pragma unroll
            for (int ai = 0; ai < 2; ++ai)
#pragma unroll
                for (int m = 0; m < 4; ++m) {
                    float ss = 0.f;
#pragma unroll
                    for (int bj = 0; bj < 2; ++bj)
#pragma unroll
                        for (int n = 0; n < 2; ++n) { const f32x4 x = acc[ai][bj][m][n]; ss += (x[0] * x[0] + x[1] * x[1]) + (x[2] * x[2] + x[3] * x[3]); }
                    ss += __shfl_xor(ss, 16); ss += __shfl_xor(ss, 32);
                    const float rs = sc / sqrtf(ss * (1.0f / 64.0f) + EPSN);
                    bf16* rp = dst + (size_t)(ai * 128 + m * 16) * ld + colb;
#pragma unroll
                    for (int bj = 0; bj < 2; ++bj) {
                        const f32x4 v0 = acc[ai][bj][m][0] * rs * gv[bj][0], v1 = acc[ai][bj][m][1] * rs * gv[bj][1];
                        v4u w; w.x = pg8::cvt_pk_bf16(v0[0], v0[1]); w.y = pg8::cvt_pk_bf16(v0[2], v0[3]); w.z = pg8::cvt_pk_bf16(v1[0], v1[1]); w.w = pg8::cvt_pk_bf16(v1[2], v1[3]);
                        *(v4u*)(rp + 32 * bj) = w;
                        if (!isq) {
                            float* so = nullptr;
                            if (pm < 64 && (pm & 15) == 15 && ai == 1) so = out + O_KWP + ((size_t)(pm >> 4) * 128 + (wr * 64 + m * 16 + fr)) * 256;
                            else if (pm == 64 && ai == 0) so = (float*)(ws + WS_KVNEW) + (size_t)(wr * 64 + m * 16 + fr) * 256;
                            if (so) { so += wc * 64 + 32 * bj + 8 * fq; *(f32x4*)so = v0; *(f32x4*)(so + 4) = v1; }
                        }
                    }
                }
            return;
        }
        if (pn == 5) {
            bf16* dst = (bf16*)(ws + WS_V) + row0 * 256 + 32 * wc + 8 * fq;
#pragma unroll
            for (int ai = 0; ai < 2; ++ai)
#pragma unroll
                for (int m = 0; m < 4; ++m)
#pragma unroll
                    for (int bj = 0; bj < 2; ++bj) {
                        const f32x4 v0 = acc[ai][bj][m][0], v1 = acc[ai][bj][m][1];
                        v4u w; w.x = pg8::cvt_pk_bf16(v0[0], v0[1]); w.y = pg8::cvt_pk_bf16(v0[2], v0[3]); w.z = pg8::cvt_pk_bf16(v1[0], v1[1]); w.w = pg8::cvt_pk_bf16(v1[2], v1[3]);
                        *(v4u*)(dst + (size_t)(ai * 128 + m * 16) * 256 + 128 * bj) = w;
                        float* so = nullptr;
                        if (pm < 64 && (pm & 15) == 15 && ai == 1) so = out + O_VWP + ((size_t)(pm >> 4) * 128 + (wr * 64 + m * 16 + fr)) * 256;
                        else if (pm == 64 && ai == 0) so = (float*)(ws + WS_KVNEW) + 128 * 256 + (size_t)(wr * 64 + m * 16 + fr) * 256;
                        if (so) { so += 128 * bj + 32 * wc + 8 * fq; *(f32x4*)so = v0; *(f32x4*)(so + 4) = v1; }
                    }
            return;
        }
        if (pn < 18) {
            const int seg = (pn - 6) >> 2;
            const int colt = ((pn - 6) & 3) * 256 + 32 * wc + 8 * fq;
            bf16* dst = (bf16*)(ws + (seg == 0 ? WS_SGA : seg == 1 ? WS_XR : WS_SGR)) + row0 * DM + colt;
#pragma unroll
            for (int ai = 0; ai < 2; ++ai)
#pragma unroll
                for (int m = 0; m < 4; ++m)
#pragma unroll
                    for (int bj = 0; bj < 2; ++bj) {
                        f32x4 v0 = acc[ai][bj][m][0], v1 = acc[ai][bj][m][1];
                        if (seg != 1) {
#pragma unroll
                            for (int e = 0; e < 4; ++e) { v0[e] = v0[e] * sigm(v0[e]); v1[e] = v1[e] * sigm(v1[e]); }
                        }
                        v4u w; w.x = pg8::cvt_pk_bf16(v0[0], v0[1]); w.y = pg8::cvt_pk_bf16(v0[2], v0[3]); w.z = pg8::cvt_pk_bf16(v1[0], v1[1]); w.w = pg8::cvt_pk_bf16(v1[2], v1[3]);
                        *(v4u*)(dst + (size_t)(ai * 128 + m * 16) * DM + 128 * bj) = w;
                        if (seg == 1 && pm < 64 && (pm & 15) == 15 && ai == 1 && wr == 1 && m == 3 && fr >= 13) {
                            float* so = out + O_CVP + ((size_t)(pm >> 4) * 3 + (fr - 13)) * DM + colt + 128 * bj;
                            *(f32x4*)so = v0; *(f32x4*)(so + 4) = v1;
                        }
                    }
            return;
        }
        {
            const int colt = (pn - 18) * 128 + 32 * wc + 8 * fq;
            unsigned char* da = ws + WS_RAT + row0 * DM + colt; unsigned char* ds = ws + WS_SMR + row0 * DM + colt;
#pragma unroll
            for (int ai = 0; ai < 2; ++ai)
#pragma unroll
                for (int m = 0; m < 4; ++m) {
                    float sa[8], sm[8];
#pragma unroll
                    for (int n = 0; n < 2; ++n)
#pragma unroll
                        for (int e = 0; e < 4; ++e) { sa[4 * n + e] = sigm(acc[ai][0][m][n][e]); sm[4 * n + e] = sigm(acc[ai][1][m][n][e]); }
                    v2u w; w.x = pk_u8x4(sa[0], sa[1], sa[2], sa[3]); w.y = pk_u8x4(sa[4], sa[5], sa[6], sa[7]);
                    *(v2u*)(da + (size_t)(ai * 128 + m * 16) * DM) = w;
                    w.x = pk_u8x4(sm[0], sm[1], sm[2], sm[3]); w.y = pk_u8x4(sm[4], sm[5], sm[6], sm[7]);
                    *(v2u*)(ds + (size_t)(ai * 128 + m * 16) * DM) = w;
                }
        }
    }
};

struct EpiMerge {
    static constexpr bool PERM = true, HAS_MID = true;
    const unsigned char* sma; const unsigned char* smr; bf16* mg;
    __device__ __forceinline__ void mid(pg8::f32x4 (&acc)[2][2][4][2], const pg8::Unit& u, int wr, int wc, int fr, int fq) const {
        asm volatile("" : "+v"(fr), "+v"(fq));
        const size_t off = ((size_t)u.pm * 256 + wr * 64 + fr) * DM + u.pn * 256 + 32 * wc + 8 * fq;
        v2u ga[16], gr[16];
#pragma unroll
        for (int ai = 0; ai < 2; ++ai)
#pragma unroll
            for (int m = 0; m < 4; ++m)
#pragma unroll
                for (int bj = 0; bj < 2; ++bj) {
                    const size_t o = off + (size_t)(ai * 128 + m * 16) * DM + 128 * bj;
                    ga[(ai * 4 + m) * 2 + bj] = *(const v2u*)(sma + o); gr[(ai * 4 + m) * 2 + bj] = *(const v2u*)(smr + o);
                }
        __builtin_amdgcn_sched_barrier(0);
#pragma unroll
        for (int ai = 0; ai < 2; ++ai)
#pragma unroll
            for (int m = 0; m < 4; ++m)
#pragma unroll
                for (int bj = 0; bj < 2; ++bj) {
                    const v2u a = ga[(ai * 4 + m) * 2 + bj], r = gr[(ai * 4 + m) * 2 + bj];
                    acc[ai][bj][m][0] *= (pg8::f32x4){u8f(a.x, 0) * frcp(u8f(r.x, 0)), u8f(a.x, 1) * frcp(u8f(r.x, 1)), u8f(a.x, 2) * frcp(u8f(r.x, 2)), u8f(a.x, 3) * frcp(u8f(r.x, 3))};
                    acc[ai][bj][m][1] *= (pg8::f32x4){u8f(a.y, 0) * frcp(u8f(r.y, 0)), u8f(a.y, 1) * frcp(u8f(r.y, 1)), u8f(a.y, 2) * frcp(u8f(r.y, 2)), u8f(a.y, 3) * frcp(u8f(r.y, 3))};
                }
    }
    __device__ __forceinline__ void operator()(const pg8::f32x4 (&acc)[2][2][4][2], const pg8::Unit& u, int wr, int wc, int fr, int fq) const {
        asm volatile("" : "+v"(fr), "+v"(fq));
        const size_t off = ((size_t)u.pm * 256 + wr * 64 + fr) * DM + u.pn * 256 + 32 * wc + 8 * fq;
        const float i255 = 1.0f / 255.0f;
        v2u gr[16];
#pragma unroll
        for (int ai = 0; ai < 2; ++ai)
#pragma unroll
            for (int m = 0; m < 4; ++m)
#pragma unroll
                for (int bj = 0; bj < 2; ++bj) gr[(ai * 4 + m) * 2 + bj] = *(const v2u*)(smr + off + (size_t)(ai * 128 + m * 16) * DM + 128 * bj);
        __builtin_amdgcn_sched_barrier(0);
#pragma unroll
        for (int ai = 0; ai < 2; ++ai)
#pragma unroll
            for (int m = 0; m < 4; ++m)
#pragma unroll
                for (int bj = 0; bj < 2; ++bj) {
                    const size_t o = off + (size_t)(ai * 128 + m * 16) * DM + 128 * bj;
                    const v2u r = gr[(ai * 4 + m) * 2 + bj];
                    const pg8::f32x4 v0 = acc[ai][bj][m][0] * ((pg8::f32x4){u8f(r.x, 0), u8f(r.x, 1), u8f(r.x, 2), u8f(r.x, 3)} * i255);
                    const pg8::f32x4 v1 = acc[ai][bj][m][1] * ((pg8::f32x4){u8f(r.y, 0), u8f(r.y, 1), u8f(r.y, 2), u8f(r.y, 3)} * i255);
                    v4u w; w.x = pg8::cvt_pk_bf16(v0[0], v0[1]); w.y = pg8::cvt_pk_bf16(v0[2], v0[3]); w.z = pg8::cvt_pk_bf16(v1[0], v1[1]); w.w = pg8::cvt_pk_bf16(v1[2], v1[3]);
                    *(v4u*)(mg + o) = w;
                }
    }
};
struct EpiOut {
    static constexpr bool PERM = false, HAS_MID = false;
    const float* x; const float* mod; float* y;
    __device__ __forceinline__ void mid(pg8::f32x4 (&)[2][2][4][2], const pg8::Unit&, int, int, int, int) const {}
    __device__ __forceinline__ void operator()(const pg8::f32x4 (&acc)[2][2][4][2], const pg8::Unit& u, int wr, int wc, int fr, int fq) const {
        asm volatile("" : "+v"(fr), "+v"(fq));
        const int col0 = u.pn * 256 + wc * 32 + 4 * fq;
        const float* gp = mod + (size_t)(u.pm >> 4) * 3072 + 2048 + col0;
        f32x4 gv[2][2];
#pragma unroll
        for (int bj = 0; bj < 2; ++bj)
#pragma unroll
            for (int n = 0; n < 2; ++n) gv[bj][n] = *(const f32x4*)(gp + 128 * bj + 16 * n);
#pragma unroll
        for (int ai = 0; ai < 2; ++ai) {
            f32x4 xv[4][2][2];
#pragma unroll
            for (int m = 0; m < 4; ++m) {
                const size_t off = ((size_t)u.pm * 256 + ai * 128 + wr * 64 + m * 16 + fr) * DM + col0;
#pragma unroll
                for (int bj = 0; bj < 2; ++bj)
#pragma unroll
                    for (int n = 0; n < 2; ++n) xv[m][bj][n] = __builtin_nontemporal_load((const f32x4*)(x + off + 128 * bj + 16 * n));
            }
            __builtin_amdgcn_sched_barrier(0);
#pragma unroll
            for (int m = 0; m < 4; ++m) {
                const size_t off = ((size_t)u.pm * 256 + ai * 128 + wr * 64 + m * 16 + fr) * DM + col0;
#pragma unroll
                for (int bj = 0; bj < 2; ++bj)
#pragma unroll
                    for (int n = 0; n < 2; ++n) __builtin_nontemporal_store(xv[m][bj][n] + gv[bj][n] * acc[ai][bj][m][n], (f32x4*)(y + off + 128 * bj + 16 * n));
            }
            __builtin_amdgcn_sched_barrier(0);
        }
    }
};

template <int KQ  >
__device__ __forceinline__ f32x4 mini_partial(const bf16* A, const bf16* B) {
    bf16x8 a[KQ], b[KQ];
#pragma unroll
    for (int ks = 0; ks < KQ; ++ks) { a[ks] = *(const bf16x8*)(A + 32 * ks); b[ks] = *(const bf16x8*)(B + 32 * ks); }
    f32x4 acc = (f32x4){0.f, 0.f, 0.f, 0.f};
#pragma unroll
    for (int ks = 0; ks < KQ; ++ks) acc = __builtin_amdgcn_mfma_f32_16x16x32_bf16(a[ks], b[ks], acc, 0, 0, 0);
    return acc;
}
__device__ __forceinline__ void mini_merge_block(Frame& F, int pair) {
    const int lane = F.lane, w = F.wave, tile = 2 * pair + (w >> 2), kq = w & 3, rt = tile >> 6, ct = tile & 63;
    const bf16* A = (const bf16*)(F.ws + WS_YT) + (size_t)(16 * rt + (lane & 15)) * 2048 + 8 * (lane >> 4) + 512 * kq;
    const bf16* B = (const bf16*)(F.ws + WS_WPP) + (size_t)(16 * ct + (lane & 15)) * 2048 + 8 * (lane >> 4) + 512 * kq;
    const f32x4 acc = mini_partial<16>(A, B);
    LAS float* part = (LAS float*)F.lds;
#pragma unroll
    for (int r = 0; r < 4; ++r) part[w * 256 + (4 * (lane >> 4) + r) * 16 + (lane & 15)] = acc[r];
    __syncthreads();
    {
        const int t2 = F.tid >> 8, e = F.tid & 255, row = e >> 4, col = e & 15, tl = 2 * pair + t2, rl = 16 * (tl >> 6) + row, cg = 16 * (tl & 63) + col;
        const LAS float* p = part + t2 * 1024 + e;
        const float sa_ = (float)(F.ws + WS_RAT)[(size_t)(MP + rl) * DM + cg], sr_ = (float)(F.ws + WS_SMR)[(size_t)(MP + rl) * DM + cg];
        const float rat = sa_ / sr_, sm = sr_ * (1.0f / 255.0f);
        const float v = ((p[0] + p[256]) * rat + (p[512] + p[768])) * sm;
        ((bf16*)(F.ws + WS_MGT))[(size_t)rl * DM + cg] = (bf16)f2bf(v);
    }
    __syncthreads();
}
__device__ __forceinline__ void mini_out_block(Frame& F, int pair) {
    const int lane = F.lane, w = F.wave, tile = 2 * pair + (w >> 2), kq = w & 3, rt = tile >> 6, ct = tile & 63;
    const bf16* A = (const bf16*)(F.ws + WS_MGT) + (size_t)(16 * rt + (lane & 15)) * DM + 8 * (lane >> 4) + 256 * kq;
    const bf16* B = (const bf16*)(F.ws + WS_WOUT) + (size_t)(16 * ct + (lane & 15)) * DM + 8 * (lane >> 4) + 256 * kq;
    const f32x4 acc = mini_partial<8>(A, B);
    LAS float* part = (LAS float*)F.lds;
#pragma unroll
    for (int r = 0; r < 4; ++r) part[w * 256 + (4 * (lane >> 4) + r) * 16 + (lane & 15)] = acc[r];
    __syncthreads();
    {
        const int t2 = F.tid >> 8, e = F.tid & 255, row = e >> 4, col = e & 15, tl = 2 * pair + t2, rl = 16 * (tl >> 6) + row, cg = 16 * (tl & 63) + col;
        const LAS float* p = part + t2 * 1024 + e;
        const float* mod = (const float*)(F.ws + WS_MOD);
        F.out[O_YS + (size_t)rl * DM + cg] = F.in[I_XS][(size_t)rl * DM + cg] + mod[(size_t)(4 + rl) * 3072 + 2048 + cg] * ((p[0] + p[256]) + (p[512] + p[768]));
    }
    __syncthreads();
}

struct ChanConst { float w0, w1, w2, w3, bc, bra, brx, c1, nbra, nbrx; };
__device__ __forceinline__ ChanConst chan_const(Frame& F, int ch) {
    ChanConst c; const float* wc = F.in[I_WCONV];
    c.w0 = wc[ch]; c.w1 = wc[DM + ch]; c.w2 = wc[2 * DM + ch]; c.w3 = wc[3 * DM + ch]; c.bc = F.in[I_BCONV][ch];
    c.bra = F.in[I_BRA][ch]; c.brx = F.in[I_BRX][ch];
    c.c1 = -8.0f * log1pf(expf(-F.in[I_LAM][ch])) * LOG2E;
    c.nbra = -LOG2E * c.bra; c.nbrx = -LOG2E * c.brx;
    return c;
}
__device__ __forceinline__ void sample_rnn_unit(Frame& F, int bs, int j);
__device__ __forceinline__ void stage_gate_weights(Frame& F, int j) {
    for (int cidx = F.tid; cidx < 1024; cidx += NWAVES * 64) {
        const int gsel = cidx >> 9, row = (cidx >> 3) & 63, c8 = cidx & 7;
        const v4u v = *(const v4u*)((const bf16*)(F.ws + (gsel ? WS_WRX : WS_WRA)) + j * 4096 + row * 64 + 8 * c8);
        *(LAS v4u*)(F.lds + GW_OFF + (gsel * 64 + row) * GW_STRIDE + 16 * c8) = v;
    }
}
template <int PASS>
__device__ __forceinline__ void scan_unit(Frame& F, int b, int c, int j, LAS unsigned char* wl) {
    const int lane = F.lane, r32 = lane & 31, hi = lane >> 5, ch = 64 * j + lane;
    const ChanConst cc = chan_const(F, ch);
    const bf16* XR = (const bf16*)(F.ws + WS_XR); const bf16* SGR = (const bf16*)(F.ws + WS_SGR);
    float* agg = (float*)(F.ws + WS_AGG);
    bf16* YM = (bf16*)(F.out + O_YP);
    LAS bf16* xt = (LAS bf16*)wl; LAS bf16* st = (LAS bf16*)(wl + 4096); LAS float* gt = (LAS float*)(wl + 8192);
    const size_t rowb = (size_t)b * SEQ + 128 * c;
    const int lrow = lane >> 3, lc8 = lane & 7;
    const bf16* xsrc = XR + (rowb + lrow) * DM + 64 * j + 8 * lc8;
    const bf16* ssrc = SGR + (rowb + lrow) * DM + 64 * j + 8 * lc8;
    v4u xn[4], sn[4];
#pragma unroll
    for (int i = 0; i < 4; ++i) { xn[i] = *(const v4u*)(xsrc + (size_t)(8 * i) * DM); if (PASS == 2) sn[i] = *(const v4u*)(ssrc + (size_t)(8 * i) * DM); }
    float xm3 = 0.f, xm2 = 0.f, xm1 = 0.f;
    if (c > 0) { xm3 = bf2f(XR[(rowb - 3) * DM + ch]); xm2 = bf2f(XR[(rowb - 2) * DM + ch]); xm1 = bf2f(XR[(rowb - 1) * DM + ch]); }
    float h = 0.f, ap = 1.f;
    if (PASS == 2) {
        for (int q = 0; q < c; ++q) { const float a = agg[((size_t)(b * NCH + q) * 2 + 0) * DM + ch], hl = agg[((size_t)(b * NCH + q) * 2 + 1) * DM + ch]; h = a * h + hl; }
    }
    const LAS unsigned char* gwr = F.lds + GW_OFF + r32 * GW_STRIDE + 16 * hi;
    for (int sc = 0; sc < 4; ++sc) {
        const size_t r0 = rowb + 32 * sc;
#pragma unroll
        for (int i = 0; i < 4; ++i) { *(LAS v4u*)(xt + (lrow + 8 * i) * 64 + 8 * lc8) = xn[i]; if (PASS == 2) *(LAS v4u*)(st + (lrow + 8 * i) * 64 + 8 * lc8) = sn[i]; }
        if (sc < 3) {
#pragma unroll
            for (int i = 0; i < 4; ++i) { xn[i] = *(const v4u*)(xsrc + (size_t)(32 * (sc + 1) + 8 * i) * DM); if (PASS == 2) sn[i] = *(const v4u*)(ssrc + (size_t)(32 * (sc + 1) + 8 * i) * DM); }
        }
        LDS_WAIT(); asm volatile("" ::: "memory");
        float xc[32];
#pragma unroll
        for (int t = 0; t < 32; ++t) {
            const float x = bf2f(xt[t * 64 + lane]);
            xc[t] = cc.bc + cc.w0 * xm3 + cc.w1 * xm2 + cc.w2 * xm1 + cc.w3 * x;
            xm3 = xm2; xm2 = xm1; xm1 = x;
            xt[t * 64 + lane] = (bf16)pg8::cvt_pk_bf16(xc[t], 0.f);
        }
        LDS_WAIT(); asm volatile("" ::: "memory");
        bf16x8 af[4];
#pragma unroll
        for (int d0 = 0; d0 < 4; ++d0) af[d0] = *(const LAS bf16x8*)(xt + r32 * 64 + 16 * d0 + 8 * hi);
        float zr[32];
#pragma unroll
        for (int oh = 0; oh < 2; ++oh) {
            f32x16 d = {};
#pragma unroll
            for (int d0 = 0; d0 < 4; ++d0) d = __builtin_amdgcn_mfma_f32_32x32x16_bf16(af[d0], *(const LAS bf16x8*)(gwr + (32 * oh) * GW_STRIDE + 32 * d0), d, 0, 0, 0);
#pragma unroll
            for (int r = 0; r < 16; ++r) gt[((r & 3) + 8 * (r >> 2) + 4 * hi) * 64 + 32 * oh + r32] = d[r];
        }
        LDS_WAIT(); asm volatile("" ::: "memory");
#pragma unroll
        for (int t = 0; t < 32; ++t) zr[t] = gt[t * 64 + lane];
        LDS_WAIT(); asm volatile("" ::: "memory");
#pragma unroll
        for (int oh = 0; oh < 2; ++oh) {
            f32x16 d = {};
#pragma unroll
            for (int d0 = 0; d0 < 4; ++d0) d = __builtin_amdgcn_mfma_f32_32x32x16_bf16(af[d0], *(const LAS bf16x8*)(gwr + (64 + 32 * oh) * GW_STRIDE + 32 * d0), d, 0, 0, 0);
#pragma unroll
            for (int r = 0; r < 16; ++r) gt[((r & 3) + 8 * (r >> 2) + 4 * hi) * 64 + 32 * oh + r32] = d[r];
        }
        LDS_WAIT(); asm volatile("" ::: "memory");
#pragma unroll
        for (int t = 0; t < 32; ++t) {
            const float zi = gt[t * 64 + lane];
            const float rg = frcp(1.0f + fexp2(__builtin_fmaf(zr[t], -LOG2E, cc.nbra))), ig = frcp(1.0f + fexp2(__builtin_fmaf(zi, -LOG2E, cc.nbrx)));
            const float a = fexp2(cc.c1 * rg);
            const float s = __builtin_amdgcn_sqrtf(__builtin_fmaf(-a, a, 1.0f));
            const float uu = s * ig * xc[t];
            h = a * h + uu;
            if (PASS == 1) ap *= a;
            if (PASS == 2) st[t * 64 + lane] = (bf16)pg8::cvt_pk_bf16(h * bf2f(st[t * 64 + lane]), 0.f);
        }
        LDS_WAIT(); asm volatile("" ::: "memory");
        if (PASS == 2) {
#pragma unroll
            for (int i = 0; i < 4; ++i) *(v4u*)(YM + (r0 + lrow + 8 * i) * DM + 64 * j + 8 * lc8) = *(const LAS v4u*)(st + (lrow + 8 * i) * 64 + 8 * lc8);
            LDS_WAIT(); asm volatile("" ::: "memory");
        }
    }
    if (PASS == 1) { st_sc1(&agg[((size_t)(b * NCH + c) * 2 + 0) * DM + ch], ap); st_sc1(&agg[((size_t)(b * NCH + c) * 2 + 1) * DM + ch], h); }
    if (PASS == 2 && c == NCH - 1) F.out[O_HP + (size_t)b * DM + ch] = h;
}
typedef GAS unsigned long long gu64;
__device__ __forceinline__ void gr_store(unsigned long long* g, float v) { __hip_atomic_store(g, (1ull << 32) | (unsigned long long)__float_as_uint(v), __ATOMIC_RELAXED, __HIP_MEMORY_SCOPE_AGENT); }
__device__ __forceinline__ unsigned long long gr_load(unsigned long long* g) { return __hip_atomic_load(g, __ATOMIC_RELAXED, __HIP_MEMORY_SCOPE_AGENT); }
__device__ __forceinline__ void scan_lb_block(Frame& F, int bu) {
    const int j = bu & 15, ib = (bu >> 4) & 3, b = bu >> 6, w = F.wave, q = 8 * ib + w;
    stage_gate_weights(F, j);
    LDS_WAIT(); __syncthreads();
    sample_rnn_unit(F, (bu >> 4) * 8 + w, j);
    const int lane = F.lane, r32 = lane & 31, hi = lane >> 5, ch = 64 * j + lane;
    LAS unsigned char* wl = F.lds + w * 16384;
    const ChanConst cc = chan_const(F, ch);
    const bf16* XR = (const bf16*)(F.ws + WS_XR); const bf16* SGR = (const bf16*)(F.ws + WS_SGR);
    bf16* YM = (bf16*)(F.out + O_YP);
    LAS bf16* xt = (LAS bf16*)wl; LAS bf16* st = (LAS bf16*)(wl + 4096); LAS float* gt = (LAS float*)(wl + 8192);
    LAS float* xch = (LAS float*)(F.lds + BT_OFF);
    unsigned long long* lba = (unsigned long long*)(F.ws + WS_LBA) + ((size_t)(b * 16 + j) * 16) * 128 + lane;
    unsigned long long* lbh = (unsigned long long*)(F.ws + WS_LBH) + ((size_t)(b * 16 + j) * 4) * 64 + lane;
    const int lrow = lane >> 3, lc8 = lane & 7;
    const size_t row0 = (size_t)b * SEQ + 32 * q;
    const bf16* xsrc = XR + (row0 + lrow) * DM + 64 * j + 8 * lc8;
    const bf16* ssrc = SGR + (row0 + lrow) * DM + 64 * j + 8 * lc8;
    v4u xn[4], sn[4];
#pragma unroll
    for (int i = 0; i < 4; ++i) { xn[i] = *(const v4u*)(xsrc + (size_t)(8 * i) * DM); sn[i] = *(const v4u*)(ssrc + (size_t)(8 * i) * DM); }
    float hx3 = 0.f, hx2 = 0.f, hx1 = 0.f;
    if (q > 0) { hx3 = bf2f(XR[(row0 - 3) * DM + ch]); hx2 = bf2f(XR[(row0 - 2) * DM + ch]); hx1 = bf2f(XR[(row0 - 1) * DM + ch]); }
    const LAS unsigned char* gwr = F.lds + GW_OFF + r32 * GW_STRIDE + 16 * hi;
    for (int r = 0; r < 4; ++r) {
        const size_t r0 = row0 + 1024 * r;
#pragma unroll
        for (int i = 0; i < 4; ++i) { *(LAS v4u*)(xt + (lrow + 8 * i) * 64 + 8 * lc8) = xn[i]; *(LAS v4u*)(st + (lrow + 8 * i) * 64 + 8 * lc8) = sn[i]; }
        float xm3 = hx3, xm2 = hx2, xm1 = hx1;
        if (r < 3) {
#pragma unroll
            for (int i = 0; i < 4; ++i) { xn[i] = *(const v4u*)(xsrc + (size_t)(1024 * (r + 1) + 8 * i) * DM); sn[i] = *(const v4u*)(ssrc + (size_t)(1024 * (r + 1) + 8 * i) * DM); }
            hx3 = bf2f(XR[(r0 + 1024 - 3) * DM + ch]); hx2 = bf2f(XR[(r0 + 1024 - 2) * DM + ch]); hx1 = bf2f(XR[(r0 + 1024 - 1) * DM + ch]);
        }
        LDS_WAIT(); asm volatile("" ::: "memory");
        float xc[32];
#pragma unroll
        for (int t = 0; t < 32; ++t) {
            const float x = bf2f(xt[t * 64 + lane]);
            xc[t] = cc.bc + cc.w0 * xm3 + cc.w1 * xm2 + cc.w2 * xm1 + cc.w3 * x;
            xm3 = xm2; xm2 = xm1; xm1 = x;
            xt[t * 64 + lane] = (bf16)pg8::cvt_pk_bf16(xc[t], 0.f);
        }
        LDS_WAIT(); asm volatile("" ::: "memory");
        bf16x8 af[4];
#pragma unroll
        for (int d0 = 0; d0 < 4; ++d0) af[d0] = *(const LAS bf16x8*)(xt + r32 * 64 + 16 * d0 + 8 * hi);
        float av[32], uv[32];
#pragma unroll
        for (int oh = 0; oh < 2; ++oh) {
            f32x16 d = {};
#pragma unroll
            for (int d0 = 0; d0 < 4; ++d0) d = __builtin_amdgcn_mfma_f32_32x32x16_bf16(af[d0], *(const LAS bf16x8*)(gwr + (32 * oh) * GW_STRIDE + 32 * d0), d, 0, 0, 0);
#pragma unroll
            for (int g4 = 0; g4 < 4; ++g4) *(LAS f32x4*)(gt + (32 * oh + r32) * 32 + (((2 * g4 + hi) ^ (((32 * oh + r32) >> 1) & 7)) << 2)) = (f32x4){d[4 * g4], d[4 * g4 + 1], d[4 * g4 + 2], d[4 * g4 + 3]};
        }
        LDS_WAIT(); asm volatile("" ::: "memory");
#pragma unroll
        for (int c = 0; c < 8; ++c) { const f32x4 v4 = *(const LAS f32x4*)(gt + lane * 32 + ((c ^ ((lane >> 1) & 7)) << 2)); av[4 * c] = v4[0]; av[4 * c + 1] = v4[1]; av[4 * c + 2] = v4[2]; av[4 * c + 3] = v4[3]; }
        LDS_WAIT(); asm volatile("" ::: "memory");
#pragma unroll
        for (int oh = 0; oh < 2; ++oh) {
            f32x16 d = {};
#pragma unroll
            for (int d0 = 0; d0 < 4; ++d0) d = __builtin_amdgcn_mfma_f32_32x32x16_bf16(af[d0], *(const LAS bf16x8*)(gwr + (64 + 32 * oh) * GW_STRIDE + 32 * d0), d, 0, 0, 0);
#pragma unroll
            for (int g4 = 0; g4 < 4; ++g4) *(LAS f32x4*)(gt + (32 * oh + r32) * 32 + (((2 * g4 + hi) ^ (((32 * oh + r32) >> 1) & 7)) << 2)) = (f32x4){d[4 * g4], d[4 * g4 + 1], d[4 * g4 + 2], d[4 * g4 + 3]};
        }
        LDS_WAIT(); asm volatile("" ::: "memory");
        float hl = 0.f, ap = 1.f;
        typedef float f2 __attribute__((ext_vector_type(2)));
#pragma unroll
        for (int c = 0; c < 8; ++c) {
            const f32x4 z4 = *(const LAS f32x4*)(gt + lane * 32 + ((c ^ ((lane >> 1) & 7)) << 2));
#pragma unroll
            for (int p = 0; p < 2; ++p) {
                const int t = 4 * c + 2 * p;
                const f2 zr2 = {av[t], av[t + 1]}, zi2 = {z4[2 * p], z4[2 * p + 1]}, xc2 = {xc[t], xc[t + 1]};
                f2 er = zr2 * (-LOG2E) + cc.nbra, ei = zi2 * (-LOG2E) + cc.nbrx;
                er = (f2){fexp2(er.x), fexp2(er.y)} + 1.0f; ei = (f2){fexp2(ei.x), fexp2(ei.y)} + 1.0f;
                const f2 rg = {frcp(er.x), frcp(er.y)}, ig = {frcp(ei.x), frcp(ei.y)};
                const f2 la = rg * cc.c1;
                const f2 a2 = {fexp2(la.x), fexp2(la.y)};
                const f2 om = 1.0f - a2 * a2;
                const f2 sq = {__builtin_amdgcn_sqrtf(om.x), __builtin_amdgcn_sqrtf(om.y)};
                const f2 u2 = sq * ig * xc2;
                av[t] = a2.x; av[t + 1] = a2.y; uv[t] = u2.x; uv[t + 1] = u2.y;
                hl = a2.x * hl + u2.x; hl = a2.y * hl + u2.y; ap *= a2.x * a2.y;
            }
        }
        LAS float* xw = xch + (r & 1) * 1024;
        xw[(w * 2 + 0) * 64 + lane] = ap; xw[(w * 2 + 1) * 64 + lane] = hl;
        LDS_WAIT(); __syncthreads();
        float pa = 1.f, ph = 0.f;
        for (int k = 0; k < w; ++k) { const float ak = xw[(k * 2 + 0) * 64 + lane], hk = xw[(k * 2 + 1) * 64 + lane]; ph = ak * ph + hk; pa = ak * pa; }
        if (w == 7 && ib < 3) { gr_store(lba + (size_t)(r * 4 + ib) * 128, ap * pa); gr_store(lba + (size_t)(r * 4 + ib) * 128 + 64, ap * ph + hl); }
        float hin = 0.f;
        {
            unsigned long long gh = (1ull << 32), ga[3] = {1ull << 32, 1ull << 32, 1ull << 32}, gb[3] = {1ull << 32, 1ull << 32, 1ull << 32};
            unsigned sp = 0;
            for (;;) {
                if (r > 0) gh = gr_load(lbh + (size_t)(r - 1) * 64);
#pragma unroll
                for (int k = 0; k < 3; ++k) if (k < ib) { ga[k] = gr_load(lba + (size_t)(r * 4 + k) * 128); gb[k] = gr_load(lba + (size_t)(r * 4 + k) * 128 + 64); }
                bool ok = (gh >> 32) == 1ull;
#pragma unroll
                for (int k = 0; k < 3; ++k) ok = ok && (ga[k] >> 32) == 1ull && (gb[k] >> 32) == 1ull;
                if (__all(ok)) break;
                __builtin_amdgcn_s_sleep(2);
                if (++sp > (1u << 20)) break;
            }
            if (r > 0) hin = __uint_as_float((unsigned)gh);
#pragma unroll
            for (int k = 0; k < 3; ++k) if (k < ib) hin = __uint_as_float((unsigned)ga[k]) * hin + __uint_as_float((unsigned)gb[k]);
            hin = pa * hin + ph;
        }
        float h = hin;
#pragma unroll
        for (int t = 0; t < 32; ++t) {
            h = av[t] * h + uv[t];
            st[t * 64 + lane] = (bf16)pg8::cvt_pk_bf16(h * bf2f(st[t * 64 + lane]), 0.f);
        }
        LDS_WAIT(); asm volatile("" ::: "memory");
#pragma unroll
        for (int i = 0; i < 4; ++i) *(v4u*)(YM + (r0 + lrow + 8 * i) * DM + 64 * j + 8 * lc8) = *(const LAS v4u*)(st + (lrow + 8 * i) * 64 + 8 * lc8);
        if (q == 31) { if (r < 3) gr_store(lbh + (size_t)r * 64, h); else F.out[O_HP + (size_t)b * DM + ch] = h; }
        LDS_WAIT(); asm volatile("" ::: "memory");
    }
    __syncthreads();
}
template <int PASS>
__device__ __forceinline__ void scan_block(Frame& F, int bu) {
    const int j = bu & 15, ub = (bu >> 4) * 8 + F.wave;
    stage_gate_weights(F, j);
    LDS_WAIT(); __syncthreads();
    if (PASS == 1) sample_rnn_unit(F, ub, j);
    scan_unit<PASS>(F, ub >> 5, ub & 31, j, F.lds + F.wave * 16384);
    __syncthreads();
}
__device__ __forceinline__ void sample_rnn_unit(Frame& F, int bs, int j) {
    const int lane = F.lane, ch = 64 * j + lane;
    const ChanConst cc = chan_const(F, ch);
    const float* scv = F.in[I_SC] + (size_t)bs * 3 * DM;
    const float x0 = scv[ch], x1 = scv[DM + ch], x2 = scv[2 * DM + ch];
    const float x3 = bf2f(((const bf16*)(F.ws + WS_XR))[(size_t)(MP + bs) * DM + ch]);
    const float h0 = F.in[I_SH][(size_t)bs * DM + ch];
    const float sg = bf2f(((const bf16*)(F.ws + WS_SGR))[(size_t)(MP + bs) * DM + ch]);
    const float xc = cc.bc + cc.w0 * x0 + cc.w1 * x1 + cc.w2 * x2 + cc.w3 * x3;
    const int xci = __float_as_int(xc);
    const LAS unsigned char* gw = F.lds + GW_OFF + lane * GW_STRIDE;
    float zr = 0.f, zi = 0.f;
#pragma unroll
    for (int k8 = 0; k8 < 8; ++k8) {
        const v4u wr4 = *(const LAS v4u*)(gw + 16 * k8), wi4 = *(const LAS v4u*)(gw + 64 * GW_STRIDE + 16 * k8);
        const unsigned wrw[4] = {wr4.x, wr4.y, wr4.z, wr4.w}, wiw[4] = {wi4.x, wi4.y, wi4.z, wi4.w};
#pragma unroll
        for (int e = 0; e < 4; ++e) {
            const float xa = __int_as_float(__builtin_amdgcn_readlane(xci, 8 * k8 + 2 * e)), xb = __int_as_float(__builtin_amdgcn_readlane(xci, 8 * k8 + 2 * e + 1));
            zr += xa * bflo(wrw[e]); zr += xb * bfhi(wrw[e]); zi += xa * bflo(wiw[e]); zi += xb * bfhi(wiw[e]);
        }
    }
    const float rg = sigm(zr + cc.bra), ig = sigm(zi + cc.brx);
    const float a = fexp2(cc.c1 * rg);
    const float sq = sqrtf(fmaxf(1.0f - a * a, 0.f));
    const float h = a * h0 + sq * ig * xc;
    F.out[O_HS + (size_t)bs * DM + ch] = h;
    float* cv = F.out + O_CVS + (size_t)bs * 3 * DM;
    cv[ch] = x1; cv[DM + ch] = x2; cv[2 * DM + ch] = x3;
    ((bf16*)(F.ws + WS_YT))[(size_t)bs * 2048 + 1024 + ch] = (bf16)f2bf(h * sg);
}

__device__ __forceinline__ float logit_bound(Frame& F) {
    float mq = fabsf(F.in[I_QG][F.lane]), mk = fabsf(F.in[I_KG][F.lane]), mb = 0.f;
#pragma unroll
    for (int i = 0; i < 8; ++i) mb = fmaxf(mb, fabsf(F.in[I_REL][F.lane + 64 * i]));
#pragma unroll
    for (int o = 1; o < 64; o <<= 1) { mq = fmaxf(mq, __shfl_xor(mq, o)); mk = fmaxf(mk, __shfl_xor(mk, o)); mb = fmaxf(mb, __shfl_xor(mb, o)); }
    return (8.0f * mq * mk + mb) * LOG2E;
}

__device__ __forceinline__ void build_bias_table(Frame& F) {
    LAS float* bt = (LAS float*)(F.lds + BT_OFF);
    float rv[4];
#pragma unroll
    for (int i = 0; i < 4; ++i) { const int e = F.tid + 512 * i; rv[i] = F.in[I_REL][rel_bucket(e & 127) * 16 + (e >> 7)]; }
#pragma unroll
    for (int i = 0; i < 4; ++i) bt[F.tid + 512 * i] = rv[i] * LOG2E;
}
__device__ __forceinline__ void sample_attn_block(Frame& F, int pair, float M0) {
    const int lane = F.lane, w = F.wave, u = 2 * pair + (w >> 2), bs = u >> 2, g = u & 3, kq = w & 3;
    const int dch = lane & 15, ksub = lane >> 4;
    const LAS float* bt = (const LAS float*)(F.lds + BT_OFF);
    LAS float* part = (LAS float*)F.lds;
    const bf16* QT = (const bf16*)(F.ws + WS_QT) + (size_t)bs * DM + g * 256;
    float q[4][4];
#pragma unroll
    for (int hh = 0; hh < 4; ++hh) { const v2u qq = *(const v2u*)(QT + hh * 64 + 4 * dch); q[hh][0] = bflo(qq.x); q[hh][1] = bfhi(qq.x); q[hh][2] = bflo(qq.y); q[hh][3] = bfhi(qq.y); }
    const float* ck = F.in[I_CK] + (((size_t)bs * 128 + 32 * kq + ksub) * 4 + g) * 64 + 4 * dch;
    const float* cv = F.in[I_CV] + (((size_t)bs * 128 + 32 * kq + ksub) * 4 + g) * 64 + 4 * dch;
    f32x4 kv[8], vv[8];
#pragma unroll
    for (int i = 0; i < 8; ++i) kv[i] = __builtin_nontemporal_load((const f32x4*)(ck + (size_t)i * 1024));
#pragma unroll
    for (int i = 0; i < 8; ++i) vv[i] = __builtin_nontemporal_load((const f32x4*)(cv + (size_t)i * 1024));
    float l[4] = {0.f, 0.f, 0.f, 0.f}; float o[4][4];
#pragma unroll
    for (int hh = 0; hh < 4; ++hh)
#pragma unroll
        for (int e = 0; e < 4; ++e) o[hh][e] = 0.f;
#pragma unroll
    for (int i = 0; i < 8; ++i) {
        const int key = 32 * kq + 4 * i + ksub;
#pragma unroll
        for (int hh = 0; hh < 4; ++hh) {
            float sdot = (kv[i][0] * q[hh][0] + kv[i][1] * q[hh][1]) + (kv[i][2] * q[hh][2] + kv[i][3] * q[hh][3]);
            sdot += __shfl_xor(sdot, 1); sdot += __shfl_xor(sdot, 2); sdot += __shfl_xor(sdot, 4); sdot += __shfl_xor(sdot, 8);
            const float ev = (key >= 1) ? fexp2(sdot + bt[(4 * g + hh) * 128 + ((128 - key) & 127)] - M0) : 0.f;
            l[hh] += ev;
#pragma unroll
            for (int e = 0; e < 4; ++e) o[hh][e] += ev * vv[i][e];
        }
    }
#pragma unroll
    for (int hh = 0; hh < 4; ++hh) {
        l[hh] += __shfl_xor(l[hh], 16); l[hh] += __shfl_xor(l[hh], 32);
#pragma unroll
        for (int e = 0; e < 4; ++e) { o[hh][e] += __shfl_xor(o[hh][e], 16); o[hh][e] += __shfl_xor(o[hh][e], 32); }
    }
    if (ksub == 0) {
#pragma unroll
        for (int hh = 0; hh < 4; ++hh) *(LAS f32x4*)(part + (w * 4 + hh) * 64 + 4 * dch) = (f32x4){o[hh][0], o[hh][1], o[hh][2], o[hh][3]};
    }
    if (lane < 4) part[8 * 256 + w * 4 + lane] = (lane == 0) ? l[0] : (lane == 1) ? l[1] : (lane == 2) ? l[2] : l[3];
    LDS_WAIT(); __syncthreads();
    if (kq == 0) {
        const float* kn = (const float*)(F.ws + WS_KVNEW) + (size_t)bs * 256 + g * 64; const float* vn = kn + 128 * 256;
        const float knew = kn[lane], vnew = vn[lane];
        const bf16* sga = (const bf16*)(F.ws + WS_SGA) + (size_t)(MP + bs) * DM + g * 256;
        bf16* yt = (bf16*)(F.ws + WS_YT) + (size_t)bs * 2048 + g * 256;
        float qh[4], sgv[4], snk[4];
#pragma unroll
        for (int hh = 0; hh < 4; ++hh) { qh[hh] = bf2f(QT[hh * 64 + lane]); sgv[hh] = bf2f(sga[hh * 64 + lane]); snk[hh] = F.in[I_SINK][4 * g + hh]; }
        float res[4];
#pragma unroll
        for (int hh = 0; hh < 4; ++hh) {
            float sn = qh[hh] * knew;
#pragma unroll
            for (int ofs = 1; ofs < 64; ofs <<= 1) sn += __shfl_xor(sn, ofs);
            const float en = fexp2(sn + bt[(4 * g + hh) * 128] - M0);
            float osum = 0.f, lsum = 0.f;
#pragma unroll
            for (int k4 = 0; k4 < 4; ++k4) { osum += part[((w + k4) * 4 + hh) * 64 + lane]; lsum += part[8 * 256 + (w + k4) * 4 + hh]; }
            const float den = lsum + en + fexp2(snk[hh] * LOG2E - M0);
            res[hh] = (osum + en * vnew) / den * sgv[hh];
        }
        F.out[O_KWS + (((size_t)bs * 128 + 127) * 4 + g) * 64 + lane] = knew; F.out[O_VWS + (((size_t)bs * 128 + 127) * 4 + g) * 64 + lane] = vnew;
#pragma unroll
        for (int hh = 0; hh < 4; ++hh) yt[hh * 64 + lane] = (bf16)f2bf(res[hh]);
    }
    LDS_WAIT(); __syncthreads();
}

constexpr int KT_STRIDE = 144;
constexpr int VT_STRIDE = 520;
constexpr int AT_K = 0, AT_V = 256 * KT_STRIDE, AT_T = AT_V + 64 * VT_STRIDE, AT_END = AT_T + 4 * 384 * 4;
static_assert(AT_END <= RING_BYTES, "attention LDS");
struct KVRegs { v4u k[4], v[4]; };
__device__ __forceinline__ void attn_load_kv(Frame& F, int b, int n, int g, KVRegs& r) {
    const bf16* Kb = (const bf16*)(F.ws + WS_K); const bf16* Vb = (const bf16*)(F.ws + WS_V);
    const long krow0 = (long)b * SEQ + 128 * (n - 1);
#pragma unroll
    for (int i = 0; i < 4; ++i) {
        const int cidx = F.tid + 512 * i; int kl = cidx >> 3; const int c8 = cidx & 7;
        if (n == 0 && kl < 128) kl += 128;
        const size_t off = (size_t)(krow0 + kl) * 256 + g * 64 + 8 * c8;
        r.k[i] = *(const v4u*)(Kb + off); r.v[i] = *(const v4u*)(Vb + off);
    }
}
__device__ __forceinline__ void attn_store_kv(Frame& F, const KVRegs& r) {
    LAS unsigned char* L = F.lds;
#pragma unroll
    for (int i = 0; i < 4; ++i) {
        const int cidx = F.tid + 512 * i, kl = cidx >> 3, c8 = cidx & 7;
        *(LAS v4u*)(L + AT_K + kl * KT_STRIDE + 16 * c8) = r.k[i];
        LAS bf16* vt = (LAS bf16*)(L + AT_V) + kl;
        const unsigned ww[4] = {r.v[i].x, r.v[i].y, r.v[i].z, r.v[i].w};
#pragma unroll
        for (int e = 0; e < 4; ++e) { vt[(8 * c8 + 2 * e) * (VT_STRIDE / 2)] = (bf16)(ww[e] & 0xffffu); vt[(8 * c8 + 2 * e + 1) * (VT_STRIDE / 2)] = (bf16)(ww[e] >> 16); }
    }
}
__device__ __forceinline__ void attn_compute(Frame& F, int b, int n, int g, float M0) {
    const int lane = F.lane, r32 = lane & 31, hi = lane >> 5, w = F.wave;
    LAS unsigned char* L = F.lds;
    const int hq = w >> 1, head = 4 * g + hq;
    const bf16* Q = (const bf16*)(F.out + O_YP) + QM_OFF;
    const bf16* SGA = (const bf16*)(F.ws + WS_SGA);
    bf16* YM = (bf16*)(F.ws + WS_XN);
    const float sinkv = fexp2(F.in[I_SINK][head] * LOG2E - M0);
    const unsigned onew = (r32 == 0 || r32 == 4) ? 0x3f803f80u : 0u;
    const bf16x8 onesf = __builtin_bit_cast(bf16x8, (v4u){onew, onew, onew, onew});
    for (int sb = 0; sb < 2; ++sb) {
        const int s = 2 * (w & 1) + sb;
        const size_t qrow = (size_t)b * SEQ + 128 * n + 32 * s + r32;
        bf16x8 qf[4];
#pragma unroll
        for (int d0 = 0; d0 < 4; ++d0) qf[d0] = *(const bf16x8*)(Q + qrow * DM + head * 64 + 16 * d0 + 8 * hi);
        const bf16* sg = SGA + qrow * DM + head * 64 + 4 * hi;
        v2u sgw[8];
#pragma unroll
        for (int q4 = 0; q4 < 4; ++q4) { sgw[q4] = *(const v2u*)(sg + 8 * q4); sgw[4 + q4] = *(const v2u*)(sg + 32 + 8 * q4); }
        f32x16 o0 = {}, o1 = {}, o2 = {};
        for (int kk = 0; kk < 3; ++kk) {
            const int kt = (s >> 1) + kk;
            if (n == 0 && kt < 2) continue;
            f32x16 p0 = {}, p1 = {};
            const LAS unsigned char* kb = L + AT_K + (64 * kt + r32) * KT_STRIDE + 16 * hi;
#pragma unroll
            for (int d0 = 0; d0 < 4; ++d0) {
                const bf16x8 a0 = *(const LAS bf16x8*)(kb + 32 * d0);
                const bf16x8 a1 = *(const LAS bf16x8*)(kb + 32 * KT_STRIDE + 32 * d0);
                p0 = __builtin_amdgcn_mfma_f32_32x32x16_bf16(a0, qf[d0], p0, 0, 0, 0);
                p1 = __builtin_amdgcn_mfma_f32_32x32x16_bf16(a1, qf[d0], p1, 0, 0, 0);
            }
            const int dbase = 128 + 32 * s + r32 - 64 * kt - 4 * hi;
            const LAS float* tb = (const LAS float*)(L + AT_T) + hq * 384 + 128 + dbase - 59;
#pragma unroll
            for (int r = 0; r < 16; ++r) {
                const int c = (r & 3) + 8 * (r >> 2);
                p0[r] = fexp2(p0[r] + tb[59 - c]); p1[r] = fexp2(p1[r] + tb[27 - c]);
            }
            const LAS unsigned char* vb = L + AT_V + r32 * VT_STRIDE + (64 * kt + 4 * hi) * 2;
#pragma unroll
            for (int ks = 0; ks < 4; ++ks) {
                v4u pw;
                if (ks == 0)      { pw.x = pg8::cvt_pk_bf16(p0[0], p0[1]);   pw.y = pg8::cvt_pk_bf16(p0[2], p0[3]);   pw.z = pg8::cvt_pk_bf16(p0[4], p0[5]);   pw.w = pg8::cvt_pk_bf16(p0[6], p0[7]); }
                else if (ks == 1) { pw.x = pg8::cvt_pk_bf16(p0[8], p0[9]);   pw.y = pg8::cvt_pk_bf16(p0[10], p0[11]); pw.z = pg8::cvt_pk_bf16(p0[12], p0[13]); pw.w = pg8::cvt_pk_bf16(p0[14], p0[15]); }
                else if (ks == 2) { pw.x = pg8::cvt_pk_bf16(p1[0], p1[1]);   pw.y = pg8::cvt_pk_bf16(p1[2], p1[3]);   pw.z = pg8::cvt_pk_bf16(p1[4], p1[5]);   pw.w = pg8::cvt_pk_bf16(p1[6], p1[7]); }
                else              { pw.x = pg8::cvt_pk_bf16(p1[8], p1[9]);   pw.y = pg8::cvt_pk_bf16(p1[10], p1[11]); pw.z = pg8::cvt_pk_bf16(p1[12], p1[13]); pw.w = pg8::cvt_pk_bf16(p1[14], p1[15]); }
                const bf16x8 pb = __builtin_bit_cast(bf16x8, pw);
                const v2u va0 = *(const LAS v2u*)(vb + 32 * ks), va1 = *(const LAS v2u*)(vb + 32 * ks + 16);
                const v2u vc0 = *(const LAS v2u*)(vb + 32 * VT_STRIDE + 32 * ks), vc1 = *(const LAS v2u*)(vb + 32 * VT_STRIDE + 32 * ks + 16);
                const bf16x8 fa = __builtin_bit_cast(bf16x8, (v4u){va0.x, va0.y, va1.x, va1.y});
                const bf16x8 fc = __builtin_bit_cast(bf16x8, (v4u){vc0.x, vc0.y, vc1.x, vc1.y});
                o0 = __builtin_amdgcn_mfma_f32_32x32x16_bf16(fa, pb, o0, 0, 0, 0);
                o1 = __builtin_amdgcn_mfma_f32_32x32x16_bf16(fc, pb, o1, 0, 0, 0);
                o2 = __builtin_amdgcn_mfma_f32_32x32x16_bf16(onesf, pb, o2, 0, 0, 0);
            }
        }
        const float inv = 1.0f / (o2[0] + sinkv);
        bf16* yo = YM + qrow * DM + head * 64 + 4 * hi;
#pragma unroll
        for (int q4 = 0; q4 < 4; ++q4) {
            {
                const v2u sw = sgw[q4];
                v2u ow; ow.x = pg8::cvt_pk_bf16(o0[4 * q4] * inv * bflo(sw.x), o0[4 * q4 + 1] * inv * bfhi(sw.x)); ow.y = pg8::cvt_pk_bf16(o0[4 * q4 + 2] * inv * bflo(sw.y), o0[4 * q4 + 3] * inv * bfhi(sw.y));
                *(v2u*)(yo + 8 * q4) = ow;
            }
            {
                const v2u sw = sgw[4 + q4];
                v2u ow; ow.x = pg8::cvt_pk_bf16(o1[4 * q4] * inv * bflo(sw.x), o1[4 * q4 + 1] * inv * bfhi(sw.x)); ow.y = pg8::cvt_pk_bf16(o1[4 * q4 + 2] * inv * bflo(sw.y), o1[4 * q4 + 3] * inv * bfhi(sw.y));
                *(v2u*)(yo + 32 + 8 * q4) = ow;
            }
        }
    }
}
__device__ __forceinline__ void attn_phase(Frame& F, float M0) {
    const int NU = NB * 32 * 4;
    int u = blockIdx.x; if (u >= NU) return;
    KVRegs r; attn_load_kv(F, u >> 7, (u >> 2) & 31, u & 3, r);
    for (; u < NU; u += F.G) {
        attn_store_kv(F, r);
        {
            const int g_ = u & 3; LAS float* tb = (LAS float*)(F.lds + AT_T);
            float rv[3];
#pragma unroll
            for (int i = 0; i < 3; ++i) { const int e = F.tid + 512 * i, hh = e / 384, dist = e % 384 - 128; rv[i] = F.in[I_REL][rel_bucket(dist & 127) * 16 + 4 * g_ + hh]; }
#pragma unroll
            for (int i = 0; i < 3; ++i) { const int e = F.tid + 512 * i, dist = e % 384 - 128; tb[e] = ((unsigned)dist < 128u) ? rv[i] * LOG2E - M0 : -1e30f; }
        }
        const int un = u + F.G;
        if (un < NU) attn_load_kv(F, un >> 7, (un >> 2) & 31, un & 3, r);
        LDS_WAIT(); __syncthreads();
        attn_compute(F, u >> 7, (u >> 2) & 31, u & 3, M0);
        __syncthreads();
    }
}

constexpr int REP[7] = {1, 1, 1, 1, 1, 1, 1};
constexpr int REPS[4] = {1, 1, 1, 1};
__global__ void __launch_bounds__(NWAVES * 64, 2) hyb_fwd(Args args) {
    extern __shared__ __attribute__((aligned(16))) unsigned char lds[];
    Frame F;
    F.lds = (LAS unsigned char*)lds;
    F.tid = threadIdx.x; F.lane = F.tid & 63; F.wave = __builtin_amdgcn_readfirstlane(F.tid >> 6);
    F.G = gridDim.x; { const int bx = blockIdx.x; F.vcu = (F.G % 8 == 0) ? (bx % 8) * (F.G / 8) + bx / 8 : bx; }
    F.in = args.in; F.out = args.out; F.ws = args.ws;
    volatile LAS unsigned* MISC = (volatile LAS unsigned*)(F.lds + MISC_OFF);
    for (int u = F.tid; u < (LDS_BYTES - LDSCTL_OFF) / 4; u += NWAVES * 64) ((LAS unsigned*)(F.lds + LDSCTL_OFF))[u] = 0u;
    __syncthreads();
    const int lo = args.ph_lo, hi = args.ph_hi;
    const bool one = (hi - lo) > 1;
    XcdBarrier bar; bar.bar = (unsigned*)(F.ws + WS_CTL) + CW_BAR; bar.x = 0; bar.st = nullptr;
    if (one) bar = xcd_barrier_post((unsigned*)(F.ws + WS_CTL) + CW_BAR, MISC + 8);
#define IN(k) (lo <= (k) && (k) < hi)
#define SEAM(k) do { if (IN(k) && IN((k) + 1)) xcd_barrier(bar); } while (0)
    const int gw = F.vcu * NWAVES + F.wave, NGW = F.G * NWAVES;
    LAS unsigned char* wl = F.lds + F.wave * 16384;

    unsigned* ctlw = (unsigned*)(F.ws + WS_CTL);
    for (int rep = 0; rep < REP[0]; ++rep)
    if (IN(0)) {
        refresh(F);
        for (int t = blockIdx.x; t < 192; t += F.G) { p0_mod_tile(F, t); soft_arrive(ctlw + CW_MODC, 1u); }
        p0_weights(F);
        {
            const int gt_ = F.vcu * (NWAVES * 64) + F.tid, NGT = F.G * NWAVES * 64;
            unsigned long long* za = (unsigned long long*)(F.ws + WS_LBA); unsigned long long* zh = (unsigned long long*)(F.ws + WS_LBH);
            for (int e = gt_; e < 131072; e += NGT) __hip_atomic_store(za + e, 0ull, __ATOMIC_RELAXED, __HIP_MEMORY_SCOPE_AGENT);
            for (int e = gt_; e < 16384; e += NGT) __hip_atomic_store(zh + e, 0ull, __ATOMIC_RELAXED, __HIP_MEMORY_SCOPE_AGENT);
        }
        __syncthreads();
    }
    for (int rep = 0; rep < REP[1]; ++rep)
    if (IN(1)) { refresh(F); soft_wait(ctlw + CW_MODC, 192u); p1_xn(F); }
    SEAM(1);
    for (int rep = 0; rep < REP[2]; ++rep)
    if (IN(2)) {
        pg8::Gemm g{(const bf16*)(F.ws + WS_XN), (const bf16*)(F.ws + WS_WIN), MPAD, INW, DM, nullptr, DM};
        pg8::StaticOrder S; S.init(MPAD, INW, F.G, (int)blockIdx.x);
        EpiZ E{F.ws, F.out, F.in[I_QG], F.in[I_KG]};
        pg8::gemm_phase<EpiZ, pg8::StaticOrder, true, true>(F.lds, g, S, E);
        refresh(F);
        for (;;) {
            if (F.tid == 0) MISC[10] = __hip_atomic_fetch_add(ctlw + CW_TQ, 1u, __ATOMIC_RELAXED, __HIP_MEMORY_SCOPE_AGENT);
            __syncthreads();
            const int it = (int)MISC[10];
            __syncthreads();
            if (it >= TQ_ALL) break;
            tail_item(F, it);
        }
    }
    SEAM(2);
    for (int rep = 0; rep < REP[3]; ++rep)
    if (IN(3)) {
        refresh(F);
        const float M0 = logit_bound(F);
        build_bias_table(F);
        LDS_WAIT(); __syncthreads();
        for (int rs = 0; rs < REPS[0]; ++rs) {
        for (int u = F.vcu; u < NS * 2; u += F.G) sample_attn_block(F, u, M0);
        }
        if (F.G == 256) {
            scan_lb_block(F, F.vcu);
            build_bias_table(F); LDS_WAIT(); __syncthreads();
        } else {
            for (int u = F.vcu; u < 256; u += F.G) scan_block<1>(F, u);
            soft_arrive(ctlw + CW_S1C, 1u);
        }
        for (int rs = 0; rs < REPS[2]; ++rs)
        attn_phase(F, M0);
    }
    for (int rep = 0; rep < REP[4]; ++rep)
    if (IN(4) && F.G != 256) {
        refresh(F);
        soft_wait(ctlw + CW_S1C, (unsigned)F.G);
        for (int u = F.vcu; u < 256; u += F.G) scan_block<2>(F, u);
        __syncthreads();
    }
    SEAM(4);
    for (int rep = 0; rep < REP[5]; ++rep)
    if (IN(5)) {
        pg8::Gemm g{(const bf16*)(F.ws + WS_XN), (const bf16*)(F.ws + WS_WPP), MP, DM, 2048, (const bf16*)(F.out + O_YP), DM};
        pg8::StaticOrder S; S.init(MP, DM, F.G, (int)blockIdx.x);
        EpiMerge E{F.ws + WS_RAT, F.ws + WS_SMR, (bf16*)(F.ws + WS_SGA)};
        pg8::gemm_phase<EpiMerge, pg8::StaticOrder, false, true>(F.lds, g, S, E);
        refresh(F);
        for (int t = F.vcu; t < 256; t += F.G) mini_merge_block(F, t);
    }
    SEAM(5);
    for (int rep = 0; rep < REP[6]; ++rep)
    if (IN(6)) {
        pg8::Gemm g{(const bf16*)(F.ws + WS_SGA), (const bf16*)(F.ws + WS_WOUT), MP, DM, DM, nullptr, DM};
        pg8::StaticOrder S; S.init(MP, DM, F.G, (int)blockIdx.x);
        EpiOut E{F.in[I_XP], (const float*)(F.ws + WS_MOD), F.out + O_YP};
        pg8::gemm_phase<EpiOut, pg8::StaticOrder, false, true>(F.lds, g, S, E);
        refresh(F);
        for (int t = F.vcu; t < 256; t += F.G) mini_out_block(F, t);
    }
#undef IN
#undef SEAM
}

#ifndef MK_N_LAUNCHES
#define MK_N_LAUNCHES 1
#endif
constexpr int N_PHASES = 7;

extern "C" void kernel_launch(void* const* d_in, const int* in_sizes, int n_in, void* d_out, int out_size, void* d_ws, size_t ws_size, hipStream_t stream) {
    static int grid = 0;
    if (grid == 0) {
        if (n_in != 26 || out_size != (int)O_END || ws_size < WS_END) { fprintf(stderr, "kernel_launch: unexpected shapes (n_in %d out %d ws %zu)\n", n_in, out_size, ws_size); grid = -1; return; }
        int dev = 0, cus = 0, per_cu = 0;
        if (hipGetDevice(&dev) != hipSuccess || hipDeviceGetAttribute(&cus, hipDeviceAttributeMultiprocessorCount, dev) != hipSuccess) { grid = -1; return; }
        if (hipFuncSetAttribute((const void*)hyb_fwd, hipFuncAttributeMaxDynamicSharedMemorySize, LDS_BYTES) != hipSuccess) { fprintf(stderr, "kernel_launch: hipFuncSetAttribute failed\n"); grid = -1; return; }
        if (hipOccupancyMaxActiveBlocksPerMultiprocessor(&per_cu, (const void*)hyb_fwd, NWAVES * 64, LDS_BYTES) != hipSuccess || per_cu < 1) { fprintf(stderr, "kernel_launch: occupancy query says %d\n", per_cu); per_cu = 1; }
        (void)hipGetLastError();
        grid = cus * (per_cu < 1 ? 1 : 1);
    }
    if (grid < 0) return;
    (void)hipMemsetAsync((char*)d_ws + WS_CTL, 0, CTL_ZERO_BYTES, stream);
    Args a{};
    for (int i = 0; i < 26; ++i) a.in[i] = (const float*)d_in[i];
    a.out = (float*)d_out; a.ws = (unsigned char*)d_ws;
    if (MK_N_LAUNCHES == 1) {
        a.ph_lo = 0; a.ph_hi = N_PHASES;
        void* kargs[] = {&a};
        hipError_t e = hipLaunchCooperativeKernel((const void*)hyb_fwd, dim3(grid), dim3(NWAVES * 64), kargs, LDS_BYTES, stream);
        if (e != hipSuccess) fprintf(stderr, "kernel_launch: cooperative launch failed: %s (grid %d)\n", hipGetErrorString(e), grid);
    } else {
        for (int p = 0; p < N_PHASES; ++p) {
            a.ph_lo = p; a.ph_hi = p + 1;
            hipLaunchKernelGGL(hyb_fwd, dim3(grid), dim3(NWAVES * 64), LDS_BYTES, stream, a);
        }
    }
}
```

```cpp
#include <hip/hip_runtime.h>
#include <cstdio>
#include <cstdint>

namespace pg8 {
#define PG8_LAS __attribute__((address_space(3)))
typedef unsigned short bf16_t;
typedef short bf16x8 __attribute__((ext_vector_type(8)));
typedef float f32x4 __attribute__((ext_vector_type(4)));
typedef unsigned u32x4 __attribute__((ext_vector_type(4)));
constexpr int BM = 256, BK = 64, HALF = 128, HTB = HALF * BK * 2, STAGE_BYTES = 8 * HTB, NXCD = 8, WGM = 8;

__host__ __device__ __forceinline__ int lds_byte(int r, int c) { const int st = (r >> 4) * 2 + (c >> 5), rr = r & 15, cc = c & 31, ob = rr * 64 + cc * 2; return st * 1024 + (ob ^ (((ob >> 9) & 1) << 5)); }
__host__ __device__ __forceinline__ void stage_rc(int b, int& R, int& C) { const int st = b / 1024, sb = b % 1024, swz = sb ^ (((sb >> 9) & 1) << 5); R = (st >> 1) * 16 + swz / 64; C = (st & 1) * 32 + (swz % 64) / 2; }
__host__ __device__ __forceinline__ int perm32(int rho) { const int n = rho >> 4, i = rho & 15; return 8 * (i >> 2) + 4 * n + (i & 3); }

struct Unit { int pm, pn; };
struct Gemm { const bf16_t* A; const bf16_t* Bt; int M, N, K; const bf16_t* A2; int lda; };

struct StaticOrder {
    int nM, nN, nwg, G, c;
    __host__ __device__ void init(int M, int N, int G_, int c_) { nM = M / BM; nN = N / BM; nwg = nM * nN; G = G_; c = c_; }
    __host__ __device__ bool next(int i, Unit& u) const {
        const long L = (long)i * G + c; if (L >= nwg) return false;
        int wgid = (int)L; { const int q = nwg / NXCD, r = nwg % NXCD, xcd = wgid % NXCD, off = wgid / NXCD; wgid = (xcd < r ? xcd * (q + 1) : r * (q + 1) + (xcd - r) * q) + off; }
        const int nig = WGM * nN, gid = wgid / nig, fm = gid * WGM, gsz = (nM - fm) < WGM ? (nM - fm) : WGM;
        u.pm = fm + ((wgid % nig) % gsz); u.pn = (wgid % nig) / gsz; return true;
    }
    __device__ __forceinline__ void a_ready(const Unit&) const {}
    __device__ __forceinline__ void done(const Unit&) const {}
};

typedef float f32x2_t __attribute__((ext_vector_type(2))); typedef __bf16 bf16x2_t __attribute__((ext_vector_type(2)));
__device__ __forceinline__ unsigned cvt_pk_bf16(float lo, float hi) { f32x2_t v = {lo, hi}; bf16x2_t b = __builtin_convertvector(v, bf16x2_t); return __builtin_bit_cast(unsigned, b); }

template <class Epi, class Sched, bool ALIGN_EPI = false, bool SP2 = false>
__device__ __forceinline__ void gemm_phase(PG8_LAS unsigned char* lds, const Gemm g, const Sched& S, const Epi& E) {
    int tid_ = threadIdx.x; asm volatile("" : "+v"(tid_));
    const int tid = tid_, wid = __builtin_amdgcn_readfirstlane(tid >> 6), lane = tid & 63, wr = wid >> 2, wc = wid & 3, fr = lane & 15, fq = lane >> 4;
    const int K = g.K, nt = K / BK;
    unsigned voffA[2], voffB[2];
#pragma unroll
    for (int i = 0; i < 2; ++i) { int R, C; stage_rc(tid * 16 + i * 8192, R, C); const int Rb = Epi::PERM ? ((R & ~31) + perm32(R & 31)) : R;
        voffA[i] = (unsigned)(R * g.lda + C) * 2u; voffB[i] = (unsigned)(Rb * K + C) * 2u; }
    const size_t kstep = (size_t)(BK * 2);
    const size_t hstep = (size_t)HALF * K * 2;
    const size_t tstep = 2 * hstep;
    const size_t hstepA = (size_t)HALF * g.lda * 2, tstepA = 2 * hstepA;
    const int nh = g.A2 ? nt / 2 : nt + 4;
    const long a2delta = g.A2 ? ((const char*)g.A2 - (const char*)g.A) - (long)nh * (long)kstep : 0;
    const unsigned ldsw = (unsigned)wid * 1024u;
    const int aoff = lds_byte(wr * 64 + fr, fq * 8), boff = lds_byte(wc * 32 + fr, fq * 8);
#define PG8_SA(b, h) (((b) * 2 + (h)) * HTB)
#define PG8_SB(b, h) ((4 + (b) * 2 + (h)) * HTB)
#define PG8_STAGE(bufoff, gbase, voff) do { _Pragma("unroll") for (int _i = 0; _i < 2; ++_i) \
        __builtin_amdgcn_global_load_lds((const unsigned*)((const char*)(gbase) + (voff)[_i]), (PG8_LAS unsigned*)(lds + (bufoff) + ldsw + _i * 8192), 16, 0, 0); } while (0)
#define PG8_LDA(dst, b, h) do { _Pragma("unroll") for (int m = 0; m < 4; ++m) _Pragma("unroll") for (int k = 0; k < 2; ++k) dst[m][k] = *(const PG8_LAS bf16x8*)(lds + PG8_SA(b, h) + aoff + m * 2048 + k * 1024); } while (0)
#define PG8_LDB(dst, b, h) do { _Pragma("unroll") for (int n = 0; n < 2; ++n) _Pragma("unroll") for (int k = 0; k < 2; ++k) dst[n][k] = *(const PG8_LAS bf16x8*)(lds + PG8_SB(b, h) + boff + n * 2048 + k * 1024); } while (0)
#define PG8_MMA(ai, bj, At, Bt) do { __builtin_amdgcn_s_setprio(1); _Pragma("unroll") for (int m = 0; m < 4; ++m) _Pragma("unroll") for (int n = 0; n < 2; ++n) _Pragma("unroll") for (int k = 0; k < 2; ++k) \
        acc[ai][bj][m][n] = __builtin_amdgcn_mfma_f32_16x16x32_bf16(Bt[n][k], At[m][k], acc[ai][bj][m][n], 0, 0, 0); __builtin_amdgcn_s_setprio(0); } while (0)
#define PG8_WAIT_V(n) asm volatile("s_waitcnt vmcnt(" #n ")" ::: "memory")
#define PG8_WAIT_L(n) asm volatile("s_waitcnt lgkmcnt(" #n ")" ::: "memory")
#define PG8_BAR __builtin_amdgcn_s_barrier()
#define PG8_SCHED __builtin_amdgcn_sched_barrier(0)
    Unit cur, nxt; int ui = 0;
    if (!S.next(0, cur)) return;
    f32x4 acc[2][2][4][2];
#pragma unroll
    for (int a = 0; a < 2; ++a)
#pragma unroll
        for (int b = 0; b < 2; ++b)
#pragma unroll
            for (int m = 0; m < 4; ++m)
#pragma unroll
                for (int n = 0; n < 2; ++n) acc[a][b][m][n] = (f32x4){0.f, 0.f, 0.f, 0.f};
    bf16x8 At[4][2], B0[2][2], B1[2][2];
    const char* cA = (const char*)g.A + (size_t)cur.pm * tstepA; const char* cB = (const char*)g.Bt + (size_t)cur.pn * tstep;
    S.a_ready(cur);
    if constexpr (SP2) {
        PG8_STAGE(PG8_SB(0, 0), cB, voffB); PG8_STAGE(PG8_SB(0, 1), cB + hstep, voffB); PG8_STAGE(PG8_SA(0, 0), cA, voffA); PG8_STAGE(PG8_SA(0, 1), cA + hstepA, voffA);
        if (wr == 1) PG8_BAR;
        PG8_WAIT_V(2); PG8_BAR;
        PG8_STAGE(PG8_SB(1, 0), cB + kstep, voffB); PG8_STAGE(PG8_SA(1, 0), cA + kstep, voffA); PG8_STAGE(PG8_SB(1, 1), cB + hstep + kstep, voffB);
        PG8_WAIT_V(6); PG8_BAR;
    } else {
        PG8_STAGE(PG8_SB(0, 0), cB, voffB); PG8_STAGE(PG8_SA(0, 0), cA, voffA); PG8_STAGE(PG8_SB(0, 1), cB + hstep, voffB); PG8_STAGE(PG8_SA(0, 1), cA + hstepA, voffA);
        if (wr == 1) PG8_BAR;
        PG8_WAIT_V(4); PG8_BAR;
        PG8_STAGE(PG8_SB(1, 0), cB + kstep, voffB); PG8_STAGE(PG8_SA(1, 0), cA + kstep, voffA); PG8_STAGE(PG8_SB(1, 1), cB + hstep + kstep, voffB);
        PG8_WAIT_V(6); PG8_BAR;
    }
    for (;;) {
        const bool has_next = S.next(ui + 1, nxt);
        const char* nA = has_next ? (const char*)g.A + (size_t)nxt.pm * tstepA : cA; const char* nB = has_next ? (const char*)g.Bt + (size_t)nxt.pn * tstep : cB;
        for (int t = 0; t < nt; t += 2) {
            if constexpr (Epi::HAS_MID) { if (t == nt / 2) E.mid(acc, cur, wr, wc, fr, fq); }
            const bool last = (t == nt - 2);
            const char* a1 = cA + (t >= nh ? a2delta : 0) + (size_t)(t + 1) * kstep;
            const char* a2 = last ? nA : cA + (t + 2 >= nh ? a2delta : 0) + (size_t)(t + 2) * kstep; const char* b2 = last ? nB : cB + (size_t)(t + 2) * kstep;
            const char* a3 = a2 + kstep; const char* b3 = b2 + kstep;
            if (last && has_next) S.a_ready(nxt);
            if constexpr (SP2) {
            PG8_LDB(B0, 0, 0); PG8_LDB(B1, 0, 1); PG8_SCHED; PG8_LDA(At, 0, 0); PG8_STAGE(PG8_SA(1, 1), a1 + hstepA, voffA);
            PG8_WAIT_V(8); PG8_WAIT_L(0); PG8_BAR; PG8_MMA(0, 0, At, B0); PG8_MMA(0, 1, At, B1); PG8_BAR; PG8_SCHED;
            PG8_LDA(At, 0, 1); PG8_STAGE(PG8_SB(0, 0), b2, voffB); PG8_STAGE(PG8_SB(0, 1), b2 + hstep, voffB); PG8_STAGE(PG8_SA(0, 0), a2, voffA);
            PG8_WAIT_V(8); PG8_WAIT_L(0); PG8_BAR; PG8_MMA(1, 0, At, B0); PG8_MMA(1, 1, At, B1); PG8_BAR; PG8_SCHED;
            PG8_LDB(B0, 1, 0); PG8_LDB(B1, 1, 1); PG8_SCHED; PG8_LDA(At, 1, 0); PG8_STAGE(PG8_SA(0, 1), a2 + hstepA, voffA);
            PG8_WAIT_V(8); PG8_WAIT_L(0); PG8_BAR; PG8_MMA(0, 0, At, B0); PG8_MMA(0, 1, At, B1); PG8_BAR; PG8_SCHED;
            PG8_LDA(At, 1, 1); PG8_STAGE(PG8_SB(1, 0), b3, voffB); PG8_STAGE(PG8_SB(1, 1), b3 + hstep, voffB); PG8_STAGE(PG8_SA(1, 0), a3, voffA);
            PG8_WAIT_V(8); PG8_WAIT_L(0); PG8_BAR; PG8_MMA(1, 0, At, B0); PG8_MMA(1, 1, At, B1); PG8_BAR; PG8_SCHED;
            } else {
            PG8_LDB(B0, 0, 0); PG8_SCHED; PG8_LDA(At, 0, 0); PG8_STAGE(PG8_SA(1, 1), a1 + hstepA, voffA);
            PG8_WAIT_L(8); PG8_BAR; PG8_WAIT_L(0); PG8_MMA(0, 0, At, B0); PG8_BAR; PG8_SCHED;
            PG8_LDB(B1, 0, 1); PG8_STAGE(PG8_SB(0, 0), b2, voffB);
            PG8_BAR; PG8_WAIT_L(0); PG8_MMA(0, 1, At, B1); PG8_BAR;
            PG8_LDA(At, 0, 1); PG8_STAGE(PG8_SA(0, 0), a2, voffA);
            PG8_BAR; PG8_WAIT_L(0); PG8_MMA(1, 0, At, B0); PG8_BAR; PG8_SCHED;
            PG8_STAGE(PG8_SB(0, 1), b2 + hstep, voffB);
            PG8_WAIT_V(6); PG8_BAR; PG8_MMA(1, 1, At, B1); PG8_BAR;
            PG8_LDB(B0, 1, 0); PG8_SCHED; PG8_LDA(At, 1, 0); PG8_STAGE(PG8_SA(0, 1), a2 + hstepA, voffA);
            PG8_WAIT_L(8); PG8_BAR; PG8_WAIT_L(0); PG8_MMA(0, 0, At, B0); PG8_BAR; PG8_SCHED;
            PG8_LDB(B1, 1, 1); PG8_STAGE(PG8_SB(1, 0), b3, voffB);
            PG8_BAR; PG8_WAIT_L(0); PG8_MMA(0, 1, At, B1); PG8_BAR;
            PG8_LDA(At, 1, 1); PG8_STAGE(PG8_SA(1, 0), a3, voffA);
            PG8_BAR; PG8_WAIT_L(0); PG8_MMA(1, 0, At, B0); PG8_BAR; PG8_SCHED;
            PG8_STAGE(PG8_SB(1, 1), b3 + hstep, voffB);
            PG8_WAIT_V(6); PG8_BAR; PG8_MMA(1, 1, At, B1); PG8_BAR;
            }
        }
        if constexpr (ALIGN_EPI) { if (wr == 0) PG8_BAR; }
        E(acc, cur, wr, wc, fr, fq); S.done(cur);
        if (!has_next) break;
#pragma unroll
        for (int a = 0; a < 2; ++a)
#pragma unroll
            for (int b = 0; b < 2; ++b)
#pragma unroll
                for (int m = 0; m < 4; ++m)
#pragma unroll
                    for (int n = 0; n < 2; ++n) acc[a][b][m][n] = (f32x4){0.f, 0.f, 0.f, 0.f};
        cur = nxt; cA = nA; cB = nB; ++ui;
        if constexpr (ALIGN_EPI) { if (wr == 1) PG8_BAR; }
    }
    PG8_WAIT_V(0);
    if constexpr (!ALIGN_EPI) { if (wr == 0) PG8_BAR; }
    PG8_BAR;
#undef PG8_SA
#undef PG8_SB
#undef PG8_STAGE
#undef PG8_LDA
#undef PG8_LDB
#undef PG8_MMA
#undef PG8_WAIT_V
#undef PG8_WAIT_L
#undef PG8_BAR
#undef PG8_SCHED
}
}

constexpr int NWAVES = 8;
constexpr int DM = 1024, NB = 4, SEQ = 4096, NS = 128, WIN = 128;
constexpr int MP = NB * SEQ;
constexpr int MALL = MP + NS;
constexpr int MPAD = 16640;
constexpr int INW = 6656;
constexpr int NCH = 32;
constexpr float EPSN = 1e-6f;
constexpr float LOG2E = 1.4426950408889634f;
constexpr float QSCALE = 0.125f * LOG2E;

constexpr size_t MiB = 1u << 20;
constexpr size_t WS_CTL = 0, CTL_ZERO_BYTES = 64 * 1024;
constexpr size_t WS_MOD = 1 * MiB;
constexpr size_t WS_WRA = 3 * MiB;
constexpr size_t WS_WRX = 3 * MiB + 128 * 1024;
constexpr size_t WS_KVNEW = 3 * MiB + 256 * 1024;
constexpr size_t WS_AGG = 4 * MiB;
constexpr size_t WS_LBA = 4 * MiB;
constexpr size_t WS_LBH = 3 * MiB + 512 * 1024;
constexpr size_t WS_WIN = 5 * MiB;
constexpr size_t WS_WPP = 18 * MiB;
constexpr size_t WS_WOUT = 22 * MiB;
constexpr size_t WS_XN = 24 * MiB;
constexpr size_t ACT = (size_t)MPAD * DM * 2;
constexpr size_t WS_K = WS_XN + ACT;
constexpr size_t WS_V = WS_K + ACT / 4;
constexpr size_t WS_SGA = WS_V + ACT / 4;
constexpr size_t WS_XR = WS_SGA + ACT;
constexpr size_t WS_SGR = WS_XR + ACT;
constexpr size_t WS_RAT = WS_SGR + ACT;
constexpr size_t WS_SMR = WS_RAT + ACT;
constexpr size_t WS_QT = WS_SMR + ACT;
constexpr size_t WS_YT = WS_QT + 512 * 1024;
constexpr size_t WS_MGT = WS_YT + 512 * 1024;
constexpr size_t WS_END = WS_MGT + 256 * 1024;
static_assert(WS_END <= 256 * MiB, "d_ws map");
constexpr size_t O_YP = 0, O_YS = 16777216, O_KWP = 16908288, O_VWP = 17039360, O_CVP = 17170432, O_HP = 17182720,
                 O_KWS = 17186816, O_VWS = 21381120, O_CVS = 25575424, O_HS = 25968640, O_END = 26099712;
constexpr size_t QM_OFF = (size_t)MP * DM;

constexpr int CW_BAR = 1024, CW_MODC = 64, CW_S1C = 128, CW_TQ = 192;

constexpr int RING_BYTES = 131072;
constexpr int GW_OFF = RING_BYTES, GW_STRIDE = 144, GW_BYTES = 2 * 64 * GW_STRIDE;
constexpr int BT_OFF = GW_OFF + GW_BYTES, BT_BYTES = 16 * 128 * 4;
constexpr int LDSCTL_OFF = BT_OFF + BT_BYTES, MISC_OFF = LDSCTL_OFF + 320;
constexpr int LDS_BYTES = LDSCTL_OFF + 512;

#define GAS __attribute__((address_space(1)))
#define LAS __attribute__((address_space(3)))
typedef unsigned short bf16;
typedef unsigned v4u __attribute__((ext_vector_type(4)));
typedef unsigned v2u __attribute__((ext_vector_type(2)));
typedef float f32x4 __attribute__((ext_vector_type(4)));
typedef float f32x16 __attribute__((ext_vector_type(16)));
typedef short bf16x8 __attribute__((ext_vector_type(8)));
typedef short s16x4 __attribute__((ext_vector_type(4)));
typedef GAS unsigned gu32;
#define RLX_AGENT __ATOMIC_RELAXED, __HIP_MEMORY_SCOPE_AGENT
#define LDS_WAIT() asm volatile("s_waitcnt lgkmcnt(0)" ::: "memory")
#define VM_WAIT() asm volatile("s_waitcnt vmcnt(0)" ::: "memory")
__device__ __forceinline__ unsigned f2bf(float f) { unsigned u = __builtin_bit_cast(unsigned, f); return (u + 0x7fffu + ((u >> 16) & 1u)) >> 16; }
__device__ __forceinline__ unsigned pk2(float lo, float hi) { return f2bf(lo) | (f2bf(hi) << 16); }
__device__ __forceinline__ float bf2f(unsigned b) { return __uint_as_float(b << 16); }
__device__ __forceinline__ float bflo(unsigned w) { return __uint_as_float(w << 16); }
__device__ __forceinline__ float bfhi(unsigned w) { return __uint_as_float(w & 0xffff0000u); }
__device__ __forceinline__ unsigned pk_u8x4(float a, float b, float c, float d) {
    unsigned r = __builtin_amdgcn_cvt_pk_u8_f32(fmaxf(a * 255.0f, 1.0f), 0, 0u); r = __builtin_amdgcn_cvt_pk_u8_f32(fmaxf(b * 255.0f, 1.0f), 1, r);
    r = __builtin_amdgcn_cvt_pk_u8_f32(fmaxf(c * 255.0f, 1.0f), 2, r); return __builtin_amdgcn_cvt_pk_u8_f32(fmaxf(d * 255.0f, 1.0f), 3, r); }
__device__ __forceinline__ float u8f(unsigned w, int i) { return (float)((w >> (8 * i)) & 0xffu); }
__device__ __forceinline__ float fexp2(float x) { return __builtin_amdgcn_exp2f(x); }
__device__ __forceinline__ float frcp(float x) { return __builtin_amdgcn_rcpf(x); }
__device__ __forceinline__ float sigm(float x) { return frcp(1.0f + fexp2(-LOG2E * x)); }

#define XB_TMO      128
#define XB_XCNT(j)  (256  + 64 * (j))
#define XB_XSUB(j)  (1280 + 64 * (j))
#define XB_XGEN(j)  (2304 + 64 * (j))
#define XB_TOP      3328
#define XB_TOPGEN   3392
#define XCD_BAR_WORDS 3456
#define XB_SPIN_CAP (1u << 22)
__device__ __forceinline__ unsigned xb_ld(unsigned* p)              { return __hip_atomic_load(p, __ATOMIC_RELAXED, __HIP_MEMORY_SCOPE_AGENT); }
__device__ __forceinline__ unsigned xb_add(unsigned* p, unsigned v) { return __hip_atomic_fetch_add(p, v, __ATOMIC_RELAXED, __HIP_MEMORY_SCOPE_AGENT); }
__device__ __forceinline__ unsigned xb_xcc_id() { return (unsigned)__builtin_amdgcn_s_getreg((3 << 11) | 20) & 0xFu; }
#define XB_SPIN(cond, bar) do { unsigned _sp = 0; while (cond) { __builtin_amdgcn_s_sleep(1); \
    if ((++_sp & 255u) == 0u) { if (xb_ld(&(bar)[XB_TMO])) break; if (_sp > XB_SPIN_CAP) { atomicAdd(&(bar)[XB_TMO], 1u); break; } } } } while (0)
struct XcdBarrier { unsigned* bar; unsigned x; volatile LAS unsigned* st; };
__device__ __forceinline__ XcdBarrier xcd_barrier_post(unsigned* bar, volatile LAS unsigned* st) {
    XcdBarrier b; b.bar = bar; b.x = xb_xcc_id(); b.st = st;
    if (threadIdx.x == 0) (void)xb_add(&bar[XB_XCNT(b.x)], 1u);
    return b;
}
__device__ __forceinline__ void xcd_barrier_complete(unsigned* bar, unsigned x, unsigned& nloc, unsigned& nx) {
    const unsigned G = gridDim.x * gridDim.y * gridDim.z;
    unsigned sum, cnt, mine, sp = 0u;
    for (;;) {
        sum = 0u; cnt = 0u; mine = 0u;
#pragma unroll
        for (unsigned j = 0; j < 16; ++j) { const unsigned c = xb_ld(&bar[XB_XCNT(j)]); sum += c; cnt += (c > 0u) ? 1u : 0u; mine = (j == x) ? c : mine; }
        if (sum == G) break;
        __builtin_amdgcn_s_sleep(1);
        if ((++sp & 255u) == 0u) { if (xb_ld(&bar[XB_TMO])) break; if (sp > XB_SPIN_CAP) { atomicAdd(&bar[XB_TMO], 1u); break; } }
    }
    nloc = mine > 0u ? mine : 1u; nx = cnt > 0u ? cnt : 1u;
}
__device__ __forceinline__ void xcd_barrier(const XcdBarrier& b) {
    asm volatile("s_waitcnt vmcnt(0)" ::: "memory");
    __syncthreads();
    if (threadIdx.x == 0) {
        unsigned* bar = b.bar;
        __builtin_amdgcn_s_waitcnt(0);
        unsigned nloc = b.st[0], nx = b.st[1];
        if (nloc == 0u) { xcd_barrier_complete(bar, b.x, nloc, nx); b.st[0] = nloc; b.st[1] = nx; }
        const unsigned old = xb_add(&bar[XB_XSUB(b.x)], 1u);
        const unsigned gen = old / nloc;
        if (old + 1u == (gen + 1u) * nloc) {
            __builtin_amdgcn_fence(__ATOMIC_RELEASE, "agent");
            asm volatile("s_waitcnt vmcnt(0)" ::: "memory");
            const unsigned og = xb_add(&bar[XB_TOP], 1u);
            const unsigned tg = og / nx;
            if (og + 1u == (tg + 1u) * nx) xb_add(&bar[XB_TOPGEN], 1u);
            else XB_SPIN(xb_ld(&bar[XB_TOPGEN]) == tg, bar);
            __builtin_amdgcn_fence(__ATOMIC_ACQUIRE, "agent");
            xb_add(&bar[XB_XGEN(b.x)], 1u);
            asm volatile("s_waitcnt vmcnt(0)" ::: "memory");
        } else {
            XB_SPIN(xb_ld(&bar[XB_XGEN(b.x)]) == gen, bar);
            __builtin_amdgcn_fence(__ATOMIC_ACQUIRE, "agent");
            asm volatile("s_waitcnt vmcnt(0)" ::: "memory");
        }
    }
    __syncthreads();
}

__device__ __forceinline__ void soft_arrive(unsigned* cnt, unsigned v) {
    asm volatile("s_waitcnt vmcnt(0)" ::: "memory"); __syncthreads();
    if (threadIdx.x == 0) (void)__hip_atomic_fetch_add(cnt, v, __ATOMIC_RELAXED, __HIP_MEMORY_SCOPE_AGENT);
}
__device__ __forceinline__ void soft_wait(unsigned* cnt, unsigned need) {
    if (threadIdx.x == 0) {
        unsigned sp = 0;
        while (__hip_atomic_load(cnt, __ATOMIC_RELAXED, __HIP_MEMORY_SCOPE_AGENT) < need) { __builtin_amdgcn_s_sleep(2); if (++sp > (1u << 22)) break; }
        __builtin_amdgcn_fence(__ATOMIC_ACQUIRE, "agent");
        asm volatile("s_waitcnt vmcnt(0)" ::: "memory");
    }
    __syncthreads();
}
__device__ __forceinline__ void st_sc1(float* p, float v) { __hip_atomic_store((unsigned*)p, __float_as_uint(v), __ATOMIC_RELAXED, __HIP_MEMORY_SCOPE_AGENT); }
struct Args {
    const float* in[26];
    float* out; unsigned char* ws;
    int ph_lo, ph_hi;
};
enum { I_XP = 0, I_XS, I_CK, I_CV, I_SC, I_SH, I_CP, I_CS, I_REL, I_NG, I_WADA, I_BADA, I_WIN, I_QG, I_KG, I_SINK, I_WCONV, I_BCONV,
       I_WRA, I_BRA, I_WRX, I_BRX, I_LAM, I_WPA, I_WPR, I_WOUT };

struct Frame {
    LAS unsigned char* lds;
    int tid, lane, wave, G, vcu;
    const float* const* in;
    float* out; unsigned char* ws;
};

__device__ __forceinline__ void refresh(Frame& F) {
    int t = threadIdx.x; asm volatile("" : "+v"(t));
    F.tid = t; F.lane = t & 63; F.wave = __builtin_amdgcn_readfirstlane(t >> 6);
}
__device__ __forceinline__ int rel_bucket(int n) { const int big = 16 + (int)(__builtin_amdgcn_logf((float)n * 0.0625f) * (16.0f / 3.0f)); return n < 16 ? n : (big < 31 ? big : 31); }
__device__ const unsigned char BUCKET[128] = {0, 1, 2, 3, 4, 5, 6, 7, 8, 9, 10, 11, 12, 13, 14, 15, 16, 16, 16, 17, 17, 18, 18, 18, 19, 19, 19, 20, 20, 20, 20, 21, 21, 21, 21, 22, 22, 22, 22, 22, 23, 23, 23, 23, 23, 23, 24, 24, 24, 24, 24, 24, 25, 25, 25, 25, 25, 25, 25, 26, 26, 26, 26, 26, 26, 26, 26, 27, 27, 27, 27, 27, 27, 27, 27, 27, 27, 28, 28, 28, 28, 28, 28, 28, 28, 28, 28, 29, 29, 29, 29, 29, 29, 29, 29, 29, 29, 29, 29, 30, 30, 30, 30, 30, 30, 30, 30, 30, 30, 30, 30, 30, 30, 31, 31, 31, 31, 31, 31, 31, 31, 31, 31, 31, 31, 31, 31, 31};

__device__ __forceinline__ void transpose_block(const float* W, int N, int k0, int n0, bf16* WT, int ldk, int drow0, int kofs, LAS float* scr, int lane) {
    f32x4 wv[8];
#pragma unroll
    for (int i = 0; i < 8; ++i) wv[i] = __builtin_nontemporal_load((const f32x4*)(W + (size_t)(k0 + 8 * i + (lane >> 3)) * N + n0 + 4 * (lane & 7)));
#pragma unroll
    for (int i = 0; i < 8; ++i) { LAS float* d = scr + (8 * i + (lane >> 3)) * 33 + 4 * (lane & 7); d[0] = wv[i][0]; d[1] = wv[i][1]; d[2] = wv[i][2]; d[3] = wv[i][3]; }
    LDS_WAIT(); asm volatile("" ::: "memory");
    const int c = lane & 7;
#pragma unroll
    for (int j = 0; j < 4; ++j) { const int n = (lane >> 3) + 8 * j; const LAS float* s = scr + (8 * c) * 33 + n;
        v4u o; o.x = pk2(s[0 * 33], s[1 * 33]); o.y = pk2(s[2 * 33], s[3 * 33]); o.z = pk2(s[4 * 33], s[5 * 33]); o.w = pk2(s[6 * 33], s[7 * 33]);
        *(GAS v4u*)(WT + (size_t)(drow0 + n) * ldk + kofs + k0 + 8 * c) = o; }
    LDS_WAIT(); asm volatile("" ::: "memory");
}
__device__ __forceinline__ int win_row(int n0) {
    if (n0 < 1280) { const int t = n0 >> 8, w = n0 & 255; return (t << 8) + (((w >> 5) & 1) << 7) + ((w >> 6) << 5); }
    if (n0 < 4608) return n0;
    if (n0 < 5632) { const int i = n0 - 4608; return 4608 + ((i >> 7) << 8) + (i & 127); }
    { const int i = n0 - 5632; return 4608 + ((i >> 7) << 8) + 128 + (i & 127); }
}
__device__ __forceinline__ void p0_weights(Frame& F) {
    LAS float* scr = (LAS float*)(F.lds + F.wave * 16384);
    const int gw = F.vcu * NWAVES + F.wave, NGW = F.G * NWAVES;
    bf16* WIN_T = (bf16*)(F.ws + WS_WIN);
    for (int it = gw; it < 16 * 208; it += NGW) { const int kb = it / 208, nb = it % 208; transpose_block(F.in[I_WIN], INW, 64 * kb, 32 * nb, WIN_T, DM, win_row(32 * nb), 0, scr, F.lane); }
}
constexpr int TQ_TR = 200, TQ_ALL = 708;
__device__ __forceinline__ void tail_item(Frame& F, int it) {
    if (it < TQ_TR) {
        LAS float* scr = (LAS float*)(F.lds + F.wave * 16384);
        int r = 8 * it + F.wave;
        bf16* WPP = (bf16*)(F.ws + WS_WPP); bf16* WOUT_T = (bf16*)(F.ws + WS_WOUT);
        if (r < 512) { const int kb = r / 32, nb = r % 32; transpose_block(F.in[I_WPA], DM, 64 * kb, 32 * nb, WPP, 2048, 32 * nb, 0, scr, F.lane); return; } r -= 512;
        if (r < 512) { const int kb = r / 32, nb = r % 32; transpose_block(F.in[I_WPR], DM, 64 * kb, 32 * nb, WPP, 2048, 32 * nb, 1024, scr, F.lane); return; } r -= 512;
        if (r < 512) { const int kb = r / 32, nb = r % 32; transpose_block(F.in[I_WOUT], DM, 64 * kb, 32 * nb, WOUT_T, DM, 32 * nb, 0, scr, F.lane); return; } r -= 512;
        if (r < 32) { const int blk = r >> 1, nb = r & 1; transpose_block(F.in[I_WRA] + blk * 4096, 64, 0, 32 * nb, (bf16*)(F.ws + WS_WRA) + blk * 4096, 64, 32 * nb, 0, scr, F.lane); return; } r -= 32;
        { const int blk = r >> 1, nb = r & 1; transpose_block(F.in[I_WRX] + blk * 4096, 64, 0, 32 * nb, (bf16*)(F.ws + WS_WRX) + blk * 4096, 64, 32 * nb, 0, scr, F.lane); }
        return;
    }
    const int rbase = (it - TQ_TR) * 64 + 8 * F.wave;
    f32x4 v[8]; size_t dsto[8];
#pragma unroll
    for (int i = 0; i < 8; ++i) {
        const int rr = rbase + i, which = rr / 16256, r2 = rr % 16256, bs = r2 / 127, jj = r2 % 127;
        v[i] = __builtin_nontemporal_load((const f32x4*)F.in[which ? I_CV : I_CK] + ((size_t)bs * 128 + jj + 1) * 64 + F.lane);
        dsto[i] = (which ? O_VWS : O_KWS) / 4 + ((size_t)bs * 128 + jj) * 64 + F.lane;
    }
#pragma unroll
    for (int i = 0; i < 8; ++i) __builtin_nontemporal_store(v[i], (f32x4*)F.out + dsto[i]);
}

__device__ __forceinline__ void p0_mod_tile(Frame& F, int nt) {
    const float* wada = F.in[I_WADA]; const int lane = F.lane, w = F.wave;
    const int n0 = 16 * nt, kbase = 128 * w;
    f32x4 acc[9];
#pragma unroll
    for (int m = 0; m < 9; ++m) acc[m] = (f32x4){0.f, 0.f, 0.f, 0.f};
    float bvv[4][8];
#pragma unroll
    for (int ks = 0; ks < 4; ++ks)
#pragma unroll
        for (int j = 0; j < 8; ++j) bvv[ks][j] = __builtin_nontemporal_load(wada + (size_t)(kbase + 32 * ks + 8 * (lane >> 4) + j) * 3072 + n0 + (lane & 15));
#pragma unroll
    for (int ks = 0; ks < 4; ++ks) {
        const int k0 = kbase + 32 * ks + 8 * (lane >> 4);
        f32x4 a0[9], a1[9];
#pragma unroll
        for (int m = 0; m < 9; ++m) {
            const int row = 16 * m + (lane & 15);
            const int rr = row < 132 ? row : 131;
            const float* cr = (rr < 4 ? F.in[I_CP] + rr * 1024 : F.in[I_CS] + (rr - 4) * 1024) + k0;
            a0[m] = *(const f32x4*)cr; a1[m] = *(const f32x4*)(cr + 4);
        }
        v4u bw; bw.x = pk2(bvv[ks][0], bvv[ks][1]); bw.y = pk2(bvv[ks][2], bvv[ks][3]); bw.z = pk2(bvv[ks][4], bvv[ks][5]); bw.w = pk2(bvv[ks][6], bvv[ks][7]);
        const bf16x8 bfr = __builtin_bit_cast(bf16x8, bw);
#pragma unroll
        for (int m = 0; m < 9; ++m) {
            const int row = 16 * m + (lane & 15);
            v4u aw; aw.x = pk2(a0[m].x, a0[m].y); aw.y = pk2(a0[m].z, a0[m].w); aw.z = pk2(a1[m].x, a1[m].y); aw.w = pk2(a1[m].z, a1[m].w);
            if (row >= 132) aw = (v4u){0u, 0u, 0u, 0u};
            acc[m] = __builtin_amdgcn_mfma_f32_16x16x32_bf16(__builtin_bit_cast(bf16x8, aw), bfr, acc[m], 0, 0, 0);
        }
    }
    LAS float* part = (LAS float*)F.lds;
#pragma unroll
    for (int m = 0; m < 9; ++m)
#pragma unroll
        for (int r = 0; r < 4; ++r) part[(w * 144 + 16 * m + 4 * (lane >> 4) + r) * 16 + (lane & 15)] = acc[m][r];
    __syncthreads();
    float* mod = (float*)(F.ws + WS_MOD);
    for (int e = F.tid; e < 132 * 4; e += NWAVES * 64) {
        const int row = e >> 2, c4 = (e & 3) * 4; f32x4 s = *(const f32x4*)(F.in[I_BADA] + n0 + c4);
#pragma unroll
        for (int ww = 0; ww < 8; ++ww) s += *(const LAS f32x4*)(part + (ww * 144 + row) * 16 + c4);
        const v4u sv = __builtin_bit_cast(v4u, s);
        unsigned long long* dst = (unsigned long long*)(mod + (size_t)row * 3072 + n0 + c4);
        __hip_atomic_store(dst, (unsigned long long)sv.x | ((unsigned long long)sv.y << 32), __ATOMIC_RELAXED, __HIP_MEMORY_SCOPE_AGENT);
        __hip_atomic_store(dst + 1, (unsigned long long)sv.z | ((unsigned long long)sv.w << 32), __ATOMIC_RELAXED, __HIP_MEMORY_SCOPE_AGENT);
    }
    __syncthreads();
}
__device__ __forceinline__ float wave_sum(float v) {
#pragma unroll
    for (int o = 1; o < 64; o <<= 1) v += __shfl_xor(v, o);
    return v;
}
__device__ __forceinline__ const float* xn_src_row(Frame& F, int m) { return m < MP ? F.in[I_XP] + (size_t)m * DM : F.in[I_XS] + (size_t)(m - MP) * DM; }
__device__ __forceinline__ void p1_xn(Frame& F) {
    const int RPB = (MPAD + F.G - 1) / F.G, rbeg = F.vcu * RPB, rend = (rbeg + RPB < MPAD) ? rbeg + RPB : MPAD;
    const float* mod = (const float*)(F.ws + WS_MOD); bf16* XN = (bf16*)(F.ws + WS_XN);
    const f32x4* gp = (const f32x4*)F.in[I_NG] + F.lane;
    f32x4 gvec[4];
#pragma unroll
    for (int j = 0; j < 4; ++j) gvec[j] = gp[64 * j];
    f32x4 nx[4];
    if (rbeg + F.wave < MALL && rbeg + F.wave < rend) { const f32x4* xr = (const f32x4*)xn_src_row(F, rbeg + F.wave) + F.lane;
#pragma unroll
        for (int j = 0; j < 4; ++j) nx[j] = __builtin_nontemporal_load(xr + 64 * j); }
    int mr_c = -1; f32x4 scv[4], shv[4];
#pragma unroll
    for (int j = 0; j < 4; ++j) { scv[j] = (f32x4){0.f, 0.f, 0.f, 0.f}; shv[j] = scv[j]; }
    for (int m = rbeg + F.wave; m < rend; m += NWAVES) {
        GAS unsigned long long* o8 = (GAS unsigned long long*)(XN + (size_t)m * DM) + F.lane;
        if (m >= MALL) {
#pragma unroll
            for (int j = 0; j < 4; ++j) o8[64 * j] = 0ull;
            continue;
        }
        f32x4 v[4];
#pragma unroll
        for (int j = 0; j < 4; ++j) v[j] = nx[j];
        const int mn = m + NWAVES;
        if (mn < MALL && mn < rend) { const f32x4* xr = (const f32x4*)xn_src_row(F, mn) + F.lane;
#pragma unroll
            for (int j = 0; j < 4; ++j) nx[j] = __builtin_nontemporal_load(xr + 64 * j); }
        const int mr = m < MP ? (m >> 12) : 4 + (m - MP);
        if (mr != mr_c) {
            const f32x4* sh = (const f32x4*)(mod + (size_t)mr * 3072) + F.lane; const f32x4* sc = sh + 256;
#pragma unroll
            for (int j = 0; j < 4; ++j) { scv[j] = sc[64 * j] + 1.0f; shv[j] = sh[64 * j]; }
            mr_c = mr;
        }
        float s = 0.f;
#pragma unroll
        for (int j = 0; j < 4; ++j) s += (v[j].x * v[j].x + v[j].y * v[j].y) + (v[j].z * v[j].z + v[j].w * v[j].w);
        const float rstd = 1.0f / sqrtf(wave_sum(s) * (1.f / DM) + EPSN);
        unsigned long long ov[4];
#pragma unroll
        for (int j = 0; j < 4; ++j) {
            const f32x4 y = v[j] * rstd * gvec[j] * scv[j] + shv[j];
            ov[j] = (unsigned long long)pk2(y.x, y.y) | ((unsigned long long)pk2(y.z, y.w) << 32);
        }
#pragma unroll
        for (int j = 0; j < 4; ++j) o8[64 * j] = ov[j];
    }
}

struct EpiZ {
    static constexpr bool PERM = true, HAS_MID = false;
    unsigned char* ws; float* out; const float* qg; const float* kg;
    __device__ __forceinline__ void mid(pg8::f32x4 (&)[2][2][4][2], const pg8::Unit&, int, int, int, int) const {}
    __device__ __forceinline__ void operator()(const pg8::f32x4 (&acc)[2][2][4][2], const pg8::Unit& u, int wr, int wc, int fr, int fq) const {
        asm volatile("" : "+v"(fr), "+v"(fq));
        const int pn = u.pn, pm = u.pm;
        const int rloc = wr * 64 + fr;
        const size_t row0 = (size_t)pm * 256 + rloc;
        if (pn < 5) {
            const bool isq = pn < 4;
            const float* gsrc = (isq ? qg : kg) + 8 * fq;
            f32x4 gv[2][2];
#pragma unroll
            for (int bj = 0; bj < 2; ++bj)
#pragma unroll
                for (int n = 0; n < 2; ++n) gv[bj][n] = *(const f32x4*)(gsrc + 32 * bj + 4 * n);
            const float sc = isq ? QSCALE : 1.0f;
            bf16* dst; int ld, colb;
            if (isq) { dst = (pm < 64) ? (bf16*)(out + O_YP) + QM_OFF + row0 * DM : (bf16*)(ws + WS_QT) + (size_t)rloc * DM; ld = DM; colb = (4 * pn + wc) * 64 + 8 * fq; }
            else { dst = (bf16*)(ws + WS_K) + row0 * 256; ld = 256; colb = wc * 64 + 8 * fq; }
#pragma unroll
            for (int ai = 0; ai < 2; ++ai)
#pragma unroll
                for (int m = 0; m < 4; ++m) {
                    float ss = 0.f;
#pragma unroll
                    for (int bj = 0; bj < 2; ++bj)
#pragma unroll
                        for (int n = 0; n < 2; ++n) { const f32x4 x = acc[ai][bj][m][n]; ss += (x[0] * x[0] + x[1] * x[1]) + (x[2] * x[2] + x[3] * x[3]); }
                    ss += __shfl_xor(ss, 16); ss += __shfl_xor(ss, 32);
                    const float rs = sc / sqrtf(ss * (1.0f / 64.0f) + EPSN);
                    bf16* rp = dst + (size_t)(ai * 128 + m * 16) * ld + colb;
#pragma unroll
                    for (int bj = 0; bj < 2; ++bj) {
                        const f32x4 v0 = acc[ai][bj][m][0] * rs * gv[bj][0], v1 = acc[ai][bj][m][1] * rs * gv[bj][1];
                        v4u w; w.x = pg8::cvt_pk_bf16(v0[0], v0[1]); w.y = pg8::cvt_pk_bf16(v0[2], v0[3]); w.z = pg8::cvt_pk_bf16(v1[0], v1[1]); w.w = pg8::cvt_pk_bf16(v1[2], v1[3]);
                        *(v4u*)(rp + 32 * bj) = w;
                        if (!isq) {
                            float* so = nullptr;
                            if (pm < 64 && (pm & 15) == 15 && ai == 1) so = out + O_KWP + ((size_t)(pm >> 4) * 128 + (wr * 64 + m * 16 + fr)) * 256;
                            else if (pm == 64 && ai == 0) so = (float*)(ws + WS_KVNEW) + (size_t)(wr * 64 + m * 16 + fr) * 256;
                            if (so) { so += wc * 64 + 32 * bj + 8 * fq; *(f32x4*)so = v0; *(f32x4*)(so + 4) = v1; }
                        }
                    }
                }
            return;
        }
        if (pn == 5) {
            bf16* dst = (bf16*)(ws + WS_V) + row0 * 256 + 32 * wc + 8 * fq;
#pragma unroll
            for (int ai = 0; ai < 2; ++ai)
#pragma unroll
                for (int m = 0; m < 4; ++m)
#pragma unroll
                    for (int bj = 0; bj < 2; ++bj) {
                        const f32x4 v0 = acc[ai][bj][m][0], v1 = acc[ai][bj][m][1];
                        v4u w; w.x = pg8::cvt_pk_bf16(v0[0], v0[1]); w.y = pg8::cvt_pk_bf16(v0[2], v0[3]); w.z = pg8::cvt_pk_bf16(v1[0], v1[1]); w.w = pg8::cvt_pk_bf16(v1[2], v1[3]);
                        *(v4u*)(dst + (size_t)(ai * 128 + m * 16) * 256 + 128 * bj) = w;
                        float* so = nullptr;
                        if (pm < 64 && (pm & 15) == 15 && ai == 1) so = out + O_VWP + ((size_t)(pm >> 4) * 128 + (wr * 64 + m * 16 + fr)) * 256;
                        else if (pm == 64 && ai == 0) so = (float*)(ws + WS_KVNEW) + 128 * 256 + (size_t)(wr * 64 + m * 16 + fr) * 256;
                        if (so) { so += 128 * bj + 32 * wc + 8 * fq; *(f32x4*)so = v0; *(f32x4*)(so + 4) = v1; }
                    }
            return;
        }
        if (pn < 18) {
            const int seg = (pn - 6) >> 2;
            const int colt = ((pn - 6) & 3) * 256 + 32 * wc + 8 * fq;
            bf16* dst = (bf16*)(ws + (seg == 0 ? WS_SGA : seg == 1 ? WS_XR : WS_SGR)) + row0 * DM + colt;
#pragma unroll
            for (int ai = 0; ai < 2; ++ai)
#pragma unroll
                for (int m = 0; m < 4; ++m)
#pragma unroll
                    for (int bj = 0; bj < 2; ++bj) {
                        f32x4 v0 = acc[ai][bj][m][0], v1 = acc[ai][bj][m][1];
                        if (seg != 1) {
#pragma unroll
                            for (int e = 0; e < 4; ++e) { v0[e] = v0[e] * sigm(v0[e]); v1[e] = v1[e] * sigm(v1[e]); }
                        }
                        v4u w; w.x = pg8::cvt_pk_bf16(v0[0], v0[1]); w.y = pg8::cvt_pk_bf16(v0[2], v0[3]); w.z = pg8::cvt_pk_bf16(v1[0], v1[1]); w.w = pg8::cvt_pk_bf16(v1[2], v1[3]);
                        *(v4u*)(dst + (size_t)(ai * 128 + m * 16) * DM + 128 * bj) = w;
                        if (seg == 1 && pm < 64 && (pm & 15) == 15 && ai == 1 && wr == 1 && m == 3 && fr >= 13) {
                            float* so = out + O_CVP + ((size_t)(pm >> 4) * 3 + (fr - 13)) * DM + colt + 128 * bj;
                            *(f32x4*)so = v0; *(f32x4*)(so + 4) = v1;
                        }
                    }
            return;
        }
        {
            const int colt = (pn - 18) * 128 + 32 * wc + 8 * fq;
            unsigned char* da = ws + WS_RAT + row0 * DM + colt; unsigned char* ds = ws + WS_SMR + row0 * DM + colt;
#pragma unroll
            for (int ai = 0; ai < 2; ++ai)
#pragma unroll
                for (int m = 0; m < 4; ++m) {
                    float sa[8], sm[8];
#pragma unroll
                    for (int n = 0; n < 2; ++n)
#pragma unroll
                        for (int e = 0; e < 4; ++e) { sa[4 * n + e] = sigm(acc[ai][0][m][n][e]); sm[4 * n + e] = sigm(acc[ai][1][m][n][e]); }
                    v2u w; w.x = pk_u8x4(sa[0], sa[1], sa[2], sa[3]); w.y = pk_u8x4(sa[4], sa[5], sa[6], sa[7]);
                    *(v2u*)(da + (size_t)(ai * 128 + m * 16) * DM) = w;
                    w.x = pk_u8x4(sm[0], sm[1], sm[2], sm[3]); w.y = pk_u8x4(sm[4], sm[5], sm[6], sm[7]);
                    *(v2u*)(ds + (size_t)(ai * 128 + m * 16) * DM) = w;
                }
        }
    }
};

struct EpiMerge {
    static constexpr bool PERM = true, HAS_MID = true;
    const unsigned char* sma; const unsigned char* smr; bf16* mg;
    __device__ __forceinline__ void mid(pg8::f32x4 (&acc)[2][2][4][2], const pg8::Unit& u, int wr, int wc, int fr, int fq) const {
        asm volatile("" : "+v"(fr), "+v"(fq));
        const size_t off = ((size_t)u.pm * 256 + wr * 64 + fr) * DM + u.pn * 256 + 32 * wc + 8 * fq;
        v2u ga[16], gr[16];
#pragma unroll
        for (int ai = 0; ai < 2; ++ai)
#pragma unroll
            for (int m = 0; m < 4; ++m)
#pragma unroll
                for (int bj = 0; bj < 2; ++bj) {
                    const size_t o = off + (size_t)(ai * 128 + m * 16) * DM + 128 * bj;
                    ga[(ai * 4 + m) * 2 + bj] = *(const v2u*)(sma + o); gr[(ai * 4 + m) * 2 + bj] = *(const v2u*)(smr + o);
                }
        __builtin_amdgcn_sched_barrier(0);
#pragma unroll
        for (int ai = 0; ai < 2; ++ai)
#pragma unroll
            for (int m = 0; m < 4; ++m)
#pragma unroll
                for (int bj = 0; bj < 2; ++bj) {
                    const v2u a = ga[(ai * 4 + m) * 2 + bj], r = gr[(ai * 4 + m) * 2 + bj];
                    acc[ai][bj][m][0] *= (pg8::f32x4){u8f(a.x, 0) * frcp(u8f(r.x, 0)), u8f(a.x, 1) * frcp(u8f(r.x, 1)), u8f(a.x, 2) * frcp(u8f(r.x, 2)), u8f(a.x, 3) * frcp(u8f(r.x, 3))};
                    acc[ai][bj][m][1] *= (pg8::f32x4){u8f(a.y, 0) * frcp(u8f(r.y, 0)), u8f(a.y, 1) * frcp(u8f(r.y, 1)), u8f(a.y, 2) * frcp(u8f(r.y, 2)), u8f(a.y, 3) * frcp(u8f(r.y, 3))};
                }
    }
    __device__ __forceinline__ void operator()(const pg8::f32x4 (&acc)[2][2][4][2], const pg8::Unit& u, int wr, int wc, int fr, int fq) const {
        asm volatile("" : "+v"(fr), "+v"(fq));
        const size_t off = ((size_t)u.pm * 256 + wr * 64 + fr) * DM + u.pn * 256 + 32 * wc + 8 * fq;
        const float i255 = 1.0f / 255.0f;
        v2u gr[16];
#pragma unroll
        for (int ai = 0; ai < 2; ++ai)
#pragma unroll
            for (int m = 0; m < 4; ++m)
#pragma unroll
                for (int bj = 0; bj < 2; ++bj) gr[(ai * 4 + m) * 2 + bj] = *(const v2u*)(smr + off + (size_t)(ai * 128 + m * 16) * DM + 128 * bj);
        __builtin_amdgcn_sched_barrier(0);
#pragma unroll
        for (int ai = 0; ai < 2; ++ai)
#pragma unroll
            for (int m = 0; m < 4; ++m)
#pragma unroll
                for (int bj = 0; bj < 2; ++bj) {
                    const size_t o = off + (size_t)(ai * 128 + m * 16) * DM + 128 * bj;
                    const v2u r = gr[(ai * 4 + m) * 2 + bj];
                    const pg8::f32x4 v0 = acc[ai][bj][m][0] * ((pg8::f32x4){u8f(r.x, 0), u8f(r.x, 1), u8f(r.x, 2), u8f(r.x, 3)} * i255);
                    const pg8::f32x4 v1 = acc[ai][bj][m][1] * ((pg8::f32x4){u8f(r.y, 0), u8f(r.y, 1), u8f(r.y, 2), u8f(r.y, 3)} * i255);
                    v4u w; w.x = pg8::cvt_pk_bf16(v0[0], v0[1]); w.y = pg8::cvt_pk_bf16(v0[2], v0[3]); w.z = pg8::cvt_pk_bf16(v1[0], v1[1]); w.w = pg8::cvt_pk_bf16(v1[2], v1[3]);
                    *(v4u*)(mg + o) = w;
                }
    }
};
struct EpiOut {
    static constexpr bool PERM = false, HAS_MID = false;
    const float* x; const float* mod; float* y;
    __device__ __forceinline__ void mid(pg8::f32x4 (&)[2][2][4][2], const pg8::Unit&, int, int, int, int) const {}
    __device__ __forceinline__ void operator()(const pg8::f32x4 (&acc)[2][2][4][2], const pg8::Unit& u, int wr, int wc, int fr, int fq) const {
        asm volatile("" : "+v"(fr), "+v"(fq));
        const int col0 = u.pn * 256 + wc * 32 + 4 * fq;
        const float* gp = mod + (size_t)(u.pm >> 4) * 3072 + 2048 + col0;
        f32x4 gv[2][2];
#pragma unroll
        for (int bj = 0; bj < 2; ++bj)
#pragma unroll
            for (int n = 0; n < 2; ++n) gv[bj][n] = *(const f32x4*)(gp + 128 * bj + 16 * n);
#pragma unroll
        for (int ai = 0; ai < 2; ++ai) {
            f32x4 xv[4][2][2];
#pragma unroll
            for (int m = 0; m < 4; ++m) {
                const size_t off = ((size_t)u.pm * 256 + ai * 128 + wr * 64 + m * 16 + fr) * DM + col0;
#pragma unroll
                for (int bj = 0; bj < 2; ++bj)
#pragma unroll
                    for (int n = 0; n < 2; ++n) xv[m][bj][n] = __builtin_nontemporal_load((const f32x4*)(x + off + 128 * bj + 16 * n));
            }
            __builtin_amdgcn_sched_barrier(0);
#pragma unroll
            for (int m = 0; m < 4; ++m) {
                const size_t off = ((size_t)u.pm * 256 + ai * 128 + wr * 64 + m * 16 + fr) * DM + col0;
#pragma unroll
                for (int bj = 0; bj < 2; ++bj)
#pragma unroll
                    for (int n = 0; n < 2; ++n) __builtin_nontemporal_store(xv[m][bj][n] + gv[bj][n] * acc[ai][bj][m][n], (f32x4*)(y + off + 128 * bj + 16 * n));
            }
            __builtin_amdgcn_sched_barrier(0);
        }
    }
};

template <int KQ  >
__device__ __forceinline__ f32x4 mini_partial(const bf16* A, const bf16* B) {
    bf16x8 a[KQ], b[KQ];
#pragma unroll
    for (int ks = 0; ks < KQ; ++ks) { a[ks] = *(const bf16x8*)(A + 32 * ks); b[ks] = *(const bf16x8*)(B + 32 * ks); }
    f32x4 acc = (f32x4){0.f, 0.f, 0.f, 0.f};
#pragma unroll
    for (int ks = 0; ks < KQ; ++ks) acc = __builtin_amdgcn_mfma_f32_16x16x32_bf16(a[ks], b[ks], acc, 0, 0, 0);
    return acc;
}
__device__ __forceinline__ void mini_merge_block(Frame& F, int pair) {
    const int lane = F.lane, w = F.wave, tile = 2 * pair + (w >> 2), kq = w & 3, rt = tile >> 6, ct = tile & 63;
    const bf16* A = (const bf16*)(F.ws + WS_YT) + (size_t)(16 * rt + (lane & 15)) * 2048 + 8 * (lane >> 4) + 512 * kq;
    const bf16* B = (const bf16*)(F.ws + WS_WPP) + (size_t)(16 * ct + (lane & 15)) * 2048 + 8 * (lane >> 4) + 512 * kq;
    const f32x4 acc = mini_partial<16>(A, B);
    LAS float* part = (LAS float*)F.lds;
#pragma unroll
    for (int r = 0; r < 4; ++r) part[w * 256 + (4 * (lane >> 4) + r) * 16 + (lane & 15)] = acc[r];
    __syncthreads();
    {
        const int t2 = F.tid >> 8, e = F.tid & 255, row = e >> 4, col = e & 15, tl = 2 * pair + t2, rl = 16 * (tl >> 6) + row, cg = 16 * (tl & 63) + col;
        const LAS float* p = part + t2 * 1024 + e;
        const float sa_ = (float)(F.ws + WS_RAT)[(size_t)(MP + rl) * DM + cg], sr_ = (float)(F.ws + WS_SMR)[(size_t)(MP + rl) * DM + cg];
        const float rat = sa_ / sr_, sm = sr_ * (1.0f / 255.0f);
        const float v = ((p[0] + p[256]) * rat + (p[512] + p[768])) * sm;
        ((bf16*)(F.ws + WS_MGT))[(size_t)rl * DM + cg] = (bf16)f2bf(v);
    }
    __syncthreads();
}
__device__ __forceinline__ void mini_out_block(Frame& F, int pair) {
    const int lane = F.lane, w = F.wave, tile = 2 * pair + (w >> 2), kq = w & 3, rt = tile >> 6, ct = tile & 63;
    const bf16* A = (const bf16*)(F.ws + WS_MGT) + (size_t)(16 * rt + (lane & 15)) * DM + 8 * (lane >> 4) + 256 * kq;
    const bf16* B = (const bf16*)(F.ws + WS_WOUT) + (size_t)(16 * ct + (lane & 15)) * DM + 8 * (lane >> 4) + 256 * kq;
    const f32x4 acc = mini_partial<8>(A, B);
    LAS float* part = (LAS float*)F.lds;
#pragma unroll
    for (int r = 0; r < 4; ++r) part[w * 256 + (4 * (lane >> 4) + r) * 16 + (lane & 15)] = acc[r];
    __syncthreads();
    {
        const int t2 = F.tid >> 8, e = F.tid & 255, row = e >> 4, col = e & 15, tl = 2 * pair + t2, rl = 16 * (tl >> 6) + row, cg = 16 * (tl & 63) + col;
        const LAS float* p = part + t2 * 1024 + e;
        const float* mod = (const float*)(F.ws + WS_MOD);
        F.out[O_YS + (size_t)rl * DM + cg] = F.in[I_XS][(size_t)rl * DM + cg] + mod[(size_t)(4 + rl) * 3072 + 2048 + cg] * ((p[0] + p[256]) + (p[512] + p[768]));
    }
    __syncthreads();
}

struct ChanConst { float w0, w1, w2, w3, bc, bra, brx, c1, nbra, nbrx; };
__device__ __forceinline__ ChanConst chan_const(Frame& F, int ch) {
    ChanConst c; const float* wc = F.in[I_WCONV];
    c.w0 = wc[ch]; c.w1 = wc[DM + ch]; c.w2 = wc[2 * DM + ch]; c.w3 = wc[3 * DM + ch]; c.bc = F.in[I_BCONV][ch];
    c.bra = F.in[I_BRA][ch]; c.brx = F.in[I_BRX][ch];
    c.c1 = -8.0f * log1pf(expf(-F.in[I_LAM][ch])) * LOG2E;
    c.nbra = -LOG2E * c.bra; c.nbrx = -LOG2E * c.brx;
    return c;
}
__device__ __forceinline__ void sample_rnn_unit(Frame& F, int bs, int j);
__device__ __forceinline__ void stage_gate_weights(Frame& F, int j) {
    for (int cidx = F.tid; cidx < 1024; cidx += NWAVES * 64) {
        const int gsel = cidx >> 9, row = (cidx >> 3) & 63, c8 = cidx & 7;
        const v4u v = *(const v4u*)((const bf16*)(F.ws + (gsel ? WS_WRX : WS_WRA)) + j * 4096 + row * 64 + 8 * c8);
        *(LAS v4u*)(F.lds + GW_OFF + (gsel * 64 + row) * GW_STRIDE + 16 * c8) = v;
    }
}
template <int PASS>
__device__ __forceinline__ void scan_unit(Frame& F, int b, int c, int j, LAS unsigned char* wl) {
    const int lane = F.lane, r32 = lane & 31, hi = lane >> 5, ch = 64 * j + lane;
    const ChanConst cc = chan_const(F, ch);
    const bf16* XR = (const bf16*)(F.ws + WS_XR); const bf16* SGR = (const bf16*)(F.ws + WS_SGR);
    float* agg = (float*)(F.ws + WS_AGG);
    bf16* YM = (bf16*)(F.out + O_YP);
    LAS bf16* xt = (LAS bf16*)wl; LAS bf16* st = (LAS bf16*)(wl + 4096); LAS float* gt = (LAS float*)(wl + 8192);
    const size_t rowb = (size_t)b * SEQ + 128 * c;
    const int lrow = lane >> 3, lc8 = lane & 7;
    const bf16* xsrc = XR + (rowb + lrow) * DM + 64 * j + 8 * lc8;
    const bf16* ssrc = SGR + (rowb + lrow) * DM + 64 * j + 8 * lc8;
    v4u xn[4], sn[4];
#pragma unroll
    for (int i = 0; i < 4; ++i) { xn[i] = *(const v4u*)(xsrc + (size_t)(8 * i) * DM); if (PASS == 2) sn[i] = *(const v4u*)(ssrc + (size_t)(8 * i) * DM); }
    float xm3 = 0.f, xm2 = 0.f, xm1 = 0.f;
    if (c > 0) { xm3 = bf2f(XR[(rowb - 3) * DM + ch]); xm2 = bf2f(XR[(rowb - 2) * DM + ch]); xm1 = bf2f(XR[(rowb - 1) * DM + ch]); }
    float h = 0.f, ap = 1.f;
    if (PASS == 2) {
        for (int q = 0; q < c; ++q) { const float a = agg[((size_t)(b * NCH + q) * 2 + 0) * DM + ch], hl = agg[((size_t)(b * NCH + q) * 2 + 1) * DM + ch]; h = a * h + hl; }
    }
    const LAS unsigned char* gwr = F.lds + GW_OFF + r32 * GW_STRIDE + 16 * hi;
    for (int sc = 0; sc < 4; ++sc) {
        const size_t r0 = rowb + 32 * sc;
#pragma unroll
        for (int i = 0; i < 4; ++i) { *(LAS v4u*)(xt + (lrow + 8 * i) * 64 + 8 * lc8) = xn[i]; if (PASS == 2) *(LAS v4u*)(st + (lrow + 8 * i) * 64 + 8 * lc8) = sn[i]; }
        if (sc < 3) {
#pragma unroll
            for (int i = 0; i < 4; ++i) { xn[i] = *(const v4u*)(xsrc + (size_t)(32 * (sc + 1) + 8 * i) * DM); if (PASS == 2) sn[i] = *(const v4u*)(ssrc + (size_t)(32 * (sc + 1) + 8 * i) * DM); }
        }
        LDS_WAIT(); asm volatile("" ::: "memory");
        float xc[32];
#pragma unroll
        for (int t = 0; t < 32; ++t) {
            const float x = bf2f(xt[t * 64 + lane]);
            xc[t] = cc.bc + cc.w0 * xm3 + cc.w1 * xm2 + cc.w2 * xm1 + cc.w3 * x;
            xm3 = xm2; xm2 = xm1; xm1 = x;
            xt[t * 64 + lane] = (bf16)pg8::cvt_pk_bf16(xc[t], 0.f);
        }
        LDS_WAIT(); asm volatile("" ::: "memory");
        bf16x8 af[4];
#pragma unroll
        for (int d0 = 0; d0 < 4; ++d0) af[d0] = *(const LAS bf16x8*)(xt + r32 * 64 + 16 * d0 + 8 * hi);
        float zr[32];
#pragma unroll
        for (int oh = 0; oh < 2; ++oh) {
            f32x16 d = {};
#pragma unroll
            for (int d0 = 0; d0 < 4; ++d0) d = __builtin_amdgcn_mfma_f32_32x32x16_bf16(af[d0], *(const LAS bf16x8*)(gwr + (32 * oh) * GW_STRIDE + 32 * d0), d, 0, 0, 0);
#pragma unroll
            for (int r = 0; r < 16; ++r) gt[((r & 3) + 8 * (r >> 2) + 4 * hi) * 64 + 32 * oh + r32] = d[r];
        }
        LDS_WAIT(); asm volatile("" ::: "memory");
#pragma unroll
        for (int t = 0; t < 32; ++t) zr[t] = gt[t * 64 + lane];
        LDS_WAIT(); asm volatile("" ::: "memory");
#pragma unroll
        for (int oh = 0; oh < 2; ++oh) {
            f32x16 d = {};
#pragma unroll
            for (int d0 = 0; d0 < 4; ++d0) d = __builtin_amdgcn_mfma_f32_32x32x16_bf16(af[d0], *(const LAS bf16x8*)(gwr + (64 + 32 * oh) * GW_STRIDE + 32 * d0), d, 0, 0, 0);
#pragma unroll
            for (int r = 0; r < 16; ++r) gt[((r & 3) + 8 * (r >> 2) + 4 * hi) * 64 + 32 * oh + r32] = d[r];
        }
        LDS_WAIT(); asm volatile("" ::: "memory");
#pragma unroll
        for (int t = 0; t < 32; ++t) {
            const float zi = gt[t * 64 + lane];
            const float rg = frcp(1.0f + fexp2(__builtin_fmaf(zr[t], -LOG2E, cc.nbra))), ig = frcp(1.0f + fexp2(__builtin_fmaf(zi, -LOG2E, cc.nbrx)));
            const float a = fexp2(cc.c1 * rg);
            const float s = __builtin_amdgcn_sqrtf(__builtin_fmaf(-a, a, 1.0f));
            const float uu = s * ig * xc[t];
            h = a * h + uu;
            if (PASS == 1) ap *= a;
            if (PASS == 2) st[t * 64 + lane] = (bf16)pg8::cvt_pk_bf16(h * bf2f(st[t * 64 + lane]), 0.f);
        }
        LDS_WAIT(); asm volatile("" ::: "memory");
        if (PASS == 2) {
#pragma unroll
            for (int i = 0; i < 4; ++i) *(v4u*)(YM + (r0 + lrow + 8 * i) * DM + 64 * j + 8 * lc8) = *(const LAS v4u*)(st + (lrow + 8 * i) * 64 + 8 * lc8);
            LDS_WAIT(); asm volatile("" ::: "memory");
        }
    }
    if (PASS == 1) { st_sc1(&agg[((size_t)(b * NCH + c) * 2 + 0) * DM + ch], ap); st_sc1(&agg[((size_t)(b * NCH + c) * 2 + 1) * DM + ch], h); }
    if (PASS == 2 && c == NCH - 1) F.out[O_HP + (size_t)b * DM + ch] = h;
}
typedef GAS unsigned long long gu64;
__device__ __forceinline__ void gr_store(unsigned long long* g, float v) { __hip_atomic_store(g, (1ull << 32) | (unsigned long long)__float_as_uint(v), __ATOMIC_RELAXED, __HIP_MEMORY_SCOPE_AGENT); }
__device__ __forceinline__ unsigned long long gr_load(unsigned long long* g) { return __hip_atomic_load(g, __ATOMIC_RELAXED, __HIP_MEMORY_SCOPE_AGENT); }
__device__ __forceinline__ void scan_lb_block(Frame& F, int bu) {
    const int j = bu & 15, ib = (bu >> 4) & 3, b = bu >> 6, w = F.wave, q = 8 * ib + w;
    stage_gate_weights(F, j);
    LDS_WAIT(); __syncthreads();
    sample_rnn_unit(F, (bu >> 4) * 8 + w, j);
    const int lane = F.lane, r32 = lane & 31, hi = lane >> 5, ch = 64 * j + lane;
    LAS unsigned char* wl = F.lds + w * 16384;
    const ChanConst cc = chan_const(F, ch);
    const bf16* XR = (const bf16*)(F.ws + WS_XR); const bf16* SGR = (const bf16*)(F.ws + WS_SGR);
    bf16* YM = (bf16*)(F.out + O_YP);
    LAS bf16* xt = (LAS bf16*)wl; LAS bf16* st = (LAS bf16*)(wl + 4096); LAS float* gt = (LAS float*)(wl + 8192);
    LAS float* xch = (LAS float*)(F.lds + BT_OFF);
    unsigned long long* lba = (unsigned long long*)(F.ws + WS_LBA) + ((size_t)(b * 16 + j) * 16) * 128 + lane;
    unsigned long long* lbh = (unsigned long long*)(F.ws + WS_LBH) + ((size_t)(b * 16 + j) * 4) * 64 + lane;
    const int lrow = lane >> 3, lc8 = lane & 7;
    const size_t row0 = (size_t)b * SEQ + 32 * q;
    const bf16* xsrc = XR + (row0 + lrow) * DM + 64 * j + 8 * lc8;
    const bf16* ssrc = SGR + (row0 + lrow) * DM + 64 * j + 8 * lc8;
    v4u xn[4], sn[4];
#pragma unroll
    for (int i = 0; i < 4; ++i) { xn[i] = __builtin_nontemporal_load((const v4u*)(xsrc + (size_t)(8 * i) * DM)); sn[i] = __builtin_nontemporal_load((const v4u*)(ssrc + (size_t)(8 * i) * DM)); }
    float hx3 = 0.f, hx2 = 0.f, hx1 = 0.f;
    if (q > 0) { hx3 = bf2f(XR[(row0 - 3) * DM + ch]); hx2 = bf2f(XR[(row0 - 2) * DM + ch]); hx1 = bf2f(XR[(row0 - 1) * DM + ch]); }
    const LAS unsigned char* gwr = F.lds + GW_OFF + r32 * GW_STRIDE + 16 * hi;
    for (int r = 0; r < 4; ++r) {
        const size_t r0 = row0 + 1024 * r;
#pragma unroll
        for (int i = 0; i < 4; ++i) { *(LAS v4u*)(xt + (lrow + 8 * i) * 64 + 8 * lc8) = xn[i]; *(LAS v4u*)(st + (lrow + 8 * i) * 64 + 8 * lc8) = sn[i]; }
        float xm3 = hx3, xm2 = hx2, xm1 = hx1;
        if (r < 3) {
#pragma unroll
            for (int i = 0; i < 4; ++i) { xn[i] = __builtin_nontemporal_load((const v4u*)(xsrc + (size_t)(1024 * (r + 1) + 8 * i) * DM)); sn[i] = __builtin_nontemporal_load((const v4u*)(ssrc + (size_t)(1024 * (r + 1) + 8 * i) * DM)); }
            hx3 = bf2f(XR[(r0 + 1024 - 3) * DM + ch]); hx2 = bf2f(XR[(r0 + 1024 - 2) * DM + ch]); hx1 = bf2f(XR[(r0 + 1024 - 1) * DM + ch]);
        }
        LDS_WAIT(); asm volatile("" ::: "memory");
        float xc[32];
#pragma unroll
        for (int t = 0; t < 32; ++t) {
            const float x = bf2f(xt[t * 64 + lane]);
            xc[t] = cc.bc + cc.w0 * xm3 + cc.w1 * xm2 + cc.w2 * xm1 + cc.w3 * x;
            xm3 = xm2; xm2 = xm1; xm1 = x;
            xt[t * 64 + lane] = (bf16)pg8::cvt_pk_bf16(xc[t], 0.f);
        }
        LDS_WAIT(); asm volatile("" ::: "memory");
        bf16x8 af[4];
#pragma unroll
        for (int d0 = 0; d0 < 4; ++d0) af[d0] = *(const LAS bf16x8*)(xt + r32 * 64 + 16 * d0 + 8 * hi);
        float av[32], uv[32];
#pragma unroll
        for (int oh = 0; oh < 2; ++oh) {
            f32x16 d = {};
#pragma unroll
            for (int d0 = 0; d0 < 4; ++d0) d = __builtin_amdgcn_mfma_f32_32x32x16_bf16(af[d0], *(const LAS bf16x8*)(gwr + (32 * oh) * GW_STRIDE + 32 * d0), d, 0, 0, 0);
#pragma unroll
            for (int g4 = 0; g4 < 4; ++g4) *(LAS f32x4*)(gt + (32 * oh + r32) * 32 + (((2 * g4 + hi) ^ (((32 * oh + r32) >> 1) & 7)) << 2)) = (f32x4){d[4 * g4], d[4 * g4 + 1], d[4 * g4 + 2], d[4 * g4 + 3]};
        }
        LDS_WAIT(); asm volatile("" ::: "memory");
#pragma unroll
        for (int c = 0; c < 8; ++c) { const f32x4 v4 = *(const LAS f32x4*)(gt + lane * 32 + ((c ^ ((lane >> 1) & 7)) << 2)); av[4 * c] = v4[0]; av[4 * c + 1] = v4[1]; av[4 * c + 2] = v4[2]; av[4 * c + 3] = v4[3]; }
        LDS_WAIT(); asm volatile("" ::: "memory");
#pragma unroll
        for (int oh = 0; oh < 2; ++oh) {
            f32x16 d = {};
#pragma unroll
            for (int d0 = 0; d0 < 4; ++d0) d = __builtin_amdgcn_mfma_f32_32x32x16_bf16(af[d0], *(const LAS bf16x8*)(gwr + (64 + 32 * oh) * GW_STRIDE + 32 * d0), d, 0, 0, 0);
#pragma unroll
            for (int g4 = 0; g4 < 4; ++g4) *(LAS f32x4*)(gt + (32 * oh + r32) * 32 + (((2 * g4 + hi) ^ (((32 * oh + r32) >> 1) & 7)) << 2)) = (f32x4){d[4 * g4], d[4 * g4 + 1], d[4 * g4 + 2], d[4 * g4 + 3]};
        }
        LDS_WAIT(); asm volatile("" ::: "memory");
        float hl = 0.f, ap = 1.f;
        typedef float f2 __attribute__((ext_vector_type(2)));
#pragma unroll
        for (int c = 0; c < 8; ++c) {
            const f32x4 z4 = *(const LAS f32x4*)(gt + lane * 32 + ((c ^ ((lane >> 1) & 7)) << 2));
#pragma unroll
            for (int p = 0; p < 2; ++p) {
                const int t = 4 * c + 2 * p;
                const f2 zr2 = {av[t], av[t + 1]}, zi2 = {z4[2 * p], z4[2 * p + 1]}, xc2 = {xc[t], xc[t + 1]};
                f2 er = zr2 * (-LOG2E) + cc.nbra, ei = zi2 * (-LOG2E) + cc.nbrx;
                er = (f2){fexp2(er.x), fexp2(er.y)} + 1.0f; ei = (f2){fexp2(ei.x), fexp2(ei.y)} + 1.0f;
                const f2 rg = {frcp(er.x), frcp(er.y)}, ig = {frcp(ei.x), frcp(ei.y)};
                const f2 la = rg * cc.c1;
                const f2 a2 = {fexp2(la.x), fexp2(la.y)};
                const f2 om = 1.0f - a2 * a2;
                const f2 sq = {__builtin_amdgcn_sqrtf(om.x), __builtin_amdgcn_sqrtf(om.y)};
                const f2 u2 = sq * ig * xc2;
                av[t] = a2.x; av[t + 1] = a2.y; uv[t] = u2.x; uv[t + 1] = u2.y;
                hl = a2.x * hl + u2.x; hl = a2.y * hl + u2.y; ap *= a2.x * a2.y;
            }
        }
        LAS float* xw = xch + (r & 1) * 1024;
        xw[(w * 2 + 0) * 64 + lane] = ap; xw[(w * 2 + 1) * 64 + lane] = hl;
        LDS_WAIT(); __syncthreads();
        float pa = 1.f, ph = 0.f;
        for (int k = 0; k < w; ++k) { const float ak = xw[(k * 2 + 0) * 64 + lane], hk = xw[(k * 2 + 1) * 64 + lane]; ph = ak * ph + hk; pa = ak * pa; }
        if (w == 7 && ib < 3) { gr_store(lba + (size_t)(r * 4 + ib) * 128, ap * pa); gr_store(lba + (size_t)(r * 4 + ib) * 128 + 64, ap * ph + hl); }
        float hin = 0.f;
        {
            unsigned long long gh = (1ull << 32), ga[3] = {1ull << 32, 1ull << 32, 1ull << 32}, gb[3] = {1ull << 32, 1ull << 32, 1ull << 32};
            unsigned sp = 0;
            for (;;) {
                if (r > 0) gh = gr_load(lbh + (size_t)(r - 1) * 64);
#pragma unroll
                for (int k = 0; k < 3; ++k) if (k < ib) { ga[k] = gr_load(lba + (size_t)(r * 4 + k) * 128); gb[k] = gr_load(lba + (size_t)(r * 4 + k) * 128 + 64); }
                bool ok = (gh >> 32) == 1ull;
#pragma unroll
                for (int k = 0; k < 3; ++k) ok = ok && (ga[k] >> 32) == 1ull && (gb[k] >> 32) == 1ull;
                if (__all(ok)) break;
                __builtin_amdgcn_s_sleep(2);
                if (++sp > (1u << 20)) break;
            }
            if (r > 0) hin = __uint_as_float((unsigned)gh);
#pragma unroll
            for (int k = 0; k < 3; ++k) if (k < ib) hin = __uint_as_float((unsigned)ga[k]) * hin + __uint_as_float((unsigned)gb[k]);
            hin = pa * hin + ph;
        }
        float h = hin;
#pragma unroll
        for (int t = 0; t < 32; ++t) {
            h = av[t] * h + uv[t];
            st[t * 64 + lane] = (bf16)pg8::cvt_pk_bf16(h * bf2f(st[t * 64 + lane]), 0.f);
        }
        LDS_WAIT(); asm volatile("" ::: "memory");
#pragma unroll
        for (int i = 0; i < 4; ++i) *(v4u*)(YM + (r0 + lrow + 8 * i) * DM + 64 * j + 8 * lc8) = *(const LAS v4u*)(st + (lrow + 8 * i) * 64 + 8 * lc8);
        if (q == 31) { if (r < 3) gr_store(lbh + (size_t)r * 64, h); else F.out[O_HP + (size_t)b * DM + ch] = h; }
        LDS_WAIT(); asm volatile("" ::: "memory");
    }
    __syncthreads();
}
template <int PASS>
__device__ __forceinline__ void scan_block(Frame& F, int bu) {
    const int j = bu & 15, ub = (bu >> 4) * 8 + F.wave;
    stage_gate_weights(F, j);
    LDS_WAIT(); __syncthreads();
    if (PASS == 1) sample_rnn_unit(F, ub, j);
    scan_unit<PASS>(F, ub >> 5, ub & 31, j, F.lds + F.wave * 16384);
    __syncthreads();
}
__device__ __forceinline__ void sample_rnn_unit(Frame& F, int bs, int j) {
    const int lane = F.lane, ch = 64 * j + lane;
    const ChanConst cc = chan_const(F, ch);
    const float* scv = F.in[I_SC] + (size_t)bs * 3 * DM;
    const float x0 = scv[ch], x1 = scv[DM + ch], x2 = scv[2 * DM + ch];
    const float x3 = bf2f(((const bf16*)(F.ws + WS_XR))[(size_t)(MP + bs) * DM + ch]);
    const float h0 = F.in[I_SH][(size_t)bs * DM + ch];
    const float sg = bf2f(((const bf16*)(F.ws + WS_SGR))[(size_t)(MP + bs) * DM + ch]);
    const float xc = cc.bc + cc.w0 * x0 + cc.w1 * x1 + cc.w2 * x2 + cc.w3 * x3;
    const int xci = __float_as_int(xc);
    const LAS unsigned char* gw = F.lds + GW_OFF + lane * GW_STRIDE;
    float zr = 0.f, zi = 0.f;
#pragma unroll
    for (int k8 = 0; k8 < 8; ++k8) {
        const v4u wr4 = *(const LAS v4u*)(gw + 16 * k8), wi4 = *(const LAS v4u*)(gw + 64 * GW_STRIDE + 16 * k8);
        const unsigned wrw[4] = {wr4.x, wr4.y, wr4.z, wr4.w}, wiw[4] = {wi4.x, wi4.y, wi4.z, wi4.w};
#pragma unroll
        for (int e = 0; e < 4; ++e) {
            const float xa = __int_as_float(__builtin_amdgcn_readlane(xci, 8 * k8 + 2 * e)), xb = __int_as_float(__builtin_amdgcn_readlane(xci, 8 * k8 + 2 * e + 1));
            zr += xa * bflo(wrw[e]); zr += xb * bfhi(wrw[e]); zi += xa * bflo(wiw[e]); zi += xb * bfhi(wiw[e]);
        }
    }
    const float rg = sigm(zr + cc.bra), ig = sigm(zi + cc.brx);
    const float a = fexp2(cc.c1 * rg);
    const float sq = sqrtf(fmaxf(1.0f - a * a, 0.f));
    const float h = a * h0 + sq * ig * xc;
    F.out[O_HS + (size_t)bs * DM + ch] = h;
    float* cv = F.out + O_CVS + (size_t)bs * 3 * DM;
    cv[ch] = x1; cv[DM + ch] = x2; cv[2 * DM + ch] = x3;
    ((bf16*)(F.ws + WS_YT))[(size_t)bs * 2048 + 1024 + ch] = (bf16)f2bf(h * sg);
}

__device__ __forceinline__ float logit_bound(Frame& F) {
    float mq = fabsf(F.in[I_QG][F.lane]), mk = fabsf(F.in[I_KG][F.lane]), mb = 0.f;
#pragma unroll
    for (int i = 0; i < 8; ++i) mb = fmaxf(mb, fabsf(F.in[I_REL][F.lane + 64 * i]));
#pragma unroll
    for (int o = 1; o < 64; o <<= 1) { mq = fmaxf(mq, __shfl_xor(mq, o)); mk = fmaxf(mk, __shfl_xor(mk, o)); mb = fmaxf(mb, __shfl_xor(mb, o)); }
    return (8.0f * mq * mk + mb) * LOG2E;
}

__device__ __forceinline__ void build_bias_table(Frame& F) {
    LAS float* bt = (LAS float*)(F.lds + BT_OFF);
    float rv[4];
#pragma unroll
    for (int i = 0; i < 4; ++i) { const int e = F.tid + 512 * i; rv[i] = F.in[I_REL][rel_bucket(e & 127) * 16 + (e >> 7)]; }
#pragma unroll
    for (int i = 0; i < 4; ++i) bt[F.tid + 512 * i] = rv[i] * LOG2E;
}
__device__ __forceinline__ void sample_attn_block(Frame& F, int pair, float M0) {
    const int lane = F.lane, w = F.wave, u = 2 * pair + (w >> 2), bs = u >> 2, g = u & 3, kq = w & 3;
    const int dch = lane & 15, ksub = lane >> 4;
    const LAS float* bt = (const LAS float*)(F.lds + BT_OFF);
    LAS float* part = (LAS float*)F.lds;
    const bf16* QT = (const bf16*)(F.ws + WS_QT) + (size_t)bs * DM + g * 256;
    float q[4][4];
#pragma unroll
    for (int hh = 0; hh < 4; ++hh) { const v2u qq = *(const v2u*)(QT + hh * 64 + 4 * dch); q[hh][0] = bflo(qq.x); q[hh][1] = bfhi(qq.x); q[hh][2] = bflo(qq.y); q[hh][3] = bfhi(qq.y); }
    const float* ck = F.in[I_CK] + (((size_t)bs * 128 + 32 * kq + ksub) * 4 + g) * 64 + 4 * dch;
    const float* cv = F.in[I_CV] + (((size_t)bs * 128 + 32 * kq + ksub) * 4 + g) * 64 + 4 * dch;
    f32x4 kv[8], vv[8];
#pragma unroll
    for (int i = 0; i < 8; ++i) kv[i] = __builtin_nontemporal_load((const f32x4*)(ck + (size_t)i * 1024));
#pragma unroll
    for (int i = 0; i < 8; ++i) vv[i] = __builtin_nontemporal_load((const f32x4*)(cv + (size_t)i * 1024));
    float l[4] = {0.f, 0.f, 0.f, 0.f}; float o[4][4];
#pragma unroll
    for (int hh = 0; hh < 4; ++hh)
#pragma unroll
        for (int e = 0; e < 4; ++e) o[hh][e] = 0.f;
#pragma unroll
    for (int i = 0; i < 8; ++i) {
        const int key = 32 * kq + 4 * i + ksub;
#pragma unroll
        for (int hh = 0; hh < 4; ++hh) {
            float sdot = (kv[i][0] * q[hh][0] + kv[i][1] * q[hh][1]) + (kv[i][2] * q[hh][2] + kv[i][3] * q[hh][3]);
            sdot += __shfl_xor(sdot, 1); sdot += __shfl_xor(sdot, 2); sdot += __shfl_xor(sdot, 4); sdot += __shfl_xor(sdot, 8);
            const float ev = (key >= 1) ? fexp2(sdot + bt[(4 * g + hh) * 128 + ((128 - key) & 127)] - M0) : 0.f;
            l[hh] += ev;
#pragma unroll
            for (int e = 0; e < 4; ++e) o[hh][e] += ev * vv[i][e];
        }
    }
#pragma unroll
    for (int hh = 0; hh < 4; ++hh) {
        l[hh] += __shfl_xor(l[hh], 16); l[hh] += __shfl_xor(l[hh], 32);
#pragma unroll
        for (int e = 0; e < 4; ++e) { o[hh][e] += __shfl_xor(o[hh][e], 16); o[hh][e] += __shfl_xor(o[hh][e], 32); }
    }
    if (ksub == 0) {
#pragma unroll
        for (int hh = 0; hh < 4; ++hh) *(LAS f32x4*)(part + (w * 4 + hh) * 64 + 4 * dch) = (f32x4){o[hh][0], o[hh][1], o[hh][2], o[hh][3]};
    }
    if (lane < 4) part[8 * 256 + w * 4 + lane] = (lane == 0) ? l[0] : (lane == 1) ? l[1] : (lane == 2) ? l[2] : l[3];
    LDS_WAIT(); __syncthreads();
    if (kq == 0) {
        const float* kn = (const float*)(F.ws + WS_KVNEW) + (size_t)bs * 256 + g * 64; const float* vn = kn + 128 * 256;
        const float knew = kn[lane], vnew = vn[lane];
        const bf16* sga = (const bf16*)(F.ws + WS_SGA) + (size_t)(MP + bs) * DM + g * 256;
        bf16* yt = (bf16*)(F.ws + WS_YT) + (size_t)bs * 2048 + g * 256;
        float qh[4], sgv[4], snk[4];
#pragma unroll
        for (int hh = 0; hh < 4; ++hh) { qh[hh] = bf2f(QT[hh * 64 + lane]); sgv[hh] = bf2f(sga[hh * 64 + lane]); snk[hh] = F.in[I_SINK][4 * g + hh]; }
        float res[4];
#pragma unroll
        for (int hh = 0; hh < 4; ++hh) {
            float sn = qh[hh] * knew;
#pragma unroll
            for (int ofs = 1; ofs < 64; ofs <<= 1) sn += __shfl_xor(sn, ofs);
            const float en = fexp2(sn + bt[(4 * g + hh) * 128] - M0);
            float osum = 0.f, lsum = 0.f;
#pragma unroll
            for (int k4 = 0; k4 < 4; ++k4) { osum += part[((w + k4) * 4 + hh) * 64 + lane]; lsum += part[8 * 256 + (w + k4) * 4 + hh]; }
            const float den = lsum + en + fexp2(snk[hh] * LOG2E - M0);
            res[hh] = (osum + en * vnew) / den * sgv[hh];
        }
        F.out[O_KWS + (((size_t)bs * 128 + 127) * 4 + g) * 64 + lane] = knew; F.out[O_VWS + (((size_t)bs * 128 + 127) * 4 + g) * 64 + lane] = vnew;
#pragma unroll
        for (int hh = 0; hh < 4; ++hh) yt[hh * 64 + lane] = (bf16)f2bf(res[hh]);
    }
    LDS_WAIT(); __syncthreads();
}

constexpr int KT_STRIDE = 144;
constexpr int VT_STRIDE = 520;
constexpr int AT_K = 0, AT_V = 256 * KT_STRIDE, AT_T = AT_V + 64 * VT_STRIDE, AT_END = AT_T + 4 * 384 * 4;
static_assert(AT_END <= RING_BYTES, "attention LDS");
struct KVRegs { v4u k[4], v[4]; };
__device__ __forceinline__ void attn_load_kv(Frame& F, int b, int n, int g, KVRegs& r) {
    const bf16* Kb = (const bf16*)(F.ws + WS_K); const bf16* Vb = (const bf16*)(F.ws + WS_V);
    const long krow0 = (long)b * SEQ + 128 * (n - 1);
#pragma unroll
    for (int i = 0; i < 4; ++i) {
        const int cidx = F.tid + 512 * i; int kl = cidx >> 3; const int c8 = cidx & 7;
        if (n == 0 && kl < 128) kl += 128;
        const size_t off = (size_t)(krow0 + kl) * 256 + g * 64 + 8 * c8;
        r.k[i] = *(const v4u*)(Kb + off); r.v[i] = *(const v4u*)(Vb + off);
    }
}
__device__ __forceinline__ void attn_store_kv(Frame& F, const KVRegs& r) {
    LAS unsigned char* L = F.lds;
#pragma unroll
    for (int i = 0; i < 4; ++i) {
        const int cidx = F.tid + 512 * i, kl = cidx >> 3, c8 = cidx & 7;
        *(LAS v4u*)(L + AT_K + kl * KT_STRIDE + 16 * c8) = r.k[i];
        LAS bf16* vt = (LAS bf16*)(L + AT_V) + kl;
        const unsigned ww[4] = {r.v[i].x, r.v[i].y, r.v[i].z, r.v[i].w};
#pragma unroll
        for (int e = 0; e < 4; ++e) { vt[(8 * c8 + 2 * e) * (VT_STRIDE / 2)] = (bf16)(ww[e] & 0xffffu); vt[(8 * c8 + 2 * e + 1) * (VT_STRIDE / 2)] = (bf16)(ww[e] >> 16); }
    }
}
__device__ __forceinline__ void attn_compute(Frame& F, int b, int n, int g, float M0) {
    const int lane = F.lane, r32 = lane & 31, hi = lane >> 5, w = F.wave;
    LAS unsigned char* L = F.lds;
    const int hq = w >> 1, head = 4 * g + hq;
    const bf16* Q = (const bf16*)(F.out + O_YP) + QM_OFF;
    const bf16* SGA = (const bf16*)(F.ws + WS_SGA);
    bf16* YM = (bf16*)(F.ws + WS_XN);
    const float sinkv = fexp2(F.in[I_SINK][head] * LOG2E - M0);
    const unsigned onew = (r32 == 0 || r32 == 4) ? 0x3f803f80u : 0u;
    const bf16x8 onesf = __builtin_bit_cast(bf16x8, (v4u){onew, onew, onew, onew});
    for (int sb = 0; sb < 2; ++sb) {
        const int s = 2 * (w & 1) + sb;
        const size_t qrow = (size_t)b * SEQ + 128 * n + 32 * s + r32;
        bf16x8 qf[4];
#pragma unroll
        for (int d0 = 0; d0 < 4; ++d0) qf[d0] = *(const bf16x8*)(Q + qrow * DM + head * 64 + 16 * d0 + 8 * hi);
        const bf16* sg = SGA + qrow * DM + head * 64 + 4 * hi;
        v2u sgw[8];
#pragma unroll
        for (int q4 = 0; q4 < 4; ++q4) { sgw[q4] = *(const v2u*)(sg + 8 * q4); sgw[4 + q4] = *(const v2u*)(sg + 32 + 8 * q4); }
        f32x16 o0 = {}, o1 = {}, o2 = {};
        for (int kk = 0; kk < 3; ++kk) {
            const int kt = (s >> 1) + kk;
            if (n == 0 && kt < 2) continue;
            f32x16 p0 = {}, p1 = {};
            const LAS unsigned char* kb = L + AT_K + (64 * kt + r32) * KT_STRIDE + 16 * hi;
#pragma unroll
            for (int d0 = 0; d0 < 4; ++d0) {
                const bf16x8 a0 = *(const LAS bf16x8*)(kb + 32 * d0);
                const bf16x8 a1 = *(const LAS bf16x8*)(kb + 32 * KT_STRIDE + 32 * d0);
                p0 = __builtin_amdgcn_mfma_f32_32x32x16_bf16(a0, qf[d0], p0, 0, 0, 0);
                p1 = __builtin_amdgcn_mfma_f32_32x32x16_bf16(a1, qf[d0], p1, 0, 0, 0);
            }
            const int dbase = 128 + 32 * s + r32 - 64 * kt - 4 * hi;
            const LAS float* tb = (const LAS float*)(L + AT_T) + hq * 384 + 128 + dbase - 59;
#pragma unroll
            for (int r = 0; r < 16; ++r) {
                const int c = (r & 3) + 8 * (r >> 2);
                p0[r] = fexp2(p0[r] + tb[59 - c]); p1[r] = fexp2(p1[r] + tb[27 - c]);
            }
            const LAS unsigned char* vb = L + AT_V + r32 * VT_STRIDE + (64 * kt + 4 * hi) * 2;
#pragma unroll
            for (int ks = 0; ks < 4; ++ks) {
                v4u pw;
                if (ks == 0)      { pw.x = pg8::cvt_pk_bf16(p0[0], p0[1]);   pw.y = pg8::cvt_pk_bf16(p0[2], p0[3]);   pw.z = pg8::cvt_pk_bf16(p0[4], p0[5]);   pw.w = pg8::cvt_pk_bf16(p0[6], p0[7]); }
                else if (ks == 1) { pw.x = pg8::cvt_pk_bf16(p0[8], p0[9]);   pw.y = pg8::cvt_pk_bf16(p0[10], p0[11]); pw.z = pg8::cvt_pk_bf16(p0[12], p0[13]); pw.w = pg8::cvt_pk_bf16(p0[14], p0[15]); }
                else if (ks == 2) { pw.x = pg8::cvt_pk_bf16(p1[0], p1[1]);   pw.y = pg8::cvt_pk_bf16(p1[2], p1[3]);   pw.z = pg8::cvt_pk_bf16(p1[4], p1[5]);   pw.w = pg8::cvt_pk_bf16(p1[6], p1[7]); }
                else              { pw.x = pg8::cvt_pk_bf16(p1[8], p1[9]);   pw.y = pg8::cvt_pk_bf16(p1[10], p1[11]); pw.z = pg8::cvt_pk_bf16(p1[12], p1[13]); pw.w = pg8::cvt_pk_bf16(p1[14], p1[15]); }
                const bf16x8 pb = __builtin_bit_cast(bf16x8, pw);
                const v2u va0 = *(const LAS v2u*)(vb + 32 * ks), va1 = *(const LAS v2u*)(vb + 32 * ks + 16);
                const v2u vc0 = *(const LAS v2u*)(vb + 32 * VT_STRIDE + 32 * ks), vc1 = *(const LAS v2u*)(vb + 32 * VT_STRIDE + 32 * ks + 16);
                const bf16x8 fa = __builtin_bit_cast(bf16x8, (v4u){va0.x, va0.y, va1.x, va1.y});
                const bf16x8 fc = __builtin_bit_cast(bf16x8, (v4u){vc0.x, vc0.y, vc1.x, vc1.y});
                o0 = __builtin_amdgcn_mfma_f32_32x32x16_bf16(fa, pb, o0, 0, 0, 0);
                o1 = __builtin_amdgcn_mfma_f32_32x32x16_bf16(fc, pb, o1, 0, 0, 0);
                o2 = __builtin_amdgcn_mfma_f32_32x32x16_bf16(onesf, pb, o2, 0, 0, 0);
            }
        }
        const float inv = 1.0f / (o2[0] + sinkv);
        bf16* yo = YM + qrow * DM + head * 64 + 4 * hi;
#pragma unroll
        for (int q4 = 0; q4 < 4; ++q4) {
            {
                const v2u sw = sgw[q4];
                v2u ow; ow.x = pg8::cvt_pk_bf16(o0[4 * q4] * inv * bflo(sw.x), o0[4 * q4 + 1] * inv * bfhi(sw.x)); ow.y = pg8::cvt_pk_bf16(o0[4 * q4 + 2] * inv * bflo(sw.y), o0[4 * q4 + 3] * inv * bfhi(sw.y));
                *(v2u*)(yo + 8 * q4) = ow;
            }
            {
                const v2u sw = sgw[4 + q4];
                v2u ow; ow.x = pg8::cvt_pk_bf16(o1[4 * q4] * inv * bflo(sw.x), o1[4 * q4 + 1] * inv * bfhi(sw.x)); ow.y = pg8::cvt_pk_bf16(o1[4 * q4 + 2] * inv * bflo(sw.y), o1[4 * q4 + 3] * inv * bfhi(sw.y));
                *(v2u*)(yo + 32 + 8 * q4) = ow;
            }
        }
    }
}
__device__ __forceinline__ void attn_phase(Frame& F, float M0) {
    const int NU = NB * 32 * 4;
    int u = blockIdx.x; if (u >= NU) return;
    KVRegs r; attn_load_kv(F, u >> 7, (u >> 2) & 31, u & 3, r);
    for (; u < NU; u += F.G) {
        attn_store_kv(F, r);
        {
            const int g_ = u & 3; LAS float* tb = (LAS float*)(F.lds + AT_T);
            float rv[3];
#pragma unroll
            for (int i = 0; i < 3; ++i) { const int e = F.tid + 512 * i, hh = e / 384, dist = e % 384 - 128; rv[i] = F.in[I_REL][rel_bucket(dist & 127) * 16 + 4 * g_ + hh]; }
#pragma unroll
            for (int i = 0; i < 3; ++i) { const int e = F.tid + 512 * i, dist = e % 384 - 128; tb[e] = ((unsigned)dist < 128u) ? rv[i] * LOG2E - M0 : -1e30f; }
        }
        const int un = u + F.G;
        if (un < NU) attn_load_kv(F, un >> 7, (un >> 2) & 31, un & 3, r);
        LDS_WAIT(); __syncthreads();
        attn_compute(F, u >> 7, (u >> 2) & 31, u & 3, M0);
        __syncthreads();
    }
}

constexpr int REP[7] = {1, 1, 1, 1, 1, 1, 1};
constexpr int REPS[4] = {1, 1, 1, 1};
__global__ void __launch_bounds__(NWAVES * 64, 2) hyb_fwd(Args args) {
    extern __shared__ __attribute__((aligned(16))) unsigned char lds[];
    Frame F;
    F.lds = (LAS unsigned char*)lds;
    F.tid = threadIdx.x; F.lane = F.tid & 63; F.wave = __builtin_amdgcn_readfirstlane(F.tid >> 6);
    F.G = gridDim.x; { const int bx = blockIdx.x; F.vcu = (F.G % 8 == 0) ? (bx % 8) * (F.G / 8) + bx / 8 : bx; }
    F.in = args.in; F.out = args.out; F.ws = args.ws;
    volatile LAS unsigned* MISC = (volatile LAS unsigned*)(F.lds + MISC_OFF);
    for (int u = F.tid; u < (LDS_BYTES - LDSCTL_OFF) / 4; u += NWAVES * 64) ((LAS unsigned*)(F.lds + LDSCTL_OFF))[u] = 0u;
    __syncthreads();
    const int lo = args.ph_lo, hi = args.ph_hi;
    const bool one = (hi - lo) > 1;
    XcdBarrier bar; bar.bar = (unsigned*)(F.ws + WS_CTL) + CW_BAR; bar.x = 0; bar.st = nullptr;
    if (one) bar = xcd_barrier_post((unsigned*)(F.ws + WS_CTL) + CW_BAR, MISC + 8);
#define IN(k) (lo <= (k) && (k) < hi)
#define SEAM(k) do { if (IN(k) && IN((k) + 1)) xcd_barrier(bar); } while (0)
    const int gw = F.vcu * NWAVES + F.wave, NGW = F.G * NWAVES;
    LAS unsigned char* wl = F.lds + F.wave * 16384;

    unsigned* ctlw = (unsigned*)(F.ws + WS_CTL);
    for (int rep = 0; rep < REP[0]; ++rep)
    if (IN(0)) {
        refresh(F);
        for (int t = blockIdx.x; t < 192; t += F.G) { p0_mod_tile(F, t); soft_arrive(ctlw + CW_MODC, 1u); }
        p0_weights(F);
        {
            const int gt_ = F.vcu * (NWAVES * 64) + F.tid, NGT = F.G * NWAVES * 64;
            unsigned long long* za = (unsigned long long*)(F.ws + WS_LBA); unsigned long long* zh = (unsigned long long*)(F.ws + WS_LBH);
            for (int e = gt_; e < 131072; e += NGT) __hip_atomic_store(za + e, 0ull, __ATOMIC_RELAXED, __HIP_MEMORY_SCOPE_AGENT);
            for (int e = gt_; e < 16384; e += NGT) __hip_atomic_store(zh + e, 0ull, __ATOMIC_RELAXED, __HIP_MEMORY_SCOPE_AGENT);
        }
        __syncthreads();
    }
    for (int rep = 0; rep < REP[1]; ++rep)
    if (IN(1)) { refresh(F); soft_wait(ctlw + CW_MODC, 192u); p1_xn(F); }
    SEAM(1);
    for (int rep = 0; rep < REP[2]; ++rep)
    if (IN(2)) {
        pg8::Gemm g{(const bf16*)(F.ws + WS_XN), (const bf16*)(F.ws + WS_WIN), MPAD, INW, DM, nullptr, DM};
        pg8::StaticOrder S; S.init(MPAD, INW, F.G, (int)blockIdx.x);
        EpiZ E{F.ws, F.out, F.in[I_QG], F.in[I_KG]};
        pg8::gemm_phase<EpiZ, pg8::StaticOrder, true, true>(F.lds, g, S, E);
        refresh(F);
        for (;;) {
            if (F.tid == 0) MISC[10] = __hip_atomic_fetch_add(ctlw + CW_TQ, 1u, __ATOMIC_RELAXED, __HIP_MEMORY_SCOPE_AGENT);
            __syncthreads();
            const int it = (int)MISC[10];
            __syncthreads();
            if (it >= TQ_ALL) break;
            tail_item(F, it);
        }
    }
    SEAM(2);
    for (int rep = 0; rep < REP[3]; ++rep)
    if (IN(3)) {
        refresh(F);
        const float M0 = logit_bound(F);
        build_bias_table(F);
        LDS_WAIT(); __syncthreads();
        for (int rs = 0; rs < REPS[0]; ++rs) {
        for (int u = F.vcu; u < NS * 2; u += F.G) sample_attn_block(F, u, M0);
        }
        if (F.G == 256) {
            scan_lb_block(F, F.vcu);
            build_bias_table(F); LDS_WAIT(); __syncthreads();
        } else {
            for (int u = F.vcu; u < 256; u += F.G) scan_block<1>(F, u);
            soft_arrive(ctlw + CW_S1C, 1u);
        }
        for (int rs = 0; rs < REPS[2]; ++rs)
        attn_phase(F, M0);
    }
    for (int rep = 0; rep < REP[4]; ++rep)
    if (IN(4) && F.G != 256) {
        refresh(F);
        soft_wait(ctlw + CW_S1C, (unsigned)F.G);
        for (int u = F.vcu; u < 256; u += F.G) scan_block<2>(F, u);
        __syncthreads();
    }
    SEAM(4);
    for (int rep = 0; rep < REP[5]; ++rep)
    if (IN(5)) {
        pg8::Gemm g{(const bf16*)(F.ws + WS_XN), (const bf16*)(F.ws + WS_WPP), MP, DM, 2048, (const bf16*)(F.out + O_YP), DM};
        pg8::StaticOrder S; S.init(MP, DM, F.G, (int)blockIdx.x);
        EpiMerge E{F.ws + WS_RAT, F.ws + WS_SMR, (bf16*)(F.ws + WS_SGA)};
        pg8::gemm_phase<EpiMerge, pg8::StaticOrder, false, true>(F.lds, g, S, E);
        refresh(F);
        for (int t = F.vcu; t < 256; t += F.G) mini_merge_block(F, t);
    }
    SEAM(5);
    for (int rep = 0; rep < REP[6]; ++rep)
    if (IN(6)) {
        pg8::Gemm g{(const bf16*)(F.ws + WS_SGA), (const bf16*)(F.ws + WS_WOUT), MP, DM, DM, nullptr, DM};
        pg8::StaticOrder S; S.init(MP, DM, F.G, (int)blockIdx.x);
        EpiOut E{F.in[I_XP], (const float*)(F.ws + WS_MOD), F.out + O_YP};
        pg8::gemm_phase<EpiOut, pg8::StaticOrder, false, true>(F.lds, g, S, E);
        refresh(F);
        for (int t = F.vcu; t < 256; t += F.G) mini_out_block(F, t);
    }
#undef IN
#undef SEAM
}

#ifndef MK_N_LAUNCHES
#define MK_N_LAUNCHES 1
#endif
constexpr int N_PHASES = 7;

extern "C" void kernel_launch(void* const* d_in, const int* in_sizes, int n_in, void* d_out, int out_size, void* d_ws, size_t ws_size, hipStream_t stream) {
    static int grid = 0;
    if (grid == 0) {
        if (n_in != 26 || out_size != (int)O_END || ws_size < WS_END) { fprintf(stderr, "kernel_launch: unexpected shapes (n_in %d out %d ws %zu)\n", n_in, out_size, ws_size); grid = -1; return; }
        int dev = 0, cus = 0, per_cu = 0;
        if (hipGetDevice(&dev) != hipSuccess || hipDeviceGetAttribute(&cus, hipDeviceAttributeMultiprocessorCount, dev) != hipSuccess) { grid = -1; return; }
        if (hipFuncSetAttribute((const void*)hyb_fwd, hipFuncAttributeMaxDynamicSharedMemorySize, LDS_BYTES) != hipSuccess) { fprintf(stderr, "kernel_launch: hipFuncSetAttribute failed\n"); grid = -1; return; }
        if (hipOccupancyMaxActiveBlocksPerMultiprocessor(&per_cu, (const void*)hyb_fwd, NWAVES * 64, LDS_BYTES) != hipSuccess || per_cu < 1) { fprintf(stderr, "kernel_launch: occupancy query says %d\n", per_cu); per_cu = 1; }
        (void)hipGetLastError();
        grid = cus * (per_cu < 1 ? 1 : 1);
    }
    if (grid < 0) return;
    (void)hipMemsetAsync((char*)d_ws + WS_CTL, 0, CTL_ZERO_BYTES, stream);
    Args a{};
    for (int i = 0; i < 26; ++i) a.in[i] = (const float*)d_in[i];
    a.out = (float*)d_out; a.ws = (unsigned char*)d_ws;
    if (MK_N_LAUNCHES == 1) {
        a.ph_lo = 0; a.ph_hi = N_PHASES;
        void* kargs[] = {&a};
        hipError_t e = hipLaunchCooperativeKernel((const void*)hyb_fwd, dim3(grid), dim3(NWAVES * 64), kargs, LDS_BYTES, stream);
        if (e != hipSuccess) fprintf(stderr, "kernel_launch: cooperative launch failed: %s (grid %d)\n", hipGetErrorString(e), grid);
    } else {
        for (int p = 0; p < N_PHASES; ++p) {
            a.ph_lo = p; a.ph_hi = p + 1;
            hipLaunchKernelGGL(hyb_fwd, dim3(grid), dim3(NWAVES * 64), LDS_BYTES, stream, a);
        }
    }
}
```

```cpp
#include <hip/hip_runtime.h>
#include <cstdio>
#include <cstdint>

namespace pg8 {
#define PG8_LAS __attribute__((address_space(3)))
typedef unsigned short bf16_t;
typedef short bf16x8 __attribute__((ext_vector_type(8)));
typedef float f32x4 __attribute__((ext_vector_type(4)));
typedef unsigned u32x4 __attribute__((ext_vector_type(4)));
constexpr int BM = 256, BK = 64, HALF = 128, HTB = HALF * BK * 2, STAGE_BYTES = 8 * HTB, NXCD = 8, WGM = 8;

__host__ __device__ __forceinline__ int lds_byte(int r, int c) { const int st = (r >> 4) * 2 + (c >> 5), rr = r & 15, cc = c & 31, ob = rr * 64 + cc * 2; return st * 1024 + (ob ^ (((ob >> 9) & 1) << 5)); }
__host__ __device__ __forceinline__ void stage_rc(int b, int& R, int& C) { const int st = b / 1024, sb = b % 1024, swz = sb ^ (((sb >> 9) & 1) << 5); R = (st >> 1) * 16 + swz / 64; C = (st & 1) * 32 + (swz % 64) / 2; }
__host__ __device__ __forceinline__ int perm32(int rho) { const int n = rho >> 4, i = rho & 15; return 8 * (i >> 2) + 4 * n + (i & 3); }

struct Unit { int pm, pn; };
struct Gemm { const bf16_t* A; const bf16_t* Bt; int M, N, K; const bf16_t* A2; int lda; };

struct StaticOrder {
    int nM, nN, nwg, G, c;
    __host__ __device__ void init(int M, int N, int G_, int c_) { nM = M / BM; nN = N / BM; nwg = nM * nN; G = G_; c = c_; }
    __host__ __device__ bool next(int i, Unit& u) const {
        const long L = (long)i * G + c; if (L >= nwg) return false;
        int wgid = (int)L; { const int q = nwg / NXCD, r = nwg % NXCD, xcd = wgid % NXCD, off = wgid / NXCD; wgid = (xcd < r ? xcd * (q + 1) : r * (q + 1) + (xcd - r) * q) + off; }
        const int nig = WGM * nN, gid = wgid / nig, fm = gid * WGM, gsz = (nM - fm) < WGM ? (nM - fm) : WGM;
        u.pm = fm + ((wgid % nig) % gsz); u.pn = (wgid % nig) / gsz; return true;
    }
    __device__ __forceinline__ void a_ready(const Unit&) const {}
    __device__ __forceinline__ void done(const Unit&) const {}
};

typedef float f32x2_t __attribute__((ext_vector_type(2))); typedef __bf16 bf16x2_t __attribute__((ext_vector_type(2)));
__device__ __forceinline__ unsigned cvt_pk_bf16(float lo, float hi) { f32x2_t v = {lo, hi}; bf16x2_t b = __builtin_convertvector(v, bf16x2_t); return __builtin_bit_cast(unsigned, b); }

template <class Epi, class Sched, bool ALIGN_EPI = false, bool SP2 = false>
__device__ __forceinline__ void gemm_phase(PG8_LAS unsigned char* lds, const Gemm g, const Sched& S, const Epi& E) {
    int tid_ = threadIdx.x; asm volatile("" : "+v"(tid_));
    const int tid = tid_, wid = __builtin_amdgcn_readfirstlane(tid >> 6), lane = tid & 63, wr = wid >> 2, wc = wid & 3, fr = lane & 15, fq = lane >> 4;
    const int K = g.K, nt = K / BK;
    unsigned voffA[2], voffB[2];
#pragma unroll
    for (int i = 0; i < 2; ++i) { int R, C; stage_rc(tid * 16 + i * 8192, R, C); const int Rb = Epi::PERM ? ((R & ~31) + perm32(R & 31)) : R;
        voffA[i] = (unsigned)(R * g.lda + C) * 2u; voffB[i] = (unsigned)(Rb * K + C) * 2u; }
    const size_t kstep = (size_t)(BK * 2);
    const size_t hstep = (size_t)HALF * K * 2;
    const size_t tstep = 2 * hstep;
    const size_t hstepA = (size_t)HALF * g.lda * 2, tstepA = 2 * hstepA;
    const int nh = g.A2 ? nt / 2 : nt + 4;
    const long a2delta = g.A2 ? ((const char*)g.A2 - (const char*)g.A) - (long)nh * (long)kstep : 0;
    const unsigned ldsw = (unsigned)wid * 1024u;
    const int aoff = lds_byte(wr * 64 + fr, fq * 8), boff = lds_byte(wc * 32 + fr, fq * 8);
#define PG8_SA(b, h) (((b) * 2 + (h)) * HTB)
#define PG8_SB(b, h) ((4 + (b) * 2 + (h)) * HTB)
#define PG8_STAGE(bufoff, gbase, voff) do { _Pragma("unroll") for (int _i = 0; _i < 2; ++_i) \
        __builtin_amdgcn_global_load_lds((const unsigned*)((const char*)(gbase) + (voff)[_i]), (PG8_LAS unsigned*)(lds + (bufoff) + ldsw + _i * 8192), 16, 0, 0); } while (0)
#define PG8_LDA(dst, b, h) do { _Pragma("unroll") for (int m = 0; m < 4; ++m) _Pragma("unroll") for (int k = 0; k < 2; ++k) dst[m][k] = *(const PG8_LAS bf16x8*)(lds + PG8_SA(b, h) + aoff + m * 2048 + k * 1024); } while (0)
#define PG8_LDB(dst, b, h) do { _Pragma("unroll") for (int n = 0; n < 2; ++n) _Pragma("unroll") for (int k = 0; k < 2; ++k) dst[n][k] = *(const PG8_LAS bf16x8*)(lds + PG8_SB(b, h) + boff + n * 2048 + k * 1024); } while (0)
#define PG8_MMA(ai, bj, At, Bt) do { __builtin_amdgcn_s_setprio(1); _Pragma("unroll") for (int m = 0; m < 4; ++m) _Pragma("unroll") for (int n = 0; n < 2; ++n) _Pragma("unroll") for (int k = 0; k < 2; ++k) \
        acc[ai][bj][m][n] = __builtin_amdgcn_mfma_f32_16x16x32_bf16(Bt[n][k], At[m][k], acc[ai][bj][m][n], 0, 0, 0); __builtin_amdgcn_s_setprio(0); } while (0)
#define PG8_WAIT_V(n) asm volatile("s_waitcnt vmcnt(" #n ")" ::: "memory")
#define PG8_WAIT_L(n) asm volatile("s_waitcnt lgkmcnt(" #n ")" ::: "memory")
#define PG8_BAR __builtin_amdgcn_s_barrier()
#define PG8_SCHED __builtin_amdgcn_sched_barrier(0)
    Unit cur, nxt; int ui = 0;
    if (!S.next(0, cur)) return;
    f32x4 acc[2][2][4][2];
#pragma unroll
    for (int a = 0; a < 2; ++a)
#pragma unroll
        for (int b = 0; b < 2; ++b)
#pragma unroll
            for (int m = 0; m < 4; ++m)
#pragma unroll
                for (int n = 0; n < 2; ++n) acc[a][b][m][n] = (f32x4){0.f, 0.f, 0.f, 0.f};
    bf16x8 At[4][2], B0[2][2], B1[2][2];
    const char* cA = (const char*)g.A + (size_t)cur.pm * tstepA; const char* cB = (const char*)g.Bt + (size_t)cur.pn * tstep;
    S.a_ready(cur);
    if constexpr (SP2) {
        PG8_STAGE(PG8_SB(0, 0), cB, voffB); PG8_STAGE(PG8_SB(0, 1), cB + hstep, voffB); PG8_STAGE(PG8_SA(0, 0), cA, voffA); PG8_STAGE(PG8_SA(0, 1), cA + hstepA, voffA);
        if (wr == 1) PG8_BAR;
        PG8_WAIT_V(2); PG8_BAR;
        PG8_STAGE(PG8_SB(1, 0), cB + kstep, voffB); PG8_STAGE(PG8_SA(1, 0), cA + kstep, voffA); PG8_STAGE(PG8_SB(1, 1), cB + hstep + kstep, voffB);
        PG8_WAIT_V(6); PG8_BAR;
    } else {
        PG8_STAGE(PG8_SB(0, 0), cB, voffB); PG8_STAGE(PG8_SA(0, 0), cA, voffA); PG8_STAGE(PG8_SB(0, 1), cB + hstep, voffB); PG8_STAGE(PG8_SA(0, 1), cA + hstepA, voffA);
        if (wr == 1) PG8_BAR;
        PG8_WAIT_V(4); PG8_BAR;
        PG8_STAGE(PG8_SB(1, 0), cB + kstep, voffB); PG8_STAGE(PG8_SA(1, 0), cA + kstep, voffA); PG8_STAGE(PG8_SB(1, 1), cB + hstep + kstep, voffB);
        PG8_WAIT_V(6); PG8_BAR;
    }
    for (;;) {
        const bool has_next = S.next(ui + 1, nxt);
        const char* nA = has_next ? (const char*)g.A + (size_t)nxt.pm * tstepA : cA; const char* nB = has_next ? (const char*)g.Bt + (size_t)nxt.pn * tstep : cB;
        for (int t = 0; t < nt; t += 2) {
            if constexpr (Epi::HAS_MID) { if (t == nt / 2) E.mid(acc, cur, wr, wc, fr, fq); }
            const bool last = (t == nt - 2);
            const char* a1 = cA + (t >= nh ? a2delta : 0) + (size_t)(t + 1) * kstep;
            const char* a2 = last ? nA : cA + (t + 2 >= nh ? a2delta : 0) + (size_t)(t + 2) * kstep; const char* b2 = last ? nB : cB + (size_t)(t + 2) * kstep;
            const char* a3 = a2 + kstep; const char* b3 = b2 + kstep;
            if (last && has_next) S.a_ready(nxt);
            if constexpr (SP2) {
            PG8_LDB(B0, 0, 0); PG8_LDB(B1, 0, 1); PG8_SCHED; PG8_LDA(At, 0, 0); PG8_STAGE(PG8_SA(1, 1), a1 + hstepA, voffA);
            PG8_WAIT_V(8); PG8_WAIT_L(0); PG8_BAR; PG8_MMA(0, 0, At, B0); PG8_MMA(0, 1, At, B1); PG8_BAR; PG8_SCHED;
            PG8_LDA(At, 0, 1); PG8_STAGE(PG8_SB(0, 0), b2, voffB); PG8_STAGE(PG8_SB(0, 1), b2 + hstep, voffB); PG8_STAGE(PG8_SA(0, 0), a2, voffA);
            PG8_WAIT_V(8); PG8_WAIT_L(0); PG8_BAR; PG8_MMA(1, 0, At, B0); PG8_MMA(1, 1, At, B1); PG8_BAR; PG8_SCHED;
            PG8_LDB(B0, 1, 0); PG8_LDB(B1, 1, 1); PG8_SCHED; PG8_LDA(At, 1, 0); PG8_STAGE(PG8_SA(0, 1), a2 + hstepA, voffA);
            PG8_WAIT_V(8); PG8_WAIT_L(0); PG8_BAR; PG8_MMA(0, 0, At, B0); PG8_MMA(0, 1, At, B1); PG8_BAR; PG8_SCHED;
            PG8_LDA(At, 1, 1); PG8_STAGE(PG8_SB(1, 0), b3, voffB); PG8_STAGE(PG8_SB(1, 1), b3 + hstep, voffB); PG8_STAGE(PG8_SA(1, 0), a3, voffA);
            PG8_WAIT_V(8); PG8_WAIT_L(0); PG8_BAR; PG8_MMA(1, 0, At, B0); PG8_MMA(1, 1, At, B1); PG8_BAR; PG8_SCHED;
            } else {
            PG8_LDB(B0, 0, 0); PG8_SCHED; PG8_LDA(At, 0, 0); PG8_STAGE(PG8_SA(1, 1), a1 + hstepA, voffA);
            PG8_WAIT_L(8); PG8_BAR; PG8_WAIT_L(0); PG8_MMA(0, 0, At, B0); PG8_BAR; PG8_SCHED;
            PG8_LDB(B1, 0, 1); PG8_STAGE(PG8_SB(0, 0), b2, voffB);
            PG8_BAR; PG8_WAIT_L(0); PG8_MMA(0, 1, At, B1); PG8_BAR;
            PG8_LDA(At, 0, 1); PG8_STAGE(PG8_SA(0, 0), a2, voffA);
            PG8_BAR; PG8_WAIT_L(0); PG8_MMA(1, 0, At, B0); PG8_BAR; PG8_SCHED;
            PG8_STAGE(PG8_SB(0, 1), b2 + hstep, voffB);
            PG8_WAIT_V(6); PG8_BAR; PG8_MMA(1, 1, At, B1); PG8_BAR;
            PG8_LDB(B0, 1, 0); PG8_SCHED; PG8_LDA(At, 1, 0); PG8_STAGE(PG8_SA(0, 1), a2 + hstepA, voffA);
            PG8_WAIT_L(8); PG8_BAR; PG8_WAIT_L(0); PG8_MMA(0, 0, At, B0); PG8_BAR; PG8_SCHED;
            PG8_LDB(B1, 1, 1); PG8_STAGE(PG8_SB(1, 0), b3, voffB);
            PG8_BAR; PG8_WAIT_L(0); PG8_MMA(0, 1, At, B1); PG8_BAR;
            PG8_LDA(At, 1, 1); PG8_STAGE(PG8_SA(1, 0), a3, voffA);
            PG8_BAR; PG8_WAIT_L(0); PG8_MMA(1, 0, At, B0); PG8_BAR; PG8_SCHED;
            PG8_STAGE(PG8_SB(1, 1), b3 + hstep, voffB);
            PG8_WAIT_V(6); PG8_BAR; PG8_MMA(1, 1, At, B1); PG8_BAR;
            }
        }
        if constexpr (ALIGN_EPI) { if (wr == 0) PG8_BAR; }
        E(acc, cur, wr, wc, fr, fq); S.done(cur);
        if (!has_next) break;
#pragma unroll
        for (int a = 0; a < 2; ++a)
#pragma unroll
            for (int b = 0; b < 2; ++b)
#pragma unroll
                for (int m = 0; m < 4; ++m)
#pragma unroll
                    for (int n = 0; n < 2; ++n) acc[a][b][m][n] = (f32x4){0.f, 0.f, 0.f, 0.f};
        cur = nxt; cA = nA; cB = nB; ++ui;
        if constexpr (ALIGN_EPI) { if (wr == 1) PG8_BAR; }
    }
    PG8_WAIT_V(0);
    if constexpr (!ALIGN_EPI) { if (wr == 0) PG8_BAR; }
    PG8_BAR;
#undef PG8_SA
#undef PG8_SB
#undef PG8_STAGE
#undef PG8_LDA
#undef PG8_LDB
#undef PG8_MMA
#undef PG8_WAIT_V
#undef PG8_WAIT_L
#undef PG8_BAR
#undef PG8_SCHED
}
}

constexpr int NWAVES = 8;
constexpr int DM = 1024, NB = 4, SEQ = 4096, NS = 128, WIN = 128;
constexpr int MP = NB * SEQ;
constexpr int MALL = MP + NS;
constexpr int MPAD = 16640;
constexpr int INW = 6656;
constexpr int NCH = 32;
constexpr float EPSN = 1e-6f;
constexpr float LOG2E = 1.4426950408889634f;
constexpr float QSCALE = 0.125f * LOG2E;

constexpr size_t MiB = 1u << 20;
constexpr size_t WS_CTL = 0, CTL_ZERO_BYTES = 64 * 1024;
constexpr size_t WS_MOD = 1 * MiB;
constexpr size_t WS_WRA = 3 * MiB;
constexpr size_t WS_WRX = 3 * MiB + 128 * 1024;
constexpr size_t WS_KVNEW = 3 * MiB + 256 * 1024;
constexpr size_t WS_AGG = 4 * MiB;
constexpr size_t WS_LBA = 4 * MiB;
constexpr size_t WS_LBH = 3 * MiB + 512 * 1024;
constexpr size_t WS_WIN = 5 * MiB;
constexpr size_t WS_WPP = 18 * MiB;
constexpr size_t WS_WOUT = 22 * MiB;
constexpr size_t WS_XN = 24 * MiB;
constexpr size_t ACT = (size_t)MPAD * DM * 2;
constexpr size_t WS_K = WS_XN + ACT;
constexpr size_t WS_V = WS_K + ACT / 4;
constexpr size_t WS_SGA = WS_V + ACT / 4;
constexpr size_t WS_XR = WS_SGA + ACT;
constexpr size_t WS_SGR = WS_XR + ACT;
constexpr size_t WS_RAT = WS_SGR + ACT;
constexpr size_t WS_SMR = WS_RAT + ACT;
constexpr size_t WS_QT = WS_SMR + ACT;
constexpr size_t WS_YT = WS_QT + 512 * 1024;
constexpr size_t WS_MGT = WS_YT + 512 * 1024;
constexpr size_t WS_END = WS_MGT + 256 * 1024;
static_assert(WS_END <= 256 * MiB, "d_ws map");
constexpr size_t O_YP = 0, O_YS = 16777216, O_KWP = 16908288, O_VWP = 17039360, O_CVP = 17170432, O_HP = 17182720,
                 O_KWS = 17186816, O_VWS = 21381120, O_CVS = 25575424, O_HS = 25968640, O_END = 26099712;
constexpr size_t QM_OFF = (size_t)MP * DM;

constexpr int CW_BAR = 1024, CW_MODC = 64, CW_S1C = 128, CW_TQ = 192, CW_MGC = 320, CW_YTC = 384, CW_MODB = 448;

constexpr int RING_BYTES = 131072;
constexpr int GW_OFF = RING_BYTES, GW_STRIDE = 144, GW_BYTES = 2 * 64 * GW_STRIDE;
constexpr int BT_OFF = GW_OFF + GW_BYTES, BT_BYTES = 16 * 128 * 4;
constexpr int LDSCTL_OFF = BT_OFF + BT_BYTES, MISC_OFF = LDSCTL_OFF + 320;
constexpr int LDS_BYTES = LDSCTL_OFF + 512;
static_assert(GW_OFF + NWAVES * 16 * 144 <= LDSCTL_OFF, "P6 epilogue staging");

#define GAS __attribute__((address_space(1)))
#define LAS __attribute__((address_space(3)))
typedef unsigned short bf16;
typedef unsigned v4u __attribute__((ext_vector_type(4)));
typedef unsigned v2u __attribute__((ext_vector_type(2)));
typedef float f32x4 __attribute__((ext_vector_type(4)));
typedef float f32x16 __attribute__((ext_vector_type(16)));
typedef short bf16x8 __attribute__((ext_vector_type(8)));
typedef short s16x4 __attribute__((ext_vector_type(4)));
typedef GAS unsigned gu32;
#define RLX_AGENT __ATOMIC_RELAXED, __HIP_MEMORY_SCOPE_AGENT
#define LDS_WAIT() asm volatile("s_waitcnt lgkmcnt(0)" ::: "memory")
#define VM_WAIT() asm volatile("s_waitcnt vmcnt(0)" ::: "memory")
__device__ __forceinline__ unsigned f2bf(float f) { unsigned u = __builtin_bit_cast(unsigned, f); return (u + 0x7fffu + ((u >> 16) & 1u)) >> 16; }
__device__ __forceinline__ unsigned pk2(float lo, float hi) { return f2bf(lo) | (f2bf(hi) << 16); }
__device__ __forceinline__ float bf2f(unsigned b) { return __uint_as_float(b << 16); }
__device__ __forceinline__ float bflo(unsigned w) { return __uint_as_float(w << 16); }
__device__ __forceinline__ float bfhi(unsigned w) { return __uint_as_float(w & 0xffff0000u); }
__device__ __forceinline__ unsigned pk_u8x4(float a, float b, float c, float d) {
    unsigned r = __builtin_amdgcn_cvt_pk_u8_f32(fmaxf(a * 255.0f, 1.0f), 0, 0u); r = __builtin_amdgcn_cvt_pk_u8_f32(fmaxf(b * 255.0f, 1.0f), 1, r);
    r = __builtin_amdgcn_cvt_pk_u8_f32(fmaxf(c * 255.0f, 1.0f), 2, r); return __builtin_amdgcn_cvt_pk_u8_f32(fmaxf(d * 255.0f, 1.0f), 3, r); }
__device__ __forceinline__ float u8f(unsigned w, int i) { return (float)((w >> (8 * i)) & 0xffu); }
__device__ __forceinline__ float fexp2(float x) { return __builtin_amdgcn_exp2f(x); }
__device__ __forceinline__ float frcp(float x) { return __builtin_amdgcn_rcpf(x); }
__device__ __forceinline__ float sigm(float x) { return frcp(1.0f + fexp2(-LOG2E * x)); }

#define XB_TMO      128
#define XB_XCNT(j)  (256  + 64 * (j))
#define XB_XSUB(j)  (1280 + 64 * (j))
#define XB_XGEN(j)  (2304 + 64 * (j))
#define XB_TOP      3328
#define XB_TOPGEN   3392
#define XCD_BAR_WORDS 3456
#define XB_SPIN_CAP (1u << 22)
__device__ __forceinline__ unsigned xb_ld(unsigned* p)              { return __hip_atomic_load(p, __ATOMIC_RELAXED, __HIP_MEMORY_SCOPE_AGENT); }
__device__ __forceinline__ unsigned xb_add(unsigned* p, unsigned v) { return __hip_atomic_fetch_add(p, v, __ATOMIC_RELAXED, __HIP_MEMORY_SCOPE_AGENT); }
__device__ __forceinline__ unsigned xb_xcc_id() { return (unsigned)__builtin_amdgcn_s_getreg((3 << 11) | 20) & 0xFu; }
#define XB_SPIN(cond, bar) do { unsigned _sp = 0; while (cond) { __builtin_amdgcn_s_sleep(1); \
    if ((++_sp & 255u) == 0u) { if (xb_ld(&(bar)[XB_TMO])) break; if (_sp > XB_SPIN_CAP) { atomicAdd(&(bar)[XB_TMO], 1u); break; } } } } while (0)
struct XcdBarrier { unsigned* bar; unsigned x; volatile LAS unsigned* st; };
__device__ __forceinline__ XcdBarrier xcd_barrier_post(unsigned* bar, volatile LAS unsigned* st) {
    XcdBarrier b; b.bar = bar; b.x = xb_xcc_id(); b.st = st;
    if (threadIdx.x == 0) (void)xb_add(&bar[XB_XCNT(b.x)], 1u);
    return b;
}
__device__ __forceinline__ void xcd_barrier_complete(unsigned* bar, unsigned x, unsigned& nloc, unsigned& nx) {
    const unsigned G = gridDim.x * gridDim.y * gridDim.z;
    unsigned sum, cnt, mine, sp = 0u;
    for (;;) {
        sum = 0u; cnt = 0u; mine = 0u;
#pragma unroll
        for (unsigned j = 0; j < 16; ++j) { const unsigned c = xb_ld(&bar[XB_XCNT(j)]); sum += c; cnt += (c > 0u) ? 1u : 0u; mine = (j == x) ? c : mine; }
        if (sum == G) break;
        __builtin_amdgcn_s_sleep(1);
        if ((++sp & 255u) == 0u) { if (xb_ld(&bar[XB_TMO])) break; if (sp > XB_SPIN_CAP) { atomicAdd(&bar[XB_TMO], 1u); break; } }
    }
    nloc = mine > 0u ? mine : 1u; nx = cnt > 0u ? cnt : 1u;
}
__device__ __forceinline__ void xcd_barrier(const XcdBarrier& b) {
    asm volatile("s_waitcnt vmcnt(0)" ::: "memory");
    __syncthreads();
    if (threadIdx.x == 0) {
        unsigned* bar = b.bar;
        __builtin_amdgcn_s_waitcnt(0);
        unsigned nloc = b.st[0], nx = b.st[1];
        if (nloc == 0u) { xcd_barrier_complete(bar, b.x, nloc, nx); b.st[0] = nloc; b.st[1] = nx; }
        const unsigned old = xb_add(&bar[XB_XSUB(b.x)], 1u);
        const unsigned gen = old / nloc;
        if (old + 1u == (gen + 1u) * nloc) {
            __builtin_amdgcn_fence(__ATOMIC_RELEASE, "agent");
            asm volatile("s_waitcnt vmcnt(0)" ::: "memory");
            const unsigned og = xb_add(&bar[XB_TOP], 1u);
            const unsigned tg = og / nx;
            if (og + 1u == (tg + 1u) * nx) {
#pragma unroll
                for (unsigned j = 0; j < 16; ++j) (void)xb_add(&bar[XB_XGEN(j)], 1u);
            } else XB_SPIN(xb_ld(&bar[XB_XGEN(b.x)]) == gen, bar);
            __builtin_amdgcn_fence(__ATOMIC_ACQUIRE, "agent");
            asm volatile("s_waitcnt vmcnt(0)" ::: "memory");
        } else {
            XB_SPIN(xb_ld(&bar[XB_XGEN(b.x)]) == gen, bar);
            __builtin_amdgcn_fence(__ATOMIC_ACQUIRE, "agent");
            asm volatile("s_waitcnt vmcnt(0)" ::: "memory");
        }
    }
    __syncthreads();
}

struct XcdPending { unsigned gen, tg; int role; };
__device__ __forceinline__ void xcd_barrier_arrive(const XcdBarrier& b, XcdPending& p) {
    asm volatile("s_waitcnt vmcnt(0)" ::: "memory");
    __syncthreads();
    p.gen = 0u; p.tg = 0u; p.role = 0;
    if (threadIdx.x == 0) {
        unsigned* bar = b.bar;
        __builtin_amdgcn_s_waitcnt(0);
        unsigned nloc = b.st[0], nx = b.st[1];
        if (nloc == 0u) { xcd_barrier_complete(bar, b.x, nloc, nx); b.st[0] = nloc; b.st[1] = nx; }
        const unsigned old = xb_add(&bar[XB_XSUB(b.x)], 1u);
        const unsigned gen = old / nloc;
        p.gen = gen; p.role = 1;
        if (old + 1u == (gen + 1u) * nloc) {
            __builtin_amdgcn_fence(__ATOMIC_RELEASE, "agent");
            asm volatile("s_waitcnt vmcnt(0)" ::: "memory");
            const unsigned og = xb_add(&bar[XB_TOP], 1u);
            const unsigned tg = og / nx;
            p.tg = tg; p.role = 2;
            if (og + 1u == (tg + 1u) * nx) {
#pragma unroll
                for (unsigned j = 0; j < 16; ++j) (void)xb_add(&bar[XB_XGEN(j)], 1u);
                p.role = 3;
            }
        }
    }
}
__device__ __forceinline__ void xcd_barrier_wait(const XcdBarrier& b, const XcdPending& p) {
    if (threadIdx.x == 0) {
        unsigned* bar = b.bar;
        if (p.role == 3) {
            __builtin_amdgcn_fence(__ATOMIC_ACQUIRE, "agent");
            asm volatile("s_waitcnt vmcnt(0)" ::: "memory");
        } else {
            XB_SPIN(xb_ld(&bar[XB_XGEN(b.x)]) == p.gen, bar);
            __builtin_amdgcn_fence(__ATOMIC_ACQUIRE, "agent");
            asm volatile("s_waitcnt vmcnt(0)" ::: "memory");
        }
    }
    __syncthreads();
}

__device__ __forceinline__ void soft_arrive(unsigned* cnt, unsigned v) {
    asm volatile("s_waitcnt vmcnt(0)" ::: "memory"); __syncthreads();
    if (threadIdx.x == 0) (void)__hip_atomic_fetch_add(cnt, v, __ATOMIC_RELAXED, __HIP_MEMORY_SCOPE_AGENT);
}
__device__ __forceinline__ void soft_wait(unsigned* cnt, unsigned need) {
    if (threadIdx.x == 0) {
        unsigned sp = 0;
        while (__hip_atomic_load(cnt, __ATOMIC_RELAXED, __HIP_MEMORY_SCOPE_AGENT) < need) { __builtin_amdgcn_s_sleep(2); if (++sp > (1u << 22)) break; }
        __builtin_amdgcn_fence(__ATOMIC_ACQUIRE, "agent");
        asm volatile("s_waitcnt vmcnt(0)" ::: "memory");
    }
    __syncthreads();
}
__device__ __forceinline__ void st_sc1(float* p, float v) { __hip_atomic_store((unsigned*)p, __float_as_uint(v), __ATOMIC_RELAXED, __HIP_MEMORY_SCOPE_AGENT); }
struct Args {
    const float* in[26];
    float* out; unsigned char* ws;
    int ph_lo, ph_hi;
};
enum { I_XP = 0, I_XS, I_CK, I_CV, I_SC, I_SH, I_CP, I_CS, I_REL, I_NG, I_WADA, I_BADA, I_WIN, I_QG, I_KG, I_SINK, I_WCONV, I_BCONV,
       I_WRA, I_BRA, I_WRX, I_BRX, I_LAM, I_WPA, I_WPR, I_WOUT };

struct Frame {
    LAS unsigned char* lds;
    int tid, lane, wave, G, vcu;
    const float* const* in;
    float* out; unsigned char* ws;
};

__device__ __forceinline__ void refresh(Frame& F) {
    int t = threadIdx.x; asm volatile("" : "+v"(t));
    F.tid = t; F.lane = t & 63; F.wave = __builtin_amdgcn_readfirstlane(t >> 6);
}
__device__ __forceinline__ int rel_bucket(int n) { const int big = 16 + (int)(__builtin_amdgcn_logf((float)n * 0.0625f) * (16.0f / 3.0f)); return n < 16 ? n : (big < 31 ? big : 31); }
__device__ const unsigned char BUCKET[128] = {0, 1, 2, 3, 4, 5, 6, 7, 8, 9, 10, 11, 12, 13, 14, 15, 16, 16, 16, 17, 17, 18, 18, 18, 19, 19, 19, 20, 20, 20, 20, 21, 21, 21, 21, 22, 22, 22, 22, 22, 23, 23, 23, 23, 23, 23, 24, 24, 24, 24, 24, 24, 25, 25, 25, 25, 25, 25, 25, 26, 26, 26, 26, 26, 26, 26, 26, 27, 27, 27, 27, 27, 27, 27, 27, 27, 27, 28, 28, 28, 28, 28, 28, 28, 28, 28, 28, 29, 29, 29, 29, 29, 29, 29, 29, 29, 29, 29, 29, 30, 30, 30, 30, 30, 30, 30, 30, 30, 30, 30, 30, 30, 30, 31, 31, 31, 31, 31, 31, 31, 31, 31, 31, 31, 31, 31, 31, 31};

__device__ __forceinline__ void transpose_block(const float* W, int N, int k0, int n0, bf16* WT, int ldk, int drow0, int kofs, LAS float* scr, int lane) {
    f32x4 wv[8];
#pragma unroll
    for (int i = 0; i < 8; ++i) wv[i] = __builtin_nontemporal_load((const f32x4*)(W + (size_t)(k0 + 8 * i + (lane >> 3)) * N + n0 + 4 * (lane & 7)));
#pragma unroll
    for (int i = 0; i < 8; ++i) { LAS float* d = scr + (8 * i + (lane >> 3)) * 33 + 4 * (lane & 7); d[0] = wv[i][0]; d[1] = wv[i][1]; d[2] = wv[i][2]; d[3] = wv[i][3]; }
    LDS_WAIT(); asm volatile("" ::: "memory");
    const int c = lane & 7;
#pragma unroll
    for (int j = 0; j < 4; ++j) { const int n = (lane >> 3) + 8 * j; const LAS float* s = scr + (8 * c) * 33 + n;
        v4u o; o.x = pk2(s[0 * 33], s[1 * 33]); o.y = pk2(s[2 * 33], s[3 * 33]); o.z = pk2(s[4 * 33], s[5 * 33]); o.w = pk2(s[6 * 33], s[7 * 33]);
        *(GAS v4u*)(WT + (size_t)(drow0 + n) * ldk + kofs + k0 + 8 * c) = o; }
    LDS_WAIT(); asm volatile("" ::: "memory");
}
__device__ __forceinline__ int win_row(int n0) {
    if (n0 < 1280) { const int t = n0 >> 8, w = n0 & 255; return (t << 8) + (((w >> 5) & 1) << 7) + ((w >> 6) << 5); }
    if (n0 < 4608) return n0;
    if (n0 < 5632) { const int i = n0 - 4608; return 4608 + ((i >> 7) << 8) + (i & 127); }
    { const int i = n0 - 5632; return 4608 + ((i >> 7) << 8) + 128 + (i & 127); }
}
__device__ __forceinline__ void p0_weights(Frame& F, int first) {
    LAS float* scr = (LAS float*)(F.lds + F.wave * 16384);
    if ((int)blockIdx.x < first) return;
    const int gw = (first ? (int)blockIdx.x - first : F.vcu) * NWAVES + F.wave, NGW = (F.G - first) * NWAVES;
    bf16* WIN_T = (bf16*)(F.ws + WS_WIN);
    for (int it = gw; it < 16 * 208; it += NGW) { const int kb = it / 208, nb = it % 208; transpose_block(F.in[I_WIN], INW, 64 * kb, 32 * nb, WIN_T, DM, win_row(32 * nb), 0, scr, F.lane); }
}
constexpr int TQ_TR = 200, TQ_ALL = 708;
__device__ __forceinline__ void tail_item(Frame& F, int it) {
    if (it < TQ_TR) {
        LAS float* scr = (LAS float*)(F.lds + F.wave * 16384);
        int r = 8 * it + F.wave;
        bf16* WPP = (bf16*)(F.ws + WS_WPP); bf16* WOUT_T = (bf16*)(F.ws + WS_WOUT);
        if (r < 512) { const int kb = r / 32, nb = r % 32; transpose_block(F.in[I_WPA], DM, 64 * kb, 32 * nb, WPP, 2048, 32 * nb, 0, scr, F.lane); return; } r -= 512;
        if (r < 512) { const int kb = r / 32, nb = r % 32; transpose_block(F.in[I_WPR], DM, 64 * kb, 32 * nb, WPP, 2048, 32 * nb, 1024, scr, F.lane); return; } r -= 512;
        if (r < 512) { const int kb = r / 32, nb = r % 32; transpose_block(F.in[I_WOUT], DM, 64 * kb, 32 * nb, WOUT_T, DM, 32 * nb, 0, scr, F.lane); return; } r -= 512;
        if (r < 32) { const int blk = r >> 1, nb = r & 1; transpose_block(F.in[I_WRA] + blk * 4096, 64, 0, 32 * nb, (bf16*)(F.ws + WS_WRA) + blk * 4096, 64, 32 * nb, 0, scr, F.lane); return; } r -= 32;
        { const int blk = r >> 1, nb = r & 1; transpose_block(F.in[I_WRX] + blk * 4096, 64, 0, 32 * nb, (bf16*)(F.ws + WS_WRX) + blk * 4096, 64, 32 * nb, 0, scr, F.lane); }
        return;
    }
    const int rbase = (it - TQ_TR) * 64 + 8 * F.wave;
    f32x4 v[8]; size_t dsto[8];
#pragma unroll
    for (int i = 0; i < 8; ++i) {
        const int rr = rbase + i, which = rr / 16256, r2 = rr % 16256, bs = r2 / 127, jj = r2 % 127;
        v[i] = __builtin_nontemporal_load((const f32x4*)F.in[which ? I_CV : I_CK] + ((size_t)bs * 128 + jj + 1) * 64 + F.lane);
        dsto[i] = (which ? O_VWS : O_KWS) / 4 + ((size_t)bs * 128 + jj) * 64 + F.lane;
    }
#pragma unroll
    for (int i = 0; i < 8; ++i) __builtin_nontemporal_store(v[i], (f32x4*)F.out + dsto[i]);
}

__device__ __forceinline__ void p0_mod_tile(Frame& F, int nt, unsigned* cntA, unsigned* cntB) {
    const float* wada = F.in[I_WADA]; const int lane = F.lane, w = F.wave;
    const int n0 = 16 * nt, kbase = 128 * w;
    const f32x4 bada4 = *(const f32x4*)(F.in[I_BADA] + n0 + (F.tid & 3) * 4);
    float bvv[4][8];
#pragma unroll
    for (int ks = 0; ks < 4; ++ks)
#pragma unroll
        for (int j = 0; j < 8; ++j) bvv[ks][j] = __builtin_nontemporal_load(wada + (size_t)(kbase + 32 * ks + 8 * (lane >> 4) + j) * 3072 + n0 + (lane & 15));
    const int l15 = lane & 15, kofs = kbase + 8 * (lane >> 4);
    LAS float* part = (LAS float*)F.lds;
    float* mod = (float*)(F.ws + WS_MOD);
    bf16x8 bfr[4];
    {
        const float* c0p = (l15 < 4 ? F.in[I_CP] + l15 * 1024 : F.in[I_CS] + (l15 - 4) * 1024) + kofs;
        f32x4 a0[4], a1[4];
#pragma unroll
        for (int ks = 0; ks < 4; ++ks) { a0[ks] = *(const f32x4*)(c0p + 32 * ks); a1[ks] = *(const f32x4*)(c0p + 32 * ks + 4); }
        f32x4 acc0 = (f32x4){0.f, 0.f, 0.f, 0.f};
#pragma unroll
        for (int ks = 0; ks < 4; ++ks) {
            v4u bw; bw.x = pk2(bvv[ks][0], bvv[ks][1]); bw.y = pk2(bvv[ks][2], bvv[ks][3]); bw.z = pk2(bvv[ks][4], bvv[ks][5]); bw.w = pk2(bvv[ks][6], bvv[ks][7]);
            bfr[ks] = __builtin_bit_cast(bf16x8, bw);
            v4u aw; aw.x = pk2(a0[ks].x, a0[ks].y); aw.y = pk2(a0[ks].z, a0[ks].w); aw.z = pk2(a1[ks].x, a1[ks].y); aw.w = pk2(a1[ks].z, a1[ks].w);
            acc0 = __builtin_amdgcn_mfma_f32_16x16x32_bf16(__builtin_bit_cast(bf16x8, aw), bfr[ks], acc0, 0, 0, 0);
        }
#pragma unroll
        for (int r = 0; r < 4; ++r) part[(w * 144 + 4 * (lane >> 4) + r) * 16 + l15] = acc0[r];
        __syncthreads();
        if (F.tid < 64) {
            const int row = F.tid >> 2, c4 = (F.tid & 3) * 4; f32x4 s = bada4;
#pragma unroll
            for (int ww = 0; ww < 8; ++ww) s += *(const LAS f32x4*)(part + (ww * 144 + row) * 16 + c4);
            const v4u sv = __builtin_bit_cast(v4u, s);
            unsigned long long* dst = (unsigned long long*)(mod + (size_t)row * 3072 + n0 + c4);
            __hip_atomic_store(dst, (unsigned long long)sv.x | ((unsigned long long)sv.y << 32), __ATOMIC_RELAXED, __HIP_MEMORY_SCOPE_AGENT);
            __hip_atomic_store(dst + 1, (unsigned long long)sv.z | ((unsigned long long)sv.w << 32), __ATOMIC_RELAXED, __HIP_MEMORY_SCOPE_AGENT);
        }
        if (cntA) soft_arrive(cntA, 1u);
    }
    {
        f32x4 acc[8];
#pragma unroll
        for (int m = 0; m < 8; ++m) acc[m] = (f32x4){0.f, 0.f, 0.f, 0.f};
#pragma unroll
        for (int ks = 0; ks < 4; ++ks) {
            f32x4 a0[8], a1[8];
#pragma unroll
            for (int m = 0; m < 8; ++m) {
                const int r = 16 * (m + 1) - 4 + l15;
                const float* cr = F.in[I_CS] + (size_t)(r < 128 ? r : 127) * 1024 + kofs + 32 * ks;
                a0[m] = *(const f32x4*)cr; a1[m] = *(const f32x4*)(cr + 4);
            }
#pragma unroll
            for (int m = 0; m < 8; ++m) {
                v4u aw; aw.x = pk2(a0[m].x, a0[m].y); aw.y = pk2(a0[m].z, a0[m].w); aw.z = pk2(a1[m].x, a1[m].y); aw.w = pk2(a1[m].z, a1[m].w);
                if (16 * (m + 1) + l15 >= 132) aw = (v4u){0u, 0u, 0u, 0u};
                acc[m] = __builtin_amdgcn_mfma_f32_16x16x32_bf16(__builtin_bit_cast(bf16x8, aw), bfr[ks], acc[m], 0, 0, 0);
            }
        }
#pragma unroll
        for (int m = 0; m < 8; ++m)
#pragma unroll
            for (int r = 0; r < 4; ++r) part[(w * 144 + 16 * (m + 1) + 4 * (lane >> 4) + r) * 16 + l15] = acc[m][r];
        __syncthreads();
        for (int e = 64 + F.tid; e < 132 * 4; e += NWAVES * 64) {
            const int row = e >> 2, c4 = (e & 3) * 4; f32x4 s = bada4;
#pragma unroll
            for (int ww = 0; ww < 8; ++ww) s += *(const LAS f32x4*)(part + (ww * 144 + row) * 16 + c4);
            const v4u sv = __builtin_bit_cast(v4u, s);
            unsigned long long* dst = (unsigned long long*)(mod + (size_t)row * 3072 + n0 + c4);
            __hip_atomic_store(dst, (unsigned long long)sv.x | ((unsigned long long)sv.y << 32), __ATOMIC_RELAXED, __HIP_MEMORY_SCOPE_AGENT);
            __hip_atomic_store(dst + 1, (unsigned long long)sv.z | ((unsigned long long)sv.w << 32), __ATOMIC_RELAXED, __HIP_MEMORY_SCOPE_AGENT);
        }
        if (cntB) soft_arrive(cntB, 1u);
        __syncthreads();
    }
}
__device__ __forceinline__ float wave_sum(float v) {
#pragma unroll
    for (int o = 1; o < 64; o <<= 1) v += __shfl_xor(v, o);
    return v;
}
__device__ __forceinline__ const float* xn_src_row(Frame& F, int m) { return m < MP ? F.in[I_XP] + (size_t)m * DM : F.in[I_XS] + (size_t)(m - MP) * DM; }
constexpr int XN_NR = 9;
__device__ __forceinline__ void xn_chunk_issue(Frame& F, int mb, int rend, f32x4 (&xr)[XN_NR][4]) {
#pragma unroll
    for (int k = 0; k < XN_NR; ++k) {
        const int m = mb + NWAVES * k, mc = m < MALL ? m : MALL - 1;
        const f32x4* xp = (const f32x4*)xn_src_row(F, mc) + F.lane;
#pragma unroll
        for (int j = 0; j < 4; ++j) xr[k][j] = __builtin_nontemporal_load(xp + 64 * j);
    }
    __builtin_amdgcn_sched_barrier(0);
}
__device__ __forceinline__ void xn_chunk_reduce(Frame& F, int mb, int rend, const f32x4 (&xr)[XN_NR][4], float (&rs)[XN_NR]) {
#pragma unroll
    for (int k = 0; k < XN_NR; ++k) {
        const int m = mb + NWAVES * k; rs[k] = 0.f;
        if (m < rend && m < MALL) {
            float s = 0.f;
#pragma unroll
            for (int j = 0; j < 4; ++j) s += (xr[k][j].x * xr[k][j].x + xr[k][j].y * xr[k][j].y) + (xr[k][j].z * xr[k][j].z + xr[k][j].w * xr[k][j].w);
            rs[k] = 1.0f / sqrtf(wave_sum(s) * (1.f / DM) + EPSN);
        }
    }
}
__device__ __forceinline__ void xn_chunk_store(Frame& F, int mb, int rend, const f32x4 (&xr)[XN_NR][4], const float (&rs)[XN_NR], const f32x4 (&gvec)[4], int& mr_c, f32x4 (&scv)[4], f32x4 (&shv)[4]) {
    const float* mod = (const float*)(F.ws + WS_MOD); bf16* XN = (bf16*)(F.ws + WS_XN);
#pragma unroll
    for (int k = 0; k < XN_NR; ++k) {
        const int m = mb + NWAVES * k;
        if (m >= rend) continue;
        GAS unsigned long long* o8 = (GAS unsigned long long*)(XN + (size_t)m * DM) + F.lane;
        if (m >= MALL) {
#pragma unroll
            for (int j = 0; j < 4; ++j) o8[64 * j] = 0ull;
            continue;
        }
        const int mr = m < MP ? (m >> 12) : 4 + (m - MP);
        if (mr != mr_c) {
            const f32x4* sh = (const f32x4*)(mod + (size_t)mr * 3072) + F.lane; const f32x4* sc = sh + 256;
#pragma unroll
            for (int j = 0; j < 4; ++j) { scv[j] = sc[64 * j] + 1.0f; shv[j] = sh[64 * j]; }
            mr_c = mr;
        }
        unsigned long long ov[4];
#pragma unroll
        for (int j = 0; j < 4; ++j) {
            const f32x4 y = xr[k][j] * rs[k] * gvec[j] * scv[j] + shv[j];
            ov[j] = (unsigned long long)pk2(y.x, y.y) | ((unsigned long long)pk2(y.z, y.w) << 32);
        }
#pragma unroll
        for (int j = 0; j < 4; ++j) o8[64 * j] = ov[j];
    }
}
__device__ __forceinline__ void p1_xn(Frame& F, unsigned* modc) {
    const int RPB = (MPAD + F.G - 1) / F.G, rbeg = F.vcu * RPB, rend = (rbeg + RPB < MPAD) ? rbeg + RPB : MPAD;
    const f32x4* gp = (const f32x4*)F.in[I_NG] + F.lane;
    f32x4 gvec[4];
#pragma unroll
    for (int j = 0; j < 4; ++j) gvec[j] = gp[64 * j];
    int mr_c = -1; f32x4 scv[4], shv[4];
#pragma unroll
    for (int j = 0; j < 4; ++j) { scv[j] = (f32x4){0.f, 0.f, 0.f, 0.f}; shv[j] = scv[j]; }
    f32x4 xr[XN_NR][4]; float rs[XN_NR];
    int mb = rbeg + F.wave;
    xn_chunk_issue(F, mb, rend, xr);
    soft_wait(modc, 128u);
    if (rend > MP) soft_wait(modc + (CW_MODB - CW_MODC), 128u);
    xn_chunk_reduce(F, mb, rend, xr, rs);
    xn_chunk_store(F, mb, rend, xr, rs, gvec, mr_c, scv, shv);
    for (mb += XN_NR * NWAVES; mb < rend; mb += XN_NR * NWAVES) { xn_chunk_issue(F, mb, rend, xr); xn_chunk_reduce(F, mb, rend, xr, rs); xn_chunk_store(F, mb, rend, xr, rs, gvec, mr_c, scv, shv); }
}

struct EpiZ {
    static constexpr bool PERM = true, HAS_MID = false;
    unsigned char* ws; float* out; const float* qg; const float* kg;
    __device__ __forceinline__ void mid(pg8::f32x4 (&)[2][2][4][2], const pg8::Unit&, int, int, int, int) const {}
    __device__ __forceinline__ void operator()(const pg8::f32x4 (&acc)[2][2][4][2], const pg8::Unit& u, int wr, int wc, int fr, int fq) const {
        asm volatile("" : "+v"(fr), "+v"(fq));
        const int pn = u.pn, pm = u.pm;
        const int rloc = wr * 64 + fr;
        const size_t row0 = (size_t)pm * 256 + rloc;
        if (pn < 5) {
            const bool isq = pn < 4;
            const float* gsrc = (isq ? qg : kg) + 8 * fq;
            f32x4 gv[2][2];
#pragma unroll
            for (int bj = 0; bj < 2; ++bj)
#pragma unroll
                for (int n = 0; n < 2; ++n) gv[bj][n] = *(const f32x4*)(gsrc + 32 * bj + 4 * n);
            const float sc = isq ? QSCALE : 1.0f;
            bf16* dst; int ld, colb;
            if (isq) { dst = (pm < 64) ? (bf16*)(out + O_YP) + QM_OFF + row0 * DM : (bf16*)(ws + WS_QT) + (size_t)rloc * DM; ld = DM; colb = (4 * pn + wc) * 64 + 8 * fq; }
            else { dst = (bf16*)(ws + WS_K) + row0 * 256; ld = 256; colb = wc * 64 + 8 * fq; }
#pragma unroll
            for (int ai = 0; ai < 2; ++ai)
#pragma unroll
                for (int m = 0; m < 4; ++m) {
                    float ss = 0.f;
#pragma unroll
                    for (int bj = 0; bj < 2; ++bj)
#pragma unroll
                        for (int n = 0; n < 2; ++n) { const f32x4 x = acc[ai][bj][m][n]; ss += (x[0] * x[0] + x[1] * x[1]) + (x[2] * x[2] + x[3] * x[3]); }
                    ss += __shfl_xor(ss, 16); ss += __shfl_xor(ss, 32);
                    const float rs = sc / sqrtf(ss * (1.0f / 64.0f) + EPSN);
                    bf16* rp = dst + (size_t)(ai * 128 + m * 16) * ld + colb;
#pragma unroll
                    for (int bj = 0; bj < 2; ++bj) {
                        const f32x4 v0 = acc[ai][bj][m][0] * rs * gv[bj][0], v1 = acc[ai][bj][m][1] * rs * gv[bj][1];
                        v4u w; w.x = pg8::cvt_pk_bf16(v0[0], v0[1]); w.y = pg8::cvt_pk_bf16(v0[2], v0[3]); w.z = pg8::cvt_pk_bf16(v1[0], v1[1]); w.w = pg8::cvt_pk_bf16(v1[2], v1[3]);
                        *(v4u*)(rp + 32 * bj) = w;
                        if (!isq) {
                            float* so = nullptr;
                            if (pm < 64 && (pm & 15) == 15 && ai == 1) so = out + O_KWP + ((size_t)(pm >> 4) * 128 + (wr * 64 + m * 16 + fr)) * 256;
                            else if (pm == 64 && ai == 0) so = (float*)(ws + WS_KVNEW) + (size_t)(wr * 64 + m * 16 + fr) * 256;
                            if (so) { so += wc * 64 + 32 * bj + 8 * fq; *(f32x4*)so = v0; *(f32x4*)(so + 4) = v1; }
                        }
                    }
                }
            return;
        }
        if (pn == 5) {
            bf16* dst = (bf16*)(ws + WS_V) + row0 * 256 + 32 * wc + 8 * fq;
#pragma unroll
            for (int ai = 0; ai < 2; ++ai)
#pragma unroll
                for (int m = 0; m < 4; ++m)
#pragma unroll
                    for (int bj = 0; bj < 2; ++bj) {
                        const f32x4 v0 = acc[ai][bj][m][0], v1 = acc[ai][bj][m][1];
                        v4u w; w.x = pg8::cvt_pk_bf16(v0[0], v0[1]); w.y = pg8::cvt_pk_bf16(v0[2], v0[3]); w.z = pg8::cvt_pk_bf16(v1[0], v1[1]); w.w = pg8::cvt_pk_bf16(v1[2], v1[3]);
                        *(v4u*)(dst + (size_t)(ai * 128 + m * 16) * 256 + 128 * bj) = w;
                        float* so = nullptr;
                        if (pm < 64 && (pm & 15) == 15 && ai == 1) so = out + O_VWP + ((size_t)(pm >> 4) * 128 + (wr * 64 + m * 16 + fr)) * 256;
                        else if (pm == 64 && ai == 0) so = (float*)(ws + WS_KVNEW) + 128 * 256 + (size_t)(wr * 64 + m * 16 + fr) * 256;
                        if (so) { so += 128 * bj + 32 * wc + 8 * fq; *(f32x4*)so = v0; *(f32x4*)(so + 4) = v1; }
                    }
            return;
        }
        if (pn < 18) {
            const int seg = (pn - 6) >> 2;
            const int colt = ((pn - 6) & 3) * 256 + 32 * wc + 8 * fq;
            bf16* dst = (bf16*)(ws + (seg == 0 ? WS_SGA : seg == 1 ? WS_XR : WS_SGR)) + row0 * DM + colt;
#pragma unroll
            for (int ai = 0; ai < 2; ++ai)
#pragma unroll
                for (int m = 0; m < 4; ++m)
#pragma unroll
                    for (int bj = 0; bj < 2; ++bj) {
                        f32x4 v0 = acc[ai][bj][m][0], v1 = acc[ai][bj][m][1];
                        if (seg != 1) {
#pragma unroll
                            for (int e = 0; e < 4; ++e) { v0[e] = v0[e] * sigm(v0[e]); v1[e] = v1[e] * sigm(v1[e]); }
                        }
                        v4u w; w.x = pg8::cvt_pk_bf16(v0[0], v0[1]); w.y = pg8::cvt_pk_bf16(v0[2], v0[3]); w.z = pg8::cvt_pk_bf16(v1[0], v1[1]); w.w = pg8::cvt_pk_bf16(v1[2], v1[3]);
                        *(v4u*)(dst + (size_t)(ai * 128 + m * 16) * DM + 128 * bj) = w;
                        if (seg == 1 && pm < 64 && (pm & 15) == 15 && ai == 1 && wr == 1 && m == 3 && fr >= 13) {
                            float* so = out + O_CVP + ((size_t)(pm >> 4) * 3 + (fr - 13)) * DM + colt + 128 * bj;
                            *(f32x4*)so = v0; *(f32x4*)(so + 4) = v1;
                        }
                    }
            return;
        }
        {
            const int colt = (pn - 18) * 128 + 32 * wc + 8 * fq;
            const size_t rw = ((size_t)pm * 256 + rloc + 16 * (fq & 1)) * DM + (pn - 18) * 128 + 32 * wc + 8 * (fq & ~1);
            unsigned char* da = ws + WS_RAT + rw; unsigned char* ds = ws + WS_SMR + rw;
#pragma unroll
            for (int ai = 0; ai < 2; ++ai)
#pragma unroll
                for (int mp = 0; mp < 2; ++mp) {
                    v2u wa[2], wm[2];
#pragma unroll
                    for (int h = 0; h < 2; ++h) {
                        const int m = 2 * mp + h;
                        float sa[8], sm[8];
#pragma unroll
                        for (int n = 0; n < 2; ++n)
#pragma unroll
                            for (int e = 0; e < 4; ++e) { sa[4 * n + e] = sigm(acc[ai][0][m][n][e]); sm[4 * n + e] = sigm(acc[ai][1][m][n][e]); }
                        wa[h].x = pk_u8x4(sa[0], sa[1], sa[2], sa[3]); wa[h].y = pk_u8x4(sa[4], sa[5], sa[6], sa[7]);
                        wm[h].x = pk_u8x4(sm[0], sm[1], sm[2], sm[3]); wm[h].y = pk_u8x4(sm[4], sm[5], sm[6], sm[7]);
                    }
                    const auto ax = __builtin_amdgcn_permlane16_swap(wa[0].x, wa[1].x, false, false), ay = __builtin_amdgcn_permlane16_swap(wa[0].y, wa[1].y, false, false);
                    const auto mx = __builtin_amdgcn_permlane16_swap(wm[0].x, wm[1].x, false, false), my = __builtin_amdgcn_permlane16_swap(wm[0].y, wm[1].y, false, false);
                    *(v4u*)(da + (size_t)(ai * 128 + mp * 32) * DM) = (v4u){(unsigned)ax[0], (unsigned)ay[0], (unsigned)ax[1], (unsigned)ay[1]};
                    *(v4u*)(ds + (size_t)(ai * 128 + mp * 32) * DM) = (v4u){(unsigned)mx[0], (unsigned)my[0], (unsigned)mx[1], (unsigned)my[1]};
                }
        }
    }
};

struct EpiMerge {
    static constexpr bool PERM = true, HAS_MID = true;
    const unsigned char* sma; const unsigned char* smr; bf16* mg;
    __device__ __forceinline__ void mid(pg8::f32x4 (&acc)[2][2][4][2], const pg8::Unit& u, int wr, int wc, int fr, int fq) const {
        asm volatile("" : "+v"(fr), "+v"(fq));
        const size_t offw = ((size_t)u.pm * 256 + wr * 64 + fr + 16 * (fq & 1)) * DM + u.pn * 256 + 32 * wc + 8 * (fq & ~1);
        v4u la[8], lr[8];
#pragma unroll
        for (int ai = 0; ai < 2; ++ai)
#pragma unroll
            for (int mp = 0; mp < 2; ++mp)
#pragma unroll
                for (int bj = 0; bj < 2; ++bj) {
                    const size_t o = offw + (size_t)(ai * 128 + mp * 32) * DM + 128 * bj;
                    la[(ai * 2 + mp) * 2 + bj] = *(const v4u*)(sma + o); lr[(ai * 2 + mp) * 2 + bj] = *(const v4u*)(smr + o);
                }
        __builtin_amdgcn_sched_barrier(0);
        v2u ga[16], gr[16];
#pragma unroll
        for (int ai = 0; ai < 2; ++ai)
#pragma unroll
            for (int mp = 0; mp < 2; ++mp)
#pragma unroll
                for (int bj = 0; bj < 2; ++bj) {
                    const v4u A = la[(ai * 2 + mp) * 2 + bj], R = lr[(ai * 2 + mp) * 2 + bj];
                    const auto a0 = __builtin_amdgcn_permlane16_swap(A.x, A.z, false, false), a1 = __builtin_amdgcn_permlane16_swap(A.y, A.w, false, false);
                    const auto r0 = __builtin_amdgcn_permlane16_swap(R.x, R.z, false, false), r1 = __builtin_amdgcn_permlane16_swap(R.y, R.w, false, false);
                    ga[(ai * 4 + 2 * mp) * 2 + bj] = (v2u){(unsigned)a0[0], (unsigned)a1[0]}; ga[(ai * 4 + 2 * mp + 1) * 2 + bj] = (v2u){(unsigned)a0[1], (unsigned)a1[1]};
                    gr[(ai * 4 + 2 * mp) * 2 + bj] = (v2u){(unsigned)r0[0], (unsigned)r1[0]}; gr[(ai * 4 + 2 * mp + 1) * 2 + bj] = (v2u){(unsigned)r0[1], (unsigned)r1[1]};
                }
#pragma unroll
        for (int ai = 0; ai < 2; ++ai)
#pragma unroll
            for (int m = 0; m < 4; ++m)
#pragma unroll
                for (int bj = 0; bj < 2; ++bj) {
                    const v2u a = ga[(ai * 4 + m) * 2 + bj], r = gr[(ai * 4 + m) * 2 + bj];
                    acc[ai][bj][m][0] *= (pg8::f32x4){u8f(a.x, 0) * frcp(u8f(r.x, 0)), u8f(a.x, 1) * frcp(u8f(r.x, 1)), u8f(a.x, 2) * frcp(u8f(r.x, 2)), u8f(a.x, 3) * frcp(u8f(r.x, 3))};
                    acc[ai][bj][m][1] *= (pg8::f32x4){u8f(a.y, 0) * frcp(u8f(r.y, 0)), u8f(a.y, 1) * frcp(u8f(r.y, 1)), u8f(a.y, 2) * frcp(u8f(r.y, 2)), u8f(a.y, 3) * frcp(u8f(r.y, 3))};
                }
    }
    __device__ __forceinline__ void operator()(const pg8::f32x4 (&acc)[2][2][4][2], const pg8::Unit& u, int wr, int wc, int fr, int fq) const {
        asm volatile("" : "+v"(fr), "+v"(fq));
        const size_t off = ((size_t)u.pm * 256 + wr * 64 + fr) * DM + u.pn * 256 + 32 * wc + 8 * fq;
        const float i255 = 1.0f / 255.0f;
        const size_t offw = ((size_t)u.pm * 256 + wr * 64 + fr + 16 * (fq & 1)) * DM + u.pn * 256 + 32 * wc + 8 * (fq & ~1);
        v4u lr[8];
#pragma unroll
        for (int ai = 0; ai < 2; ++ai)
#pragma unroll
            for (int mp = 0; mp < 2; ++mp)
#pragma unroll
                for (int bj = 0; bj < 2; ++bj) lr[(ai * 2 + mp) * 2 + bj] = *(const v4u*)(smr + offw + (size_t)(ai * 128 + mp * 32) * DM + 128 * bj);
        __builtin_amdgcn_sched_barrier(0);
        v2u gr[16];
#pragma unroll
        for (int ai = 0; ai < 2; ++ai)
#pragma unroll
            for (int mp = 0; mp < 2; ++mp)
#pragma unroll
                for (int bj = 0; bj < 2; ++bj) {
                    const v4u R = lr[(ai * 2 + mp) * 2 + bj];
                    const auto r0 = __builtin_amdgcn_permlane16_swap(R.x, R.z, false, false), r1 = __builtin_amdgcn_permlane16_swap(R.y, R.w, false, false);
                    gr[(ai * 4 + 2 * mp) * 2 + bj] = (v2u){(unsigned)r0[0], (unsigned)r1[0]}; gr[(ai * 4 + 2 * mp + 1) * 2 + bj] = (v2u){(unsigned)r0[1], (unsigned)r1[1]};
                }
#pragma unroll
        for (int ai = 0; ai < 2; ++ai)
#pragma unroll
            for (int m = 0; m < 4; ++m)
#pragma unroll
                for (int bj = 0; bj < 2; ++bj) {
                    const size_t o = off + (size_t)(ai * 128 + m * 16) * DM + 128 * bj;
                    const v2u r = gr[(ai * 4 + m) * 2 + bj];
                    const pg8::f32x4 v0 = acc[ai][bj][m][0] * ((pg8::f32x4){u8f(r.x, 0), u8f(r.x, 1), u8f(r.x, 2), u8f(r.x, 3)} * i255);
                    const pg8::f32x4 v1 = acc[ai][bj][m][1] * ((pg8::f32x4){u8f(r.y, 0), u8f(r.y, 1), u8f(r.y, 2), u8f(r.y, 3)} * i255);
                    v4u w; w.x = pg8::cvt_pk_bf16(v0[0], v0[1]); w.y = pg8::cvt_pk_bf16(v0[2], v0[3]); w.z = pg8::cvt_pk_bf16(v1[0], v1[1]); w.w = pg8::cvt_pk_bf16(v1[2], v1[3]);
                    *(v4u*)(mg + o) = w;
                }
    }
};
struct EpiOut {
    static constexpr bool PERM = false, HAS_MID = false;
    const float* x; const float* mod; float* y; LAS unsigned char* stg;
    __device__ __forceinline__ void mid(pg8::f32x4 (&)[2][2][4][2], const pg8::Unit&, int, int, int, int) const {}
    __device__ __forceinline__ void operator()(const pg8::f32x4 (&acc)[2][2][4][2], const pg8::Unit& u, int wr, int wc, int fr, int fq) const {
        asm volatile("" : "+v"(fr), "+v"(fq));
        const int lane = fr + 16 * fq, lrow = lane >> 3, lchk = lane & 7;
        const int col0 = u.pn * 256 + wc * 32 + 4 * fq;
        const float* gp = mod + (size_t)(u.pm >> 4) * 3072 + 2048 + col0;
        f32x4 gv[2][2];
#pragma unroll
        for (int bj = 0; bj < 2; ++bj)
#pragma unroll
            for (int n = 0; n < 2; ++n) gv[bj][n] = *(const f32x4*)(gp + 128 * bj + 16 * n);
        LAS unsigned char* st = stg + (wr * 4 + wc) * (16 * 144);
#pragma unroll
        for (int ai = 0; ai < 2; ++ai) {
            f32x4 xv[4][2][2];
            const size_t rowb = ((size_t)u.pm * 256 + ai * 128 + wr * 64 + lrow) * DM + u.pn * 256 + wc * 32 + 4 * lchk;
#pragma unroll
            for (int m = 0; m < 4; ++m)
#pragma unroll
                for (int bj = 0; bj < 2; ++bj)
#pragma unroll
                    for (int h = 0; h < 2; ++h) xv[m][bj][h] = __builtin_nontemporal_load((const f32x4*)(x + rowb + (size_t)(m * 16 + 8 * h) * DM + 128 * bj));
            __builtin_amdgcn_sched_barrier(0);
#pragma unroll
            for (int m = 0; m < 4; ++m)
#pragma unroll
                for (int bj = 0; bj < 2; ++bj) {
#pragma unroll
                    for (int n = 0; n < 2; ++n) *(LAS f32x4*)(st + fr * 144 + 64 * n + 16 * fq) = gv[bj][n] * acc[ai][bj][m][n];
                    asm volatile("s_waitcnt lgkmcnt(0)" ::: "memory");
                    f32x4 t[2];
#pragma unroll
                    for (int h = 0; h < 2; ++h) t[h] = *(const LAS f32x4*)(st + (8 * h + lrow) * 144 + 16 * lchk);
                    asm volatile("s_waitcnt lgkmcnt(0)" ::: "memory");
#pragma unroll
                    for (int h = 0; h < 2; ++h) *(f32x4*)(y + rowb + (size_t)(m * 16 + 8 * h) * DM + 128 * bj) = xv[m][bj][h] + t[h];
                }
            __builtin_amdgcn_sched_barrier(0);
        }
    }
};

template <int KQ  >
__device__ __forceinline__ f32x4 mini_partial(const bf16* A, const bf16* B, unsigned* seam, unsigned need) {
    bf16x8 a[KQ], b[KQ];
#pragma unroll
    for (int ks = 0; ks < KQ; ++ks) b[ks] = *(const bf16x8*)(B + 32 * ks);
    if (seam) soft_wait(seam, need);
#pragma unroll
    for (int ks = 0; ks < KQ; ++ks) a[ks] = *(const bf16x8*)(A + 32 * ks);
    f32x4 acc = (f32x4){0.f, 0.f, 0.f, 0.f};
#pragma unroll
    for (int ks = 0; ks < KQ; ++ks) acc = __builtin_amdgcn_mfma_f32_16x16x32_bf16(a[ks], b[ks], acc, 0, 0, 0);
    return acc;
}
__device__ __forceinline__ void mini_merge_block(Frame& F, int pair, unsigned* seam, unsigned need) {
    const int lane = F.lane, w = F.wave, tile = 2 * pair + (w >> 2), kq = w & 3, rt = tile >> 6, ct = tile & 63;
    const bf16* A = (const bf16*)(F.ws + WS_YT) + (size_t)(16 * rt + (lane & 15)) * 2048 + 8 * (lane >> 4) + 512 * kq;
    const bf16* B = (const bf16*)(F.ws + WS_WPP) + (size_t)(16 * ct + (lane & 15)) * 2048 + 8 * (lane >> 4) + 512 * kq;
    const int t2 = F.tid >> 8, e = F.tid & 255, row = e >> 4, col = e & 15, tl = 2 * pair + t2, rl = 16 * (tl >> 6) + row, cg = 16 * (tl & 63) + col;
    const unsigned char ga_ = (F.ws + WS_RAT)[(size_t)(MP + rl) * DM + cg], gr_ = (F.ws + WS_SMR)[(size_t)(MP + rl) * DM + cg];
    const f32x4 acc = mini_partial<16>(A, B, seam, need);
    LAS float* part = (LAS float*)F.lds;
#pragma unroll
    for (int r = 0; r < 4; ++r) part[w * 256 + (4 * (lane >> 4) + r) * 16 + (lane & 15)] = acc[r];
    __syncthreads();
    {
        const LAS float* p = part + t2 * 1024 + e;
        const float sa_ = (float)ga_, sr_ = (float)gr_;
        const float rat = sa_ / sr_, sm = sr_ * (1.0f / 255.0f);
        const float v = ((p[0] + p[256]) * rat + (p[512] + p[768])) * sm;
        const unsigned mine = f2bf(v), other = (unsigned)__shfl_xor((int)mine, 1);
        if ((col & 1) == 0) __hip_atomic_store((unsigned*)((bf16*)(F.ws + WS_MGT) + (size_t)rl * DM + cg), mine | (other << 16), __ATOMIC_RELAXED, __HIP_MEMORY_SCOPE_AGENT);
    }
    __syncthreads();
}
__device__ __forceinline__ void mini_out_block(Frame& F, int pair, unsigned* seam, unsigned need) {
    const int lane = F.lane, w = F.wave, tile = 2 * pair + (w >> 2), kq = w & 3, rt = tile >> 6, ct = tile & 63;
    const bf16* A = (const bf16*)(F.ws + WS_MGT) + (size_t)(16 * rt + (lane & 15)) * DM + 8 * (lane >> 4) + 256 * kq;
    const bf16* B = (const bf16*)(F.ws + WS_WOUT) + (size_t)(16 * ct + (lane & 15)) * DM + 8 * (lane >> 4) + 256 * kq;
    const int t2 = F.tid >> 8, e = F.tid & 255, row = e >> 4, col = e & 15, tl = 2 * pair + t2, rl = 16 * (tl >> 6) + row, cg = 16 * (tl & 63) + col;
    const float xs_ = F.in[I_XS][(size_t)rl * DM + cg], gt_ = ((const float*)(F.ws + WS_MOD))[(size_t)(4 + rl) * 3072 + 2048 + cg];
    const f32x4 acc = mini_partial<8>(A, B, seam, need);
    LAS float* part = (LAS float*)F.lds;
#pragma unroll
    for (int r = 0; r < 4; ++r) part[w * 256 + (4 * (lane >> 4) + r) * 16 + (lane & 15)] = acc[r];
    __syncthreads();
    {
        const LAS float* p = part + t2 * 1024 + e;
        F.out[O_YS + (size_t)rl * DM + cg] = xs_ + gt_ * ((p[0] + p[256]) + (p[512] + p[768]));
    }
    __syncthreads();
}

struct ChanConst { float w0, w1, w2, w3, bc, bra, brx, c1, nbra, nbrx; };
__device__ __forceinline__ ChanConst chan_const(Frame& F, int ch) {
    ChanConst c; const float* wc = F.in[I_WCONV];
    c.w0 = wc[ch]; c.w1 = wc[DM + ch]; c.w2 = wc[2 * DM + ch]; c.w3 = wc[3 * DM + ch]; c.bc = F.in[I_BCONV][ch];
    c.bra = F.in[I_BRA][ch]; c.brx = F.in[I_BRX][ch];
    c.c1 = -8.0f * log1pf(expf(-F.in[I_LAM][ch])) * LOG2E;
    c.nbra = -LOG2E * c.bra; c.nbrx = -LOG2E * c.brx;
    return c;
}
__device__ __forceinline__ void sample_rnn_unit(Frame& F, int bs, int j);
__device__ __forceinline__ void sample_rnn_body(Frame& F, int bs, int j, const ChanConst cc);
__device__ __forceinline__ void stage_gate_weights_direct(Frame& F, int j) {
    float wv[16];
#pragma unroll
    for (int i = 0; i < 16; ++i) { const int idx = F.tid + 512 * i, gsel = idx >> 12; wv[i] = (gsel ? F.in[I_WRX] : F.in[I_WRA])[j * 4096 + (idx & 4095)]; }
#pragma unroll
    for (int i = 0; i < 16; ++i) { const int idx = F.tid + 512 * i, gsel = idx >> 12, k = (idx >> 6) & 63, n = idx & 63;
        *(LAS unsigned short*)(F.lds + GW_OFF + (gsel * 64 + n) * GW_STRIDE + 2 * k) = (unsigned short)f2bf(wv[i]); }
}
__device__ __forceinline__ void stage_gate_weights(Frame& F, int j) {
    for (int cidx = F.tid; cidx < 1024; cidx += NWAVES * 64) {
        const int gsel = cidx >> 9, row = (cidx >> 3) & 63, c8 = cidx & 7;
        const v4u v = *(const v4u*)((const bf16*)(F.ws + (gsel ? WS_WRX : WS_WRA)) + j * 4096 + row * 64 + 8 * c8);
        *(LAS v4u*)(F.lds + GW_OFF + (gsel * 64 + row) * GW_STRIDE + 16 * c8) = v;
    }
}
template <int PASS>
__device__ __forceinline__ void scan_unit(Frame& F, int b, int c, int j, LAS unsigned char* wl) {
    const int lane = F.lane, r32 = lane & 31, hi = lane >> 5, ch = 64 * j + lane;
    const ChanConst cc = chan_const(F, ch);
    const bf16* XR = (const bf16*)(F.ws + WS_XR); const bf16* SGR = (const bf16*)(F.ws + WS_SGR);
    float* agg = (float*)(F.ws + WS_AGG);
    bf16* YM = (bf16*)(F.out + O_YP);
    LAS bf16* xt = (LAS bf16*)wl; LAS bf16* st = (LAS bf16*)(wl + 4096); LAS float* gt = (LAS float*)(wl + 8192);
    const size_t rowb = (size_t)b * SEQ + 128 * c;
    const int lrow = lane >> 3, lc8 = lane & 7;
    const bf16* xsrc = XR + (rowb + lrow) * DM + 64 * j + 8 * lc8;
    const bf16* ssrc = SGR + (rowb + lrow) * DM + 64 * j + 8 * lc8;
    v4u xn[4], sn[4];
#pragma unroll
    for (int i = 0; i < 4; ++i) { xn[i] = *(const v4u*)(xsrc + (size_t)(8 * i) * DM); if (PASS == 2) sn[i] = *(const v4u*)(ssrc + (size_t)(8 * i) * DM); }
    float xm3 = 0.f, xm2 = 0.f, xm1 = 0.f;
    if (c > 0) { xm3 = bf2f(XR[(rowb - 3) * DM + ch]); xm2 = bf2f(XR[(rowb - 2) * DM + ch]); xm1 = bf2f(XR[(rowb - 1) * DM + ch]); }
    float h = 0.f, ap = 1.f;
    if (PASS == 2) {
        for (int q = 0; q < c; ++q) { const float a = agg[((size_t)(b * NCH + q) * 2 + 0) * DM + ch], hl = agg[((size_t)(b * NCH + q) * 2 + 1) * DM + ch]; h = a * h + hl; }
    }
    const LAS unsigned char* gwr = F.lds + GW_OFF + r32 * GW_STRIDE + 16 * hi;
    for (int sc = 0; sc < 4; ++sc) {
        const size_t r0 = rowb + 32 * sc;
#pragma unroll
        for (int i = 0; i < 4; ++i) { *(LAS v4u*)(xt + (lrow + 8 * i) * 64 + 8 * lc8) = xn[i]; if (PASS == 2) *(LAS v4u*)(st + (lrow + 8 * i) * 64 + 8 * lc8) = sn[i]; }
        if (sc < 3) {
#pragma unroll
            for (int i = 0; i < 4; ++i) { xn[i] = *(const v4u*)(xsrc + (size_t)(32 * (sc + 1) + 8 * i) * DM); if (PASS == 2) sn[i] = *(const v4u*)(ssrc + (size_t)(32 * (sc + 1) + 8 * i) * DM); }
        }
        LDS_WAIT(); asm volatile("" ::: "memory");
        float xc[32];
#pragma unroll
        for (int t = 0; t < 32; ++t) {
            const float x = bf2f(xt[t * 64 + lane]);
            xc[t] = cc.bc + cc.w0 * xm3 + cc.w1 * xm2 + cc.w2 * xm1 + cc.w3 * x;
            xm3 = xm2; xm2 = xm1; xm1 = x;
            xt[t * 64 + lane] = (bf16)pg8::cvt_pk_bf16(xc[t], 0.f);
        }
        LDS_WAIT(); asm volatile("" ::: "memory");
        bf16x8 af[4];
#pragma unroll
        for (int d0 = 0; d0 < 4; ++d0) af[d0] = *(const LAS bf16x8*)(xt + r32 * 64 + 16 * d0 + 8 * hi);
        float zr[32];
#pragma unroll
        for (int oh = 0; oh < 2; ++oh) {
            f32x16 d = {};
#pragma unroll
            for (int d0 = 0; d0 < 4; ++d0) d = __builtin_amdgcn_mfma_f32_32x32x16_bf16(af[d0], *(const LAS bf16x8*)(gwr + (32 * oh) * GW_STRIDE + 32 * d0), d, 0, 0, 0);
#pragma unroll
            for (int r = 0; r < 16; ++r) gt[((r & 3) + 8 * (r >> 2) + 4 * hi) * 64 + 32 * oh + r32] = d[r];
        }
        LDS_WAIT(); asm volatile("" ::: "memory");
#pragma unroll
        for (int t = 0; t < 32; ++t) zr[t] = gt[t * 64 + lane];
        LDS_WAIT(); asm volatile("" ::: "memory");
#pragma unroll
        for (int oh = 0; oh < 2; ++oh) {
            f32x16 d = {};
#pragma unroll
            for (int d0 = 0; d0 < 4; ++d0) d = __builtin_amdgcn_mfma_f32_32x32x16_bf16(af[d0], *(const LAS bf16x8*)(gwr + (64 + 32 * oh) * GW_STRIDE + 32 * d0), d, 0, 0, 0);
#pragma unroll
            for (int r = 0; r < 16; ++r) gt[((r & 3) + 8 * (r >> 2) + 4 * hi) * 64 + 32 * oh + r32] = d[r];
        }
        LDS_WAIT(); asm volatile("" ::: "memory");
#pragma unroll
        for (int t = 0; t < 32; ++t) {
            const float zi = gt[t * 64 + lane];
            const float rg = frcp(1.0f + fexp2(__builtin_fmaf(zr[t], -LOG2E, cc.nbra))), ig = frcp(1.0f + fexp2(__builtin_fmaf(zi, -LOG2E, cc.nbrx)));
            const float a = fexp2(cc.c1 * rg);
            const float s = __builtin_amdgcn_sqrtf(__builtin_fmaf(-a, a, 1.0f));
            const float uu = s * ig * xc[t];
            h = a * h + uu;
            if (PASS == 1) ap *= a;
            if (PASS == 2) st[t * 64 + lane] = (bf16)pg8::cvt_pk_bf16(h * bf2f(st[t * 64 + lane]), 0.f);
        }
        LDS_WAIT(); asm volatile("" ::: "memory");
        if (PASS == 2) {
#pragma unroll
            for (int i = 0; i < 4; ++i) *(v4u*)(YM + (r0 + lrow + 8 * i) * DM + 64 * j + 8 * lc8) = *(const LAS v4u*)(st + (lrow + 8 * i) * 64 + 8 * lc8);
            LDS_WAIT(); asm volatile("" ::: "memory");
        }
    }
    if (PASS == 1) { st_sc1(&agg[((size_t)(b * NCH + c) * 2 + 0) * DM + ch], ap); st_sc1(&agg[((size_t)(b * NCH + c) * 2 + 1) * DM + ch], h); }
    if (PASS == 2 && c == NCH - 1) F.out[O_HP + (size_t)b * DM + ch] = h;
}
typedef GAS unsigned long long gu64;
__device__ __forceinline__ void gr_store(unsigned long long* g, float v) { __hip_atomic_store(g, (1ull << 32) | (unsigned long long)__float_as_uint(v), __ATOMIC_RELAXED, __HIP_MEMORY_SCOPE_AGENT); }
__device__ __forceinline__ unsigned long long gr_load(unsigned long long* g) { return __hip_atomic_load(g, __ATOMIC_RELAXED, __HIP_MEMORY_SCOPE_AGENT); }
__device__ __forceinline__ void scan_lb_block(Frame& F, int bu, const ChanConst cc) {
    const int j = bu & 15, ib = (bu >> 4) & 3, b = bu >> 6, w = F.wave, q = 8 * ib + w;
    sample_rnn_body(F, (bu >> 4) * 8 + w, j, cc);
    const int lane = F.lane, r32 = lane & 31, hi = lane >> 5, ch = 64 * j + lane;
    LAS unsigned char* wl = F.lds + w * 16384;
    const bf16* XR = (const bf16*)(F.ws + WS_XR); const bf16* SGR = (const bf16*)(F.ws + WS_SGR);
    bf16* YM = (bf16*)(F.out + O_YP);
    LAS bf16* xt = (LAS bf16*)wl; LAS bf16* st = (LAS bf16*)(wl + 4096); LAS float* gt = (LAS float*)(wl + 8192);
    LAS float* xch = (LAS float*)(F.lds + BT_OFF);
    unsigned long long* lba = (unsigned long long*)(F.ws + WS_LBA) + ((size_t)(b * 16 + j) * 16) * 128 + lane;
    unsigned long long* lbh = (unsigned long long*)(F.ws + WS_LBH) + ((size_t)(b * 16 + j) * 4) * 64 + lane;
    const int lrow = lane >> 3, lc8 = lane & 7;
    const size_t row0 = (size_t)b * SEQ + 32 * q;
    const bf16* xsrc = XR + (row0 + lrow) * DM + 64 * j + 8 * lc8;
    const bf16* ssrc = SGR + (row0 + lrow) * DM + 64 * j + 8 * lc8;
    v4u xn[4], sn[4];
#pragma unroll
    for (int i = 0; i < 4; ++i) { xn[i] = __builtin_nontemporal_load((const v4u*)(xsrc + (size_t)(8 * i) * DM)); sn[i] = __builtin_nontemporal_load((const v4u*)(ssrc + (size_t)(8 * i) * DM)); }
    float hx3 = 0.f, hx2 = 0.f, hx1 = 0.f;
    if (q > 0) { hx3 = bf2f(XR[(row0 - 3) * DM + ch]); hx2 = bf2f(XR[(row0 - 2) * DM + ch]); hx1 = bf2f(XR[(row0 - 1) * DM + ch]); }
    const LAS unsigned char* gwr = F.lds + GW_OFF + r32 * GW_STRIDE + 16 * hi;
    for (int r = 0; r < 4; ++r) {
        const size_t r0 = row0 + 1024 * r;
#pragma unroll
        for (int i = 0; i < 4; ++i) { *(LAS v4u*)(xt + (lrow + 8 * i) * 64 + 8 * lc8) = xn[i]; *(LAS v4u*)(st + (lrow + 8 * i) * 64 + 8 * lc8) = sn[i]; }
        float xm3 = hx3, xm2 = hx2, xm1 = hx1;
        if (r < 3) {
#pragma unroll
            for (int i = 0; i < 4; ++i) { xn[i] = __builtin_nontemporal_load((const v4u*)(xsrc + (size_t)(1024 * (r + 1) + 8 * i) * DM)); sn[i] = __builtin_nontemporal_load((const v4u*)(ssrc + (size_t)(1024 * (r + 1) + 8 * i) * DM)); }
            hx3 = bf2f(XR[(r0 + 1024 - 3) * DM + ch]); hx2 = bf2f(XR[(r0 + 1024 - 2) * DM + ch]); hx1 = bf2f(XR[(r0 + 1024 - 1) * DM + ch]);
        }
        LDS_WAIT(); asm volatile("" ::: "memory");
        float xc[32];
#pragma unroll
        for (int t = 0; t < 32; ++t) {
            const float x = bf2f(xt[t * 64 + lane]);
            xc[t] = cc.bc + cc.w0 * xm3 + cc.w1 * xm2 + cc.w2 * xm1 + cc.w3 * x;
            xm3 = xm2; xm2 = xm1; xm1 = x;
            xt[t * 64 + lane] = (bf16)pg8::cvt_pk_bf16(xc[t], 0.f);
        }
        LDS_WAIT(); asm volatile("" ::: "memory");
        bf16x8 af[4];
#pragma unroll
        for (int d0 = 0; d0 < 4; ++d0) af[d0] = *(const LAS bf16x8*)(xt + r32 * 64 + 16 * d0 + 8 * hi);
        float av[32], uv[32];
#pragma unroll
        for (int oh = 0; oh < 2; ++oh) {
            f32x16 d = {};
#pragma unroll
            for (int d0 = 0; d0 < 4; ++d0) d = __builtin_amdgcn_mfma_f32_32x32x16_bf16(af[d0], *(const LAS bf16x8*)(gwr + (32 * oh) * GW_STRIDE + 32 * d0), d, 0, 0, 0);
#pragma unroll
            for (int g4 = 0; g4 < 4; ++g4) *(LAS f32x4*)(gt + (32 * oh + r32) * 32 + (((2 * g4 + hi) ^ (((32 * oh + r32) >> 1) & 7)) << 2)) = (f32x4){d[4 * g4], d[4 * g4 + 1], d[4 * g4 + 2], d[4 * g4 + 3]};
        }
        LDS_WAIT(); asm volatile("" ::: "memory");
#pragma unroll
        for (int c = 0; c < 8; ++c) { const f32x4 v4 = *(const LAS f32x4*)(gt + lane * 32 + ((c ^ ((lane >> 1) & 7)) << 2)); av[4 * c] = v4[0]; av[4 * c + 1] = v4[1]; av[4 * c + 2] = v4[2]; av[4 * c + 3] = v4[3]; }
        LDS_WAIT(); asm volatile("" ::: "memory");
#pragma unroll
        for (int oh = 0; oh < 2; ++oh) {
            f32x16 d = {};
#pragma unroll
            for (int d0 = 0; d0 < 4; ++d0) d = __builtin_amdgcn_mfma_f32_32x32x16_bf16(af[d0], *(const LAS bf16x8*)(gwr + (64 + 32 * oh) * GW_STRIDE + 32 * d0), d, 0, 0, 0);
#pragma unroll
            for (int g4 = 0; g4 < 4; ++g4) *(LAS f32x4*)(gt + (32 * oh + r32) * 32 + (((2 * g4 + hi) ^ (((32 * oh + r32) >> 1) & 7)) << 2)) = (f32x4){d[4 * g4], d[4 * g4 + 1], d[4 * g4 + 2], d[4 * g4 + 3]};
        }
        LDS_WAIT(); asm volatile("" ::: "memory");
        float hl = 0.f, ap = 1.f;
        typedef float f2 __attribute__((ext_vector_type(2)));
#pragma unroll
        for (int c = 0; c < 8; ++c) {
            const f32x4 z4 = *(const LAS f32x4*)(gt + lane * 32 + ((c ^ ((lane >> 1) & 7)) << 2));
#pragma unroll
            for (int p = 0; p < 2; ++p) {
                const int t = 4 * c + 2 * p;
                const f2 zr2 = {av[t], av[t + 1]}, zi2 = {z4[2 * p], z4[2 * p + 1]}, xc2 = {xc[t], xc[t + 1]};
                f2 er = zr2 * (-LOG2E) + cc.nbra, ei = zi2 * (-LOG2E) + cc.nbrx;
                er = (f2){fexp2(er.x), fexp2(er.y)} + 1.0f; ei = (f2){fexp2(ei.x), fexp2(ei.y)} + 1.0f;
                const f2 rg = {frcp(er.x), frcp(er.y)}, ig = {frcp(ei.x), frcp(ei.y)};
                const f2 la = rg * cc.c1;
                const f2 a2 = {fexp2(la.x), fexp2(la.y)};
                const f2 om = 1.0f - a2 * a2;
                const f2 sq = {__builtin_amdgcn_sqrtf(om.x), __builtin_amdgcn_sqrtf(om.y)};
                const f2 u2 = sq * ig * xc2;
                av[t] = a2.x; av[t + 1] = a2.y; uv[t] = u2.x; uv[t + 1] = u2.y;
                hl = a2.x * hl + u2.x; hl = a2.y * hl + u2.y; ap *= a2.x * a2.y;
            }
        }
        LAS float* xw = xch + (r & 1) * 1024;
        xw[(w * 2 + 0) * 64 + lane] = ap; xw[(w * 2 + 1) * 64 + lane] = hl;
        LDS_WAIT(); __syncthreads();
        float pa = 1.f, ph = 0.f;
        for (int k = 0; k < w; ++k) { const float ak = xw[(k * 2 + 0) * 64 + lane], hk = xw[(k * 2 + 1) * 64 + lane]; ph = ak * ph + hk; pa = ak * pa; }
        if (w == 7 && ib < 3) { gr_store(lba + (size_t)(r * 4 + ib) * 128, ap * pa); gr_store(lba + (size_t)(r * 4 + ib) * 128 + 64, ap * ph + hl); }
        float hin = 0.f;
        {
            unsigned long long gh = (1ull << 32), ga[3] = {1ull << 32, 1ull << 32, 1ull << 32}, gb[3] = {1ull << 32, 1ull << 32, 1ull << 32};
            unsigned sp = 0;
            for (;;) {
                if (r > 0) gh = gr_load(lbh + (size_t)(r - 1) * 64);
#pragma unroll
                for (int k = 0; k < 3; ++k) if (k < ib) { ga[k] = gr_load(lba + (size_t)(r * 4 + k) * 128); gb[k] = gr_load(lba + (size_t)(r * 4 + k) * 128 + 64); }
                bool ok = (gh >> 32) == 1ull;
#pragma unroll
                for (int k = 0; k < 3; ++k) ok = ok && (ga[k] >> 32) == 1ull && (gb[k] >> 32) == 1ull;
                if (__all(ok)) break;
                __builtin_amdgcn_s_sleep(2);
                if (++sp > (1u << 20)) break;
            }
            if (r > 0) hin = __uint_as_float((unsigned)gh);
#pragma unroll
            for (int k = 0; k < 3; ++k) if (k < ib) hin = __uint_as_float((unsigned)ga[k]) * hin + __uint_as_float((unsigned)gb[k]);
            hin = pa * hin + ph;
        }
        float h = hin;
#pragma unroll
        for (int t = 0; t < 32; ++t) {
            h = av[t] * h + uv[t];
            st[t * 64 + lane] = (bf16)pg8::cvt_pk_bf16(h * bf2f(st[t * 64 + lane]), 0.f);
        }
        LDS_WAIT(); asm volatile("" ::: "memory");
#pragma unroll
        for (int i = 0; i < 4; ++i) *(v4u*)(YM + (r0 + lrow + 8 * i) * DM + 64 * j + 8 * lc8) = *(const LAS v4u*)(st + (lrow + 8 * i) * 64 + 8 * lc8);
        if (q == 31) { if (r < 3) gr_store(lbh + (size_t)r * 64, h); else F.out[O_HP + (size_t)b * DM + ch] = h; }
        LDS_WAIT(); asm volatile("" ::: "memory");
    }
    __syncthreads();
}
template <int PASS>
__device__ __forceinline__ void scan_block(Frame& F, int bu) {
    const int j = bu & 15, ub = (bu >> 4) * 8 + F.wave;
    stage_gate_weights(F, j);
    LDS_WAIT(); __syncthreads();
    if (PASS == 1) sample_rnn_unit(F, ub, j);
    scan_unit<PASS>(F, ub >> 5, ub & 31, j, F.lds + F.wave * 16384);
    __syncthreads();
}
__device__ __forceinline__ void sample_rnn_unit(Frame& F, int bs, int j) { sample_rnn_body(F, bs, j, chan_const(F, 64 * j + F.lane)); }
__device__ __forceinline__ void sample_rnn_body(Frame& F, int bs, int j, const ChanConst cc) {
    const int lane = F.lane, ch = 64 * j + lane;
    const float* scv = F.in[I_SC] + (size_t)bs * 3 * DM;
    const float x0 = scv[ch], x1 = scv[DM + ch], x2 = scv[2 * DM + ch];
    const float x3 = bf2f(((const bf16*)(F.ws + WS_XR))[(size_t)(MP + bs) * DM + ch]);
    const float h0 = F.in[I_SH][(size_t)bs * DM + ch];
    const float sg = bf2f(((const bf16*)(F.ws + WS_SGR))[(size_t)(MP + bs) * DM + ch]);
    const float xc = cc.bc + cc.w0 * x0 + cc.w1 * x1 + cc.w2 * x2 + cc.w3 * x3;
    const int xci = __float_as_int(xc);
    const LAS unsigned char* gw = F.lds + GW_OFF + lane * GW_STRIDE;
    float zr = 0.f, zi = 0.f;
#pragma unroll
    for (int k8 = 0; k8 < 8; ++k8) {
        const v4u wr4 = *(const LAS v4u*)(gw + 16 * k8), wi4 = *(const LAS v4u*)(gw + 64 * GW_STRIDE + 16 * k8);
        const unsigned wrw[4] = {wr4.x, wr4.y, wr4.z, wr4.w}, wiw[4] = {wi4.x, wi4.y, wi4.z, wi4.w};
#pragma unroll
        for (int e = 0; e < 4; ++e) {
            const float xa = __int_as_float(__builtin_amdgcn_readlane(xci, 8 * k8 + 2 * e)), xb = __int_as_float(__builtin_amdgcn_readlane(xci, 8 * k8 + 2 * e + 1));
            zr += xa * bflo(wrw[e]); zr += xb * bfhi(wrw[e]); zi += xa * bflo(wiw[e]); zi += xb * bfhi(wiw[e]);
        }
    }
    const float rg = sigm(zr + cc.bra), ig = sigm(zi + cc.brx);
    const float a = fexp2(cc.c1 * rg);
    const float sq = sqrtf(fmaxf(1.0f - a * a, 0.f));
    const float h = a * h0 + sq * ig * xc;
    F.out[O_HS + (size_t)bs * DM + ch] = h;
    float* cv = F.out + O_CVS + (size_t)bs * 3 * DM;
    cv[ch] = x1; cv[DM + ch] = x2; cv[2 * DM + ch] = x3;
    {
        const unsigned mine = f2bf(h * sg), other = (unsigned)__shfl_xor((int)mine, 1);
        if ((lane & 1) == 0) __hip_atomic_store((unsigned*)((bf16*)(F.ws + WS_YT) + (size_t)bs * 2048 + 1024 + ch), mine | (other << 16), __ATOMIC_RELAXED, __HIP_MEMORY_SCOPE_AGENT);
    }
}

__device__ __forceinline__ float logit_bound(Frame& F) {
    float mq = fabsf(F.in[I_QG][F.lane]), mk = fabsf(F.in[I_KG][F.lane]), mb = 0.f;
#pragma unroll
    for (int i = 0; i < 8; ++i) mb = fmaxf(mb, fabsf(F.in[I_REL][F.lane + 64 * i]));
#pragma unroll
    for (int o = 1; o < 64; o <<= 1) { mq = fmaxf(mq, __shfl_xor(mq, o)); mk = fmaxf(mk, __shfl_xor(mk, o)); mb = fmaxf(mb, __shfl_xor(mb, o)); }
    return (8.0f * mq * mk + mb) * LOG2E;
}

__device__ __forceinline__ void build_bias_table(Frame& F) {
    LAS float* bt = (LAS float*)(F.lds + BT_OFF);
    float rv[4];
#pragma unroll
    for (int i = 0; i < 4; ++i) { const int e = F.tid + 512 * i; rv[i] = F.in[I_REL][rel_bucket(e & 127) * 16 + (e >> 7)]; }
#pragma unroll
    for (int i = 0; i < 4; ++i) bt[F.tid + 512 * i] = rv[i] * LOG2E;
}
__device__ __forceinline__ void sample_attn_load(Frame& F, int pair, f32x4 (&kv)[8], f32x4 (&vv)[8]) {
    const int lane = F.lane, w = F.wave, u = 2 * pair + (w >> 2), bs = u >> 2, g = u & 3, kq = w & 3;
    const int dch = lane & 15, ksub = lane >> 4;
    const float* ck = F.in[I_CK] + (((size_t)bs * 128 + 32 * kq + ksub) * 4 + g) * 64 + 4 * dch;
    const float* cv = F.in[I_CV] + (((size_t)bs * 128 + 32 * kq + ksub) * 4 + g) * 64 + 4 * dch;
#pragma unroll
    for (int i = 0; i < 8; ++i) kv[i] = __builtin_nontemporal_load((const f32x4*)(ck + (size_t)i * 1024));
#pragma unroll
    for (int i = 0; i < 8; ++i) vv[i] = __builtin_nontemporal_load((const f32x4*)(cv + (size_t)i * 1024));
}
__device__ __forceinline__ void sample_attn_body(Frame& F, int pair, float M0, const f32x4 (&kv)[8], const f32x4 (&vv)[8]) {
    const int lane = F.lane, w = F.wave, u = 2 * pair + (w >> 2), bs = u >> 2, g = u & 3, kq = w & 3;
    const int dch = lane & 15, ksub = lane >> 4;
    const LAS float* bt = (const LAS float*)(F.lds + BT_OFF);
    LAS float* part = (LAS float*)F.lds;
    const bf16* QT = (const bf16*)(F.ws + WS_QT) + (size_t)bs * DM + g * 256;
    float q[4][4];
#pragma unroll
    for (int hh = 0; hh < 4; ++hh) { const v2u qq = *(const v2u*)(QT + hh * 64 + 4 * dch); q[hh][0] = bflo(qq.x); q[hh][1] = bfhi(qq.x); q[hh][2] = bflo(qq.y); q[hh][3] = bfhi(qq.y); }
    float l[4] = {0.f, 0.f, 0.f, 0.f}; float o[4][4];
#pragma unroll
    for (int hh = 0; hh < 4; ++hh)
#pragma unroll
        for (int e = 0; e < 4; ++e) o[hh][e] = 0.f;
#pragma unroll
    for (int i = 0; i < 8; ++i) {
        const int key = 32 * kq + 4 * i + ksub;
#pragma unroll
        for (int hh = 0; hh < 4; ++hh) {
            float sdot = (kv[i][0] * q[hh][0] + kv[i][1] * q[hh][1]) + (kv[i][2] * q[hh][2] + kv[i][3] * q[hh][3]);
            sdot += __shfl_xor(sdot, 1); sdot += __shfl_xor(sdot, 2); sdot += __shfl_xor(sdot, 4); sdot += __shfl_xor(sdot, 8);
            const float ev = (key >= 1) ? fexp2(sdot + bt[(4 * g + hh) * 128 + ((128 - key) & 127)] - M0) : 0.f;
            l[hh] += ev;
#pragma unroll
            for (int e = 0; e < 4; ++e) o[hh][e] += ev * vv[i][e];
        }
    }
#pragma unroll
    for (int hh = 0; hh < 4; ++hh) {
        l[hh] += __shfl_xor(l[hh], 16); l[hh] += __shfl_xor(l[hh], 32);
#pragma unroll
        for (int e = 0; e < 4; ++e) { o[hh][e] += __shfl_xor(o[hh][e], 16); o[hh][e] += __shfl_xor(o[hh][e], 32); }
    }
    if (ksub == 0) {
#pragma unroll
        for (int hh = 0; hh < 4; ++hh) *(LAS f32x4*)(part + (w * 4 + hh) * 64 + 4 * dch) = (f32x4){o[hh][0], o[hh][1], o[hh][2], o[hh][3]};
    }
    if (lane < 4) part[8 * 256 + w * 4 + lane] = (lane == 0) ? l[0] : (lane == 1) ? l[1] : (lane == 2) ? l[2] : l[3];
    LDS_WAIT(); __syncthreads();
    if (kq == 0) {
        const float* kn = (const float*)(F.ws + WS_KVNEW) + (size_t)bs * 256 + g * 64; const float* vn = kn + 128 * 256;
        const float knew = kn[lane], vnew = vn[lane];
        const bf16* sga = (const bf16*)(F.ws + WS_SGA) + (size_t)(MP + bs) * DM + g * 256;
        bf16* yt = (bf16*)(F.ws + WS_YT) + (size_t)bs * 2048 + g * 256;
        float qh[4], sgv[4], snk[4];
#pragma unroll
        for (int hh = 0; hh < 4; ++hh) { qh[hh] = bf2f(QT[hh * 64 + lane]); sgv[hh] = bf2f(sga[hh * 64 + lane]); snk[hh] = F.in[I_SINK][4 * g + hh]; }
        float res[4];
#pragma unroll
        for (int hh = 0; hh < 4; ++hh) {
            float sn = qh[hh] * knew;
#pragma unroll
            for (int ofs = 1; ofs < 64; ofs <<= 1) sn += __shfl_xor(sn, ofs);
            const float en = fexp2(sn + bt[(4 * g + hh) * 128] - M0);
            float osum = 0.f, lsum = 0.f;
#pragma unroll
            for (int k4 = 0; k4 < 4; ++k4) { osum += part[((w + k4) * 4 + hh) * 64 + lane]; lsum += part[8 * 256 + (w + k4) * 4 + hh]; }
            const float den = lsum + en + fexp2(snk[hh] * LOG2E - M0);
            res[hh] = (osum + en * vnew) / den * sgv[hh];
        }
        F.out[O_KWS + (((size_t)bs * 128 + 127) * 4 + g) * 64 + lane] = knew; F.out[O_VWS + (((size_t)bs * 128 + 127) * 4 + g) * 64 + lane] = vnew;
#pragma unroll
        for (int hh = 0; hh < 4; ++hh) {
            const unsigned mine = f2bf(res[hh]), other = (unsigned)__shfl_xor((int)mine, 1);
            if ((lane & 1) == 0) __hip_atomic_store((unsigned*)(yt + hh * 64 + lane), mine | (other << 16), __ATOMIC_RELAXED, __HIP_MEMORY_SCOPE_AGENT);
        }
    }
    LDS_WAIT(); __syncthreads();
}
__device__ __forceinline__ void sample_attn_block(Frame& F, int pair, float M0) { f32x4 kv[8], vv[8]; sample_attn_load(F, pair, kv, vv); sample_attn_body(F, pair, M0, kv, vv); }

constexpr int KT_STRIDE = 144;
constexpr int VT_STRIDE = 520;
constexpr int AT_K = 0, AT_V = 256 * KT_STRIDE, AT_T = AT_V + 64 * VT_STRIDE, AT_END = AT_T + 4 * 384 * 4;
static_assert(AT_END <= RING_BYTES, "attention LDS");
constexpr int AT_OS = 144, AT_O = (AT_END + 15) & ~15;
static_assert(AT_O + NWAVES * 32 * AT_OS <= RING_BYTES, "attention output staging");
struct KVRegs { v4u k[4], v[4]; };
__device__ __forceinline__ void attn_load_kv(Frame& F, int b, int n, int g, KVRegs& r) {
    const bf16* Kb = (const bf16*)(F.ws + WS_K); const bf16* Vb = (const bf16*)(F.ws + WS_V);
    const long krow0 = (long)b * SEQ + 128 * (n - 1);
#pragma unroll
    for (int i = 0; i < 4; ++i) {
        const int cidx = F.tid + 512 * i; int kl = cidx >> 3; const int c8 = cidx & 7;
        if (n == 0 && kl < 128) kl += 128;
        const size_t off = (size_t)(krow0 + kl) * 256 + g * 64 + 8 * c8;
        r.k[i] = *(const v4u*)(Kb + off); r.v[i] = *(const v4u*)(Vb + off);
    }
}
__device__ __forceinline__ void attn_store_kv(Frame& F, const KVRegs& r) {
    LAS unsigned char* L = F.lds;
#pragma unroll
    for (int i = 0; i < 4; ++i) {
        const int cidx = F.tid + 512 * i, kl = cidx >> 3, c8 = cidx & 7;
        *(LAS v4u*)(L + AT_K + kl * KT_STRIDE + 16 * c8) = r.k[i];
        LAS bf16* vt = (LAS bf16*)(L + AT_V) + kl;
        const unsigned ww[4] = {r.v[i].x, r.v[i].y, r.v[i].z, r.v[i].w};
#pragma unroll
        for (int e = 0; e < 4; ++e) { vt[(8 * c8 + 2 * e) * (VT_STRIDE / 2)] = (bf16)(ww[e] & 0xffffu); vt[(8 * c8 + 2 * e + 1) * (VT_STRIDE / 2)] = (bf16)(ww[e] >> 16); }
    }
}
__device__ __forceinline__ void attn_compute(Frame& F, int b, int n, int g, float M0) {
    const int lane = F.lane, r32 = lane & 31, hi = lane >> 5, w = F.wave;
    LAS unsigned char* L = F.lds;
    const int hq = w >> 1, head = 4 * g + hq;
    const bf16* Q = (const bf16*)(F.out + O_YP) + QM_OFF;
    const bf16* SGA = (const bf16*)(F.ws + WS_SGA);
    bf16* YM = (bf16*)(F.ws + WS_XN);
    const float sinkv = fexp2(F.in[I_SINK][head] * LOG2E - M0);
    const unsigned onew = (r32 == 0 || r32 == 4) ? 0x3f803f80u : 0u;
    const bf16x8 onesf = __builtin_bit_cast(bf16x8, (v4u){onew, onew, onew, onew});
    for (int sb = 0; sb < 2; ++sb) {
        const int s = 2 * (w & 1) + sb;
        const size_t qrow = (size_t)b * SEQ + 128 * n + 32 * s + r32;
        bf16x8 qf[4];
#pragma unroll
        for (int d0 = 0; d0 < 4; ++d0) qf[d0] = *(const bf16x8*)(Q + qrow * DM + head * 64 + 16 * d0 + 8 * hi);
        const bf16* sg = SGA + qrow * DM + head * 64 + 4 * hi;
        v2u sgw[8];
#pragma unroll
        for (int q4 = 0; q4 < 4; ++q4) { sgw[q4] = *(const v2u*)(sg + 8 * q4); sgw[4 + q4] = *(const v2u*)(sg + 32 + 8 * q4); }
        f32x16 o0 = {}, o1 = {}, o2 = {};
        for (int kk = 0; kk < 3; ++kk) {
            const int kt = (s >> 1) + kk;
            if (n == 0 && kt < 2) continue;
            f32x16 p0 = {}, p1 = {};
            const LAS unsigned char* kb = L + AT_K + (64 * kt + r32) * KT_STRIDE + 16 * hi;
#pragma unroll
            for (int d0 = 0; d0 < 4; ++d0) {
                const bf16x8 a0 = *(const LAS bf16x8*)(kb + 32 * d0);
                const bf16x8 a1 = *(const LAS bf16x8*)(kb + 32 * KT_STRIDE + 32 * d0);
                p0 = __builtin_amdgcn_mfma_f32_32x32x16_bf16(a0, qf[d0], p0, 0, 0, 0);
                p1 = __builtin_amdgcn_mfma_f32_32x32x16_bf16(a1, qf[d0], p1, 0, 0, 0);
            }
            const int dbase = 128 + 32 * s + r32 - 64 * kt - 4 * hi;
            const LAS float* tb = (const LAS float*)(L + AT_T) + hq * 384 + 128 + dbase - 59;
#pragma unroll
            for (int r = 0; r < 16; ++r) {
                const int c = (r & 3) + 8 * (r >> 2);
                p0[r] = fexp2(p0[r] + tb[59 - c]); p1[r] = fexp2(p1[r] + tb[27 - c]);
            }
            const LAS unsigned char* vb = L + AT_V + r32 * VT_STRIDE + (64 * kt + 4 * hi) * 2;
#pragma unroll
            for (int ks = 0; ks < 4; ++ks) {
                v4u pw;
                if (ks == 0)      { pw.x = pg8::cvt_pk_bf16(p0[0], p0[1]);   pw.y = pg8::cvt_pk_bf16(p0[2], p0[3]);   pw.z = pg8::cvt_pk_bf16(p0[4], p0[5]);   pw.w = pg8::cvt_pk_bf16(p0[6], p0[7]); }
                else if (ks == 1) { pw.x = pg8::cvt_pk_bf16(p0[8], p0[9]);   pw.y = pg8::cvt_pk_bf16(p0[10], p0[11]); pw.z = pg8::cvt_pk_bf16(p0[12], p0[13]); pw.w = pg8::cvt_pk_bf16(p0[14], p0[15]); }
                else if (ks == 2) { pw.x = pg8::cvt_pk_bf16(p1[0], p1[1]);   pw.y = pg8::cvt_pk_bf16(p1[2], p1[3]);   pw.z = pg8::cvt_pk_bf16(p1[4], p1[5]);   pw.w = pg8::cvt_pk_bf16(p1[6], p1[7]); }
                else              { pw.x = pg8::cvt_pk_bf16(p1[8], p1[9]);   pw.y = pg8::cvt_pk_bf16(p1[10], p1[11]); pw.z = pg8::cvt_pk_bf16(p1[12], p1[13]); pw.w = pg8::cvt_pk_bf16(p1[14], p1[15]); }
                const bf16x8 pb = __builtin_bit_cast(bf16x8, pw);
                const v2u va0 = *(const LAS v2u*)(vb + 32 * ks), va1 = *(const LAS v2u*)(vb + 32 * ks + 16);
                const v2u vc0 = *(const LAS v2u*)(vb + 32 * VT_STRIDE + 32 * ks), vc1 = *(const LAS v2u*)(vb + 32 * VT_STRIDE + 32 * ks + 16);
                const bf16x8 fa = __builtin_bit_cast(bf16x8, (v4u){va0.x, va0.y, va1.x, va1.y});
                const bf16x8 fc = __builtin_bit_cast(bf16x8, (v4u){vc0.x, vc0.y, vc1.x, vc1.y});
                o0 = __builtin_amdgcn_mfma_f32_32x32x16_bf16(fa, pb, o0, 0, 0, 0);
                o1 = __builtin_amdgcn_mfma_f32_32x32x16_bf16(fc, pb, o1, 0, 0, 0);
                o2 = __builtin_amdgcn_mfma_f32_32x32x16_bf16(onesf, pb, o2, 0, 0, 0);
            }
        }
        const float inv = 1.0f / (o2[0] + sinkv);
        LAS unsigned char* ost = L + AT_O + w * (32 * AT_OS);
#pragma unroll
        for (int half = 0; half < 2; ++half) {
            v2u ow[4];
#pragma unroll
            for (int q4 = 0; q4 < 4; ++q4) {
                const v2u sw = sgw[4 * half + q4];
                const float o_0 = half ? o1[4 * q4] : o0[4 * q4], o_1 = half ? o1[4 * q4 + 1] : o0[4 * q4 + 1], o_2 = half ? o1[4 * q4 + 2] : o0[4 * q4 + 2], o_3 = half ? o1[4 * q4 + 3] : o0[4 * q4 + 3];
                ow[q4].x = pg8::cvt_pk_bf16(o_0 * inv * bflo(sw.x), o_1 * inv * bfhi(sw.x)); ow[q4].y = pg8::cvt_pk_bf16(o_2 * inv * bflo(sw.y), o_3 * inv * bfhi(sw.y));
            }
#pragma unroll
            for (int k = 0; k < 4; k += 2) {
                const auto rx = __builtin_amdgcn_permlane32_swap(ow[k].x, ow[k + 1].x, false, false);
                const auto ry = __builtin_amdgcn_permlane32_swap(ow[k].y, ow[k + 1].y, false, false);
                *(LAS v4u*)(ost + r32 * AT_OS + 64 * half + 16 * k + 16 * hi) = (v4u){(unsigned)rx[0], (unsigned)ry[0], (unsigned)rx[1], (unsigned)ry[1]};
            }
        }
        LDS_WAIT(); asm volatile("" ::: "memory");
#pragma unroll
        for (int i = 0; i < 4; ++i) {
            const int row = 8 * i + (lane >> 3);
            *(v4u*)(YM + (qrow - r32 + row) * DM + head * 64 + 8 * (lane & 7)) = *(const LAS v4u*)(ost + row * AT_OS + 16 * (lane & 7));
        }
        LDS_WAIT(); asm volatile("" ::: "memory");
    }
}
__device__ __forceinline__ void attn_phase(Frame& F, float M0) {
    const int NU = NB * 32 * 4;
    int u = blockIdx.x; if (u >= NU) return;
    KVRegs r; attn_load_kv(F, u >> 7, (u >> 2) & 31, u & 3, r);
    for (; u < NU; u += F.G) {
        attn_store_kv(F, r);
        {
            const int g_ = u & 3; LAS float* tb = (LAS float*)(F.lds + AT_T);
            float rv[3];
#pragma unroll
            for (int i = 0; i < 3; ++i) { const int e = F.tid + 512 * i, hh = e / 384, dist = e % 384 - 128; rv[i] = F.in[I_REL][rel_bucket(dist & 127) * 16 + 4 * g_ + hh]; }
#pragma unroll
            for (int i = 0; i < 3; ++i) { const int e = F.tid + 512 * i, dist = e % 384 - 128; tb[e] = ((unsigned)dist < 128u) ? rv[i] * LOG2E - M0 : -1e30f; }
        }
        const int un = u + F.G;
        if (un < NU) attn_load_kv(F, un >> 7, (un >> 2) & 31, un & 3, r);
        LDS_WAIT(); __syncthreads();
        attn_compute(F, u >> 7, (u >> 2) & 31, u & 3, M0);
        __syncthreads();
    }
}

constexpr int REP[7] = {1, 1, 1, 1, 1, 1, 1};
constexpr int REPS[4] = {1, 1, 1, 1};
__global__ void __launch_bounds__(NWAVES * 64, 2) hyb_fwd(Args args) {
    extern __shared__ __attribute__((aligned(16))) unsigned char lds[];
    Frame F;
    F.lds = (LAS unsigned char*)lds;
    F.tid = threadIdx.x; F.lane = F.tid & 63; F.wave = __builtin_amdgcn_readfirstlane(F.tid >> 6);
    F.G = gridDim.x; { const int bx = blockIdx.x; F.vcu = (F.G % 8 == 0) ? (bx % 8) * (F.G / 8) + bx / 8 : bx; }
    F.in = args.in; F.out = args.out; F.ws = args.ws;
    volatile LAS unsigned* MISC = (volatile LAS unsigned*)(F.lds + MISC_OFF);
    for (int u = F.tid; u < (LDS_BYTES - LDSCTL_OFF) / 4; u += NWAVES * 64) ((LAS unsigned*)(F.lds + LDSCTL_OFF))[u] = 0u;
    __syncthreads();
    const int lo = args.ph_lo, hi = args.ph_hi;
    const bool one = (hi - lo) > 1;
    XcdBarrier bar; bar.bar = (unsigned*)(F.ws + WS_CTL) + CW_BAR; bar.x = 0; bar.st = nullptr;
    if (one) bar = xcd_barrier_post((unsigned*)(F.ws + WS_CTL) + CW_BAR, MISC + 8);
#define IN(k) (lo <= (k) && (k) < hi)
#define SEAM(k) do { if (IN(k) && IN((k) + 1)) xcd_barrier(bar); } while (0)
    const int gw = F.vcu * NWAVES + F.wave, NGW = F.G * NWAVES;
    LAS unsigned char* wl = F.lds + F.wave * 16384;

    unsigned* ctlw = (unsigned*)(F.ws + WS_CTL);
    for (int rep = 0; rep < REP[0]; ++rep)
    if (IN(0)) {
        refresh(F);
        if (F.G == 256) {
            const int bx = (int)blockIdx.x;
            if (bx < 128) p0_mod_tile(F, bx, ctlw + CW_MODC, ctlw + CW_MODB);
            p0_weights(F, 128);
        } else {
            for (int t = blockIdx.x; t < 192; t += F.G) p0_mod_tile(F, t, t < 128 ? ctlw + CW_MODC : nullptr, t < 128 ? ctlw + CW_MODB : nullptr);
            p0_weights(F, 0);
        }
        {
            const int gt_ = F.vcu * (NWAVES * 64) + F.tid, NGT = F.G * NWAVES * 64;
            unsigned long long* za = (unsigned long long*)(F.ws + WS_LBA); unsigned long long* zh = (unsigned long long*)(F.ws + WS_LBH);
            for (int e = gt_; e < 131072; e += NGT) __hip_atomic_store(za + e, 0ull, __ATOMIC_RELAXED, __HIP_MEMORY_SCOPE_AGENT);
            for (int e = gt_; e < 16384; e += NGT) __hip_atomic_store(zh + e, 0ull, __ATOMIC_RELAXED, __HIP_MEMORY_SCOPE_AGENT);
        }
        __syncthreads();
    }
    for (int rep = 0; rep < REP[1]; ++rep)
    if (IN(1)) { refresh(F); p1_xn(F, ctlw + CW_MODC); }
    {
        XcdPending pend; const bool split = IN(1) && IN(2);
        if (split) xcd_barrier_arrive(bar, pend);
        const bool gate_tile = IN(0) && F.G == 256 && blockIdx.x >= 192;
        bool first_wait = false;
        if (gate_tile && split) {
            if (F.tid == 0) MISC[12] = (unsigned)pend.role;
            __syncthreads();
            first_wait = MISC[12] >= 2u;
            if (first_wait) xcd_barrier_wait(bar, pend);
        }
        if (gate_tile) { refresh(F); p0_mod_tile(F, 128 + ((int)blockIdx.x - 192), nullptr, nullptr); }
        if (split && !first_wait) xcd_barrier_wait(bar, pend);
    }
    for (int rep = 0; rep < REP[2]; ++rep)
    if (IN(2)) {
        pg8::Gemm g{(const bf16*)(F.ws + WS_XN), (const bf16*)(F.ws + WS_WIN), MPAD, INW, DM, nullptr, DM};
        pg8::StaticOrder S; S.init(MPAD, INW, F.G, (int)blockIdx.x);
        EpiZ E{F.ws, F.out, F.in[I_QG], F.in[I_KG]};
        pg8::gemm_phase<EpiZ, pg8::StaticOrder, true, true>(F.lds, g, S, E);
        refresh(F);
        for (;;) {
            if (F.tid == 0) MISC[10] = __hip_atomic_fetch_add(ctlw + CW_TQ, 1u, __ATOMIC_RELAXED, __HIP_MEMORY_SCOPE_AGENT);
            __syncthreads();
            const int it = (int)MISC[10];
            __syncthreads();
            if (it >= TQ_ALL) break;
            tail_item(F, it);
        }
    }
    float M0 = 0.f; ChanConst ccs{0.f, 0.f, 0.f, 0.f, 0.f, 0.f, 0.f, 0.f, 0.f, 0.f};
    f32x4 skv[8], svv[8];
    {
        XcdPending pend; const bool split = IN(2) && IN(3);
        if (split) xcd_barrier_arrive(bar, pend);
        if (IN(3) && F.vcu < NS * 2 && F.wave != 0) sample_attn_load(F, F.vcu, skv, svv);
        if (IN(3)) { refresh(F); M0 = logit_bound(F); build_bias_table(F); ccs = chan_const(F, 64 * (F.vcu & 15) + F.lane); if (F.G == 256) stage_gate_weights_direct(F, F.vcu & 15); LDS_WAIT(); }
        if (split) xcd_barrier_wait(bar, pend);
    }
    for (int rep = 0; rep < REP[3]; ++rep)
    if (IN(3)) {
        refresh(F);
        __syncthreads();
        for (int rs = 0; rs < REPS[0]; ++rs) {
        if (F.vcu < NS * 2) { if (F.wave == 0) sample_attn_load(F, F.vcu, skv, svv); sample_attn_body(F, F.vcu, M0, skv, svv); }
        for (int u = F.vcu + F.G; u < NS * 2; u += F.G) sample_attn_block(F, u, M0);
        }
        if (F.G == 256) {
            scan_lb_block(F, F.vcu, ccs);
        } else {
            for (int u = F.vcu; u < 256; u += F.G) scan_block<1>(F, u);
            soft_arrive(ctlw + CW_S1C, 1u);
        }
        soft_arrive(ctlw + CW_YTC, 1u);
        for (int rs = 0; rs < REPS[2]; ++rs)
        attn_phase(F, M0);
    }
    for (int rep = 0; rep < REP[4]; ++rep)
    if (IN(4) && F.G != 256) {
        refresh(F);
        soft_wait(ctlw + CW_S1C, (unsigned)F.G);
        for (int u = F.vcu; u < 256; u += F.G) scan_block<2>(F, u);
        __syncthreads();
    }
    {
        XcdPending pend; const bool split = IN(4) && IN(5);
        if (split) xcd_barrier_arrive(bar, pend);
        if (IN(5)) {
            refresh(F);
            bool first = true;
            for (int t = F.vcu; t < 256; t += F.G) { mini_merge_block(F, t, first ? ctlw + CW_YTC : nullptr, (unsigned)F.G); first = false; soft_arrive(ctlw + CW_MGC, 1u); }
            if (first) soft_wait(ctlw + CW_YTC, (unsigned)F.G);
        }
        if (split) xcd_barrier_wait(bar, pend);
    }
    for (int rep = 0; rep < REP[5]; ++rep)
    if (IN(5)) {
        pg8::Gemm g{(const bf16*)(F.ws + WS_XN), (const bf16*)(F.ws + WS_WPP), MP, DM, 2048, (const bf16*)(F.out + O_YP), DM};
        pg8::StaticOrder S; S.init(MP, DM, F.G, (int)blockIdx.x);
        EpiMerge E{F.ws + WS_RAT, F.ws + WS_SMR, (bf16*)(F.ws + WS_SGA)};
        pg8::gemm_phase<EpiMerge, pg8::StaticOrder, false, true>(F.lds, g, S, E);
    }
    {
        XcdPending pend; const bool split = IN(5) && IN(6);
        if (split) xcd_barrier_arrive(bar, pend);
        if (IN(6)) {
            refresh(F);
            bool first = true;
            for (int t = F.vcu; t < 256; t += F.G) { mini_out_block(F, t, first ? ctlw + CW_MGC : nullptr, 256u); first = false; }
            if (first) soft_wait(ctlw + CW_MGC, 256u);
        }
        if (split) xcd_barrier_wait(bar, pend);
    }
    for (int rep = 0; rep < REP[6]; ++rep)
    if (IN(6)) {
        refresh(F);
        pg8::Gemm g{(const bf16*)(F.ws + WS_SGA), (const bf16*)(F.ws + WS_WOUT), MP, DM, DM, nullptr, DM};
        pg8::StaticOrder S; S.init(MP, DM, F.G, (int)blockIdx.x);
        EpiOut E{F.in[I_XP], (const float*)(F.ws + WS_MOD), F.out + O_YP, F.lds + GW_OFF};
        pg8::gemm_phase<EpiOut, pg8::StaticOrder, false, true>(F.lds, g, S, E);
    }
#undef IN
#undef SEAM
}

#ifndef MK_N_LAUNCHES
#define MK_N_LAUNCHES 1
#endif
constexpr int N_PHASES = 7;

extern "C" void kernel_launch(void* const* d_in, const int* in_sizes, int n_in, void* d_out, int out_size, void* d_ws, size_t ws_size, hipStream_t stream) {
    static int grid = 0;
    if (grid == 0) {
        if (n_in != 26 || out_size != (int)O_END || ws_size < WS_END) { fprintf(stderr, "kernel_launch: unexpected shapes (n_in %d out %d ws %zu)\n", n_in, out_size, ws_size); grid = -1; return; }
        int dev = 0, cus = 0, per_cu = 0;
        if (hipGetDevice(&dev) != hipSuccess || hipDeviceGetAttribute(&cus, hipDeviceAttributeMultiprocessorCount, dev) != hipSuccess) { grid = -1; return; }
        if (hipFuncSetAttribute((const void*)hyb_fwd, hipFuncAttributeMaxDynamicSharedMemorySize, LDS_BYTES) != hipSuccess) { fprintf(stderr, "kernel_launch: hipFuncSetAttribute failed\n"); grid = -1; return; }
        if (hipOccupancyMaxActiveBlocksPerMultiprocessor(&per_cu, (const void*)hyb_fwd, NWAVES * 64, LDS_BYTES) != hipSuccess || per_cu < 1) { fprintf(stderr, "kernel_launch: occupancy query says %d\n", per_cu); per_cu = 1; }
        (void)hipGetLastError();
        grid = cus * (per_cu < 1 ? 1 : 1);
    }
    if (grid < 0) return;
    (void)hipMemsetAsync((char*)d_ws + WS_CTL, 0, CTL_ZERO_BYTES, stream);
    Args a{};
    for (int i = 0; i < 26; ++i) a.in[i] = (const float*)d_in[i];
    a.out = (float*)d_out; a.ws = (unsigned char*)d_ws;
    if (MK_N_LAUNCHES == 1) {
        a.ph_lo = 0; a.ph_hi = N_PHASES;
        void* kargs[] = {&a};
        hipError_t e = hipLaunchCooperativeKernel((const void*)hyb_fwd, dim3(grid), dim3(NWAVES * 64), kargs, LDS_BYTES, stream);
        if (e != hipSuccess) fprintf(stderr, "kernel_launch: cooperative launch failed: %s (grid %d)\n", hipGetErrorString(e), grid);
    } else {
        for (int p = 0; p < N_PHASES; ++p) {
            a.ph_lo = p; a.ph_hi = p + 1;
            hipLaunchKernelGGL(hyb_fwd, dim3(grid), dim3(NWAVES * 64), LDS_BYTES, stream, a);
        }
    }
}
```
